# Optimizing an MI355X kernel written in HIP

```python
import jax, jax.numpy as jnp
from jax import lax
import numpy as np

D_MODEL = 1024
BATCH = 4
SEQ = 4096
DEPTH = 4

CONV_CH = 512
CONV_W = 3
MLA_HEADS = 8
QK_NOPE = 64
QK_ROPE = 32
V_DIM = 64
Q_RANK = 384
KV_RANK = 256
ROPE_THETA = 10000.0
ATTN_BLOCK = 128
EVEN_SPLITS = (CONV_CH, 2 * CONV_CH, 3 * CONV_CH, 3 * CONV_CH + Q_RANK, 3 * CONV_CH + Q_RANK + KV_RANK)
EVEN_IN = 3 * CONV_CH + Q_RANK + KV_RANK + QK_ROPE
EVEN_MIX = CONV_CH + MLA_HEADS * V_DIM
SG_WIDTH = 1024
SG_GROUPS = 8
SG_CHUNK = 128
N_GROUPS = 4
EXP_PER_GROUP = 8
N_EXPERTS = N_GROUPS * EXP_PER_GROUP
TOP_K = 2
D_EXPERT = 512
MOE_BLOCK = 128
PLE_DIM = 256
N_EVEN = (DEPTH + 1) // 2
N_ODD = DEPTH // 2
NORM_EPS = 1e-6
NEG_INF = -1e30

kernel_name = "hybrid_conv_mla_sgmlp_hmoe"


def rms_norm(x, g):
    x32 = x.astype(jnp.float32)
    y = x32 * lax.rsqrt(jnp.mean(x32 * x32, axis=-1, keepdims=True) + NORM_EPS)
    return y.astype(x.dtype) * g


def rope_angles(positions):
    inv_freq = 1.0 / (ROPE_THETA ** (jnp.arange(0, QK_ROPE, 2, dtype=jnp.float32) / QK_ROPE))
    ang = positions.astype(jnp.float32)[..., None] * inv_freq
    return jnp.cos(ang)[:, :, None, :], jnp.sin(ang)[:, :, None, :]


def apply_rope(x, cos, sin):
    half = x.shape[-1] // 2
    x1, x2 = x[..., :half], x[..., half:]
    c, s = cos.astype(x.dtype), sin.astype(x.dtype)
    return jnp.concatenate([x1 * c - x2 * s, x2 * c + x1 * s], axis=-1)


def causal_block_attention(q, k, v):
    B_, S_, H, Dqk = q.shape
    nb = S_ // ATTN_BLOCK
    scale = 1.0 / float(np.sqrt(Dqk))
    qb = q.reshape(B_, nb, ATTN_BLOCK, H, Dqk).transpose(1, 0, 2, 3, 4)
    key_idx = jnp.arange(S_)

    def attend(args):
        q_blk, blk = args
        s = jnp.einsum('bqhd,bkhd->bhqk', q_blk, k).astype(jnp.float32) * scale
        q_idx = blk * ATTN_BLOCK + jnp.arange(ATTN_BLOCK)
        s = jnp.where(key_idx[None, :] <= q_idx[:, None], s, NEG_INF)
        pr = jax.nn.softmax(s, axis=-1).astype(v.dtype)
        return jnp.einsum('bhqk,bkhd->bqhd', pr, v)

    o = lax.map(attend, (qb, jnp.arange(nb)))
    return o.transpose(1, 0, 2, 3, 4).reshape(B_, S_, H * v.shape[-1])


def conv_mla_mixer(hn, positions, w_in, conv_w, q_norm, w_q_up, kv_norm, w_kv_up, w_out):
    B_, S_, _ = hn.shape
    proj = hn @ w_in
    xc, gb, gc, c_q, c_kv, k_pe = jnp.split(proj, EVEN_SPLITS, axis=-1)
    z = gc * xc
    z = lax.conv_general_dilated(z, conv_w[:, None, :], window_strides=(1,),
                                 padding=[(CONV_W - 1, 0)],
                                 dimension_numbers=('NWC', 'WIO', 'NWC'),
                                 feature_group_count=CONV_CH)
    y_a = gb * z
    q = (rms_norm(c_q, q_norm) @ w_q_up).reshape(B_, S_, MLA_HEADS, QK_NOPE + QK_ROPE)
    kv = (rms_norm(c_kv, kv_norm) @ w_kv_up).reshape(B_, S_, MLA_HEADS, QK_NOPE + V_DIM)
    k_nope, v = kv[..., :QK_NOPE], kv[..., QK_NOPE:]
    cos, sin = rope_angles(positions)
    q_pe = apply_rope(q[..., QK_NOPE:], cos, sin)
    k_pe = apply_rope(k_pe[:, :, None, :], cos, sin)
    q = jnp.concatenate([q[..., :QK_NOPE], q_pe], axis=-1)
    k = jnp.concatenate([k_nope, jnp.broadcast_to(k_pe, (B_, S_, MLA_HEADS, QK_ROPE))], axis=-1)
    y_b = causal_block_attention(q, k, v)
    return jnp.concatenate([y_a, y_b], axis=-1) @ w_out


def spatial_gating_mixer(hn, w_in, v_norm, w_s, b_s, w_out):
    B_, S_, _ = hn.shape
    z = jax.nn.gelu(hn @ w_in)
    u, v = z[..., :SG_WIDTH], z[..., SG_WIDTH:]
    v = rms_norm(v, v_norm).reshape(B_, S_ // SG_CHUNK, SG_CHUNK, SG_GROUPS, SG_WIDTH // SG_GROUPS)
    w = jnp.tril(w_s)
    s = jnp.einsum('gts,bcsgd->bctgd', w, v) + b_s.T[:, :, None]
    return (u * s.reshape(B_, S_, SG_WIDTH)) @ w_out


def hierarchical_moe(h, w_rg, w_re, w_gate, w_up, w_down):
    B_, S_, D = h.shape
    T = B_ * S_
    xt = h.reshape(T, D)
    g_logits = (xt @ w_rg).astype(jnp.float32)
    g_prob = jax.nn.softmax(g_logits, axis=-1)
    g_idx = jnp.argmax(g_logits, axis=-1)
    g_w = jnp.take_along_axis(g_prob, g_idx[:, None], axis=-1)
    e_logits = (xt @ w_re).astype(jnp.float32).reshape(T, N_GROUPS, EXP_PER_GROUP)
    e_logits = jnp.take_along_axis(e_logits, g_idx[:, None, None], axis=1)[:, 0]
    top_p, top_i = lax.top_k(jax.nn.softmax(e_logits, axis=-1), TOP_K)
    top_p = top_p / jnp.sum(top_p, axis=-1, keepdims=True)
    weights = (g_w * top_p).reshape(-1)
    expert = (g_idx[:, None] * EXP_PER_GROUP + top_i).reshape(-1)
    tok = jnp.repeat(jnp.arange(T, dtype=jnp.int32), TOP_K)
    A = T * TOP_K
    order = jnp.argsort(expert)
    se = expert[order]
    counts = jnp.bincount(expert, length=N_EXPERTS)
    starts = jnp.cumsum(counts) - counts
    padded = ((counts + MOE_BLOCK - 1) // MOE_BLOCK) * MOE_BLOCK
    pend = jnp.cumsum(padded)
    pstarts = pend - padded
    dest = pstarts[se] + (jnp.arange(A) - starts[se])
    P = A + N_EXPERTS * MOE_BLOCK
    nblk = P // MOE_BLOCK
    buf_tok = jnp.full((P,), T, dtype=jnp.int32).at[dest].set(tok[order])
    buf_w = jnp.zeros((P,), dtype=jnp.float32).at[dest].set(weights[order])
    blk_e = jnp.minimum(jnp.searchsorted(pend, jnp.arange(nblk) * MOE_BLOCK, side='right'),
                        N_EXPERTS - 1)
    xpad = jnp.concatenate([xt, jnp.zeros((1, D), xt.dtype)], axis=0)
    xb = xpad[buf_tok].reshape(nblk, MOE_BLOCK, D)

    def expert_block(args):
        x_blk, e = args
        return (jax.nn.silu(x_blk @ w_gate[e]) * (x_blk @ w_up[e])) @ w_down[e]

    yb = lax.map(expert_block, (xb, blk_e)).reshape(P, D)
    yb = yb * buf_w[:, None].astype(yb.dtype)
    out = jax.ops.segment_sum(yb, buf_tok, num_segments=T + 1)[:T]
    return out.reshape(B_, S_, D)


def per_layer_embedding(h, p_i, g_norm, w_gate, w_proj):
    gate = jax.nn.sigmoid(rms_norm(h, g_norm) @ w_gate)
    return gate * (p_i @ w_proj)


def setup_inputs(seed: int = 0) -> dict:
    key = jax.random.key(seed)
    ks = jax.random.split(key, 32)
    f32 = jnp.float32

    def nrm(k, shape, fan_in):
        return jax.random.normal(k, shape, f32) * (fan_in ** -0.5)

    def gain(k, shape):
        return 1.0 + 0.02 * jax.random.normal(k, shape, f32)

    x = jax.random.normal(ks[0], (BATCH, SEQ, D_MODEL), f32)
    p = jax.random.normal(ks[1], (DEPTH, BATCH, SEQ, PLE_DIM), f32)
    positions = (jnp.arange(SEQ, dtype=jnp.int32)[None, :]
                 + jax.random.randint(ks[2], (BATCH, 1), 0, 1024, dtype=jnp.int32))
    return {
        'x': x,
        'p': p,
        'positions': positions,
        'norm_mix': gain(ks[3], (DEPTH, D_MODEL)),
        'norm_ffn': gain(ks[4], (DEPTH, D_MODEL)),
        'w_in_e': nrm(ks[5], (N_EVEN, D_MODEL, EVEN_IN), D_MODEL),
        'conv_w': nrm(ks[6], (N_EVEN, CONV_W, CONV_CH), CONV_W),
        'q_norm': gain(ks[7], (N_EVEN, Q_RANK)),
        'w_q_up': nrm(ks[8], (N_EVEN, Q_RANK, MLA_HEADS * (QK_NOPE + QK_ROPE)), Q_RANK),
        'kv_norm': gain(ks[9], (N_EVEN, KV_RANK)),
        'w_kv_up': nrm(ks[10], (N_EVEN, KV_RANK, MLA_HEADS * (QK_NOPE + V_DIM)), KV_RANK),
        'w_out_e': nrm(ks[11], (N_EVEN, EVEN_MIX, D_MODEL), EVEN_MIX),
        'w_in_o': nrm(ks[12], (N_ODD, D_MODEL, 2 * SG_WIDTH), D_MODEL),
        'v_norm': gain(ks[13], (N_ODD, SG_WIDTH)),
        'w_s': nrm(ks[14], (N_ODD, SG_GROUPS, SG_CHUNK, SG_CHUNK), SG_CHUNK),
        'b_s': 1.0 + 0.02 * jax.random.normal(ks[15], (N_ODD, SG_GROUPS, SG_CHUNK), f32),
        'w_out_o': nrm(ks[16], (N_ODD, SG_WIDTH, D_MODEL), SG_WIDTH),
        'w_router_group': nrm(ks[17], (DEPTH, D_MODEL, N_GROUPS), D_MODEL),
        'w_router_expert': nrm(ks[18], (DEPTH, D_MODEL, N_EXPERTS), D_MODEL),
        'w_gate': nrm(ks[19], (DEPTH, N_EXPERTS, D_MODEL, D_EXPERT), D_MODEL),
        'w_up': nrm(ks[20], (DEPTH, N_EXPERTS, D_MODEL, D_EXPERT), D_MODEL),
        'w_down': nrm(ks[21], (DEPTH, N_EXPERTS, D_EXPERT, D_MODEL), D_EXPERT),
        'norm_ple': gain(ks[22], (DEPTH, D_MODEL)),
        'w_ple_gate': nrm(ks[23], (DEPTH, D_MODEL, D_MODEL), D_MODEL),
        'w_ple_proj': nrm(ks[24], (DEPTH, PLE_DIM, D_MODEL), PLE_DIM),
        'final_norm': gain(ks[25], (D_MODEL,)),
    }


def reference(x, p, positions, norm_mix, norm_ffn, w_in_e, conv_w, q_norm, w_q_up, kv_norm,
              w_kv_up, w_out_e, w_in_o, v_norm, w_s, b_s, w_out_o, w_router_group,
              w_router_expert, w_gate, w_up, w_down, norm_ple, w_ple_gate, w_ple_proj,
              final_norm):
    h = x
    for i in range(DEPTH):
        hn = rms_norm(h, norm_mix[i])
        j = i // 2
        if i % 2 == 0:
            mix = conv_mla_mixer(hn, positions, w_in_e[j], conv_w[j], q_norm[j], w_q_up[j],
                                 kv_norm[j], w_kv_up[j], w_out_e[j])
        else:
            mix = spatial_gating_mixer(hn, w_in_o[j], v_norm[j], w_s[j], b_s[j], w_out_o[j])
        h = h + mix
        h = h + hierarchical_moe(rms_norm(h, norm_ffn[i]), w_router_group[i], w_router_expert[i],
                                 w_gate[i], w_up[i], w_down[i])
        h = h + per_layer_embedding(h, p[i], norm_ple[i], w_ple_gate[i], w_ple_proj[i])
    return rms_norm(h, final_norm)
```

```cpp
#include <hip/hip_runtime.h>
#include <cstdio>
#include <cstdint>

#ifndef MEGA
#define MEGA 0
#endif

#define LAS __attribute__((address_space(3)))
#define GAS __attribute__((address_space(1)))
typedef unsigned short bf16_t;
typedef float f32x4 __attribute__((ext_vector_type(4)));
typedef unsigned u32x4 __attribute__((ext_vector_type(4)));
typedef unsigned u32x2 __attribute__((ext_vector_type(2)));
typedef short bf16x8 __attribute__((ext_vector_type(8)));

constexpr int T = 16384, D = 1024, SEQ = 4096, NBATCH = 4, DEPTH = 4;
constexpr int EIN = 2208, EINP = 2304;
constexpr int NH = 8, DQK = 96, DV = 64;
constexpr int QR = 384, KVR = 256;
constexpr int NEXP = 32, DEXP = 512;
constexpr int PLE = 256;
constexpr float EPS = 1e-6f;
constexpr int NWAVES = 8, NTHREADS = 512;
constexpr int MOE_ROWS = 40960;
constexpr float QSCALE = 0.10206207261596577f * 1.4426950408889634f;

constexpr size_t MiB = 1u << 20;
constexpr size_t WS_CTL = 0, CTL_ZERO_BYTES = 1 * MiB;
constexpr size_t WS_WINE = 1 * MiB;
constexpr size_t WS_WQ = 10 * MiB;
constexpr size_t WS_WKV = 12 * MiB;
constexpr size_t WS_WOE = 13 * MiB;
constexpr size_t WS_WINO = 17 * MiB;
constexpr size_t WS_WOO = 25 * MiB;
constexpr size_t WS_WS = 29 * MiB;
constexpr size_t WS_WR = 30 * MiB;
constexpr size_t WS_WG = 31 * MiB;
constexpr size_t WS_WP = 39 * MiB;
constexpr size_t WS_WGU = 41 * MiB;
constexpr size_t WS_WDN = 297 * MiB;
constexpr size_t WS_H = 425 * MiB;
constexpr size_t WS_HB0 = 489 * MiB;
constexpr size_t WS_HB1 = 521 * MiB;
constexpr size_t WS_SSQ0 = 553 * MiB;
constexpr size_t WS_SSQ1 = 554 * MiB;
constexpr size_t WS_SSQX = 555 * MiB;
constexpr size_t WS_ROPE = 558 * MiB;
constexpr size_t WS_PB = 560 * MiB;
constexpr size_t WS_P3 = 592 * MiB;
constexpr size_t WS_CQ = 640 * MiB;
constexpr size_t WS_CKV = 652 * MiB;
constexpr size_t WS_KPE = 660 * MiB;
constexpr size_t WS_Z = 592 * MiB;
constexpr size_t WS_Q = 661 * MiB;
constexpr size_t WS_KV = 685 * MiB;
constexpr size_t WS_MIX = 717 * MiB;
constexpr size_t WS_LIST = 749 * MiB;
constexpr size_t WS_LW = 751 * MiB;
constexpr size_t WS_TOK = 753 * MiB;
constexpr size_t WS_ACT = 754 * MiB;
constexpr size_t WS_Y = 794 * MiB;
constexpr size_t WS_PP = 874 * MiB;
constexpr size_t WS_END = 906 * MiB;

constexpr int CW_CNT = 64;
constexpr int CW_BAR = 4096;

constexpr int LDS_BYTES = 147456;
constexpr int LDS_MISC = LDS_BYTES - 256;

__device__ __forceinline__ float bf2f(unsigned b) { return __uint_as_float(b << 16); }
__device__ __forceinline__ unsigned f2bf(float f) { unsigned u = __float_as_uint(f); return (u + 0x7fffu + ((u >> 16) & 1u)) >> 16; }
__device__ __forceinline__ unsigned pk2(float lo, float hi) { return f2bf(lo) | (f2bf(hi) << 16); }
__device__ __forceinline__ void unpack8(const u32x4 w, float* v) {
    v[0] = __uint_as_float(w.x << 16); v[1] = __uint_as_float(w.x & 0xffff0000u);
    v[2] = __uint_as_float(w.y << 16); v[3] = __uint_as_float(w.y & 0xffff0000u);
    v[4] = __uint_as_float(w.z << 16); v[5] = __uint_as_float(w.z & 0xffff0000u);
    v[6] = __uint_as_float(w.w << 16); v[7] = __uint_as_float(w.w & 0xffff0000u);
}
__device__ __forceinline__ u32x4 pack8(const float* v) { u32x4 w; w.x = pk2(v[0], v[1]); w.y = pk2(v[2], v[3]); w.z = pk2(v[4], v[5]); w.w = pk2(v[6], v[7]); return w; }
__device__ __forceinline__ float rbf(float f) { return bf2f(f2bf(f)); }
__device__ __forceinline__ float wave_sum(float v) {
#pragma unroll
    for (int o = 1; o < 64; o <<= 1) v += __shfl_xor(v, o);
    return v;
}
__device__ __forceinline__ float wave_max(float v) {
#pragma unroll
    for (int o = 1; o < 64; o <<= 1) v = fmaxf(v, __shfl_xor(v, o));
    return v;
}
__device__ __forceinline__ float sigmoidf_(float x) { return 1.0f / (1.0f + __expf(-x)); }
__device__ __forceinline__ float gelu_tanh(float x) {
    const float u = 0.7978845608028654f * (x + 0.044715f * x * x * x);
    const float e = __expf(2.0f * u);
    const float th = 1.0f - 2.0f / (e + 1.0f);
    return 0.5f * x * (1.0f + th);
}

#define XB_TMO      128
#define XB_XCNT(j)  (256  + 64 * (j))
#define XB_XSUB(j)  (1280 + 64 * (j))
#define XB_XGEN(j)  (2304 + 64 * (j))
#define XB_TOP      3328
#define XB_TOPGEN   3392
#define XCD_BAR_WORDS 3456
#define XB_SPIN_CAP (1u << 22)
__device__ __forceinline__ unsigned xb_ld(unsigned* p)              { return __hip_atomic_load(p, __ATOMIC_RELAXED, __HIP_MEMORY_SCOPE_AGENT); }
__device__ __forceinline__ unsigned xb_add(unsigned* p, unsigned v) { return __hip_atomic_fetch_add(p, v, __ATOMIC_RELAXED, __HIP_MEMORY_SCOPE_AGENT); }
__device__ __forceinline__ unsigned xb_xcc_id() { return (unsigned)__builtin_amdgcn_s_getreg((3 << 11) | 20) & 0xFu; }
#define XB_SPIN(cond, bar) do { unsigned _sp = 0; while (cond) { __builtin_amdgcn_s_sleep(1); \
    if ((++_sp & 255u) == 0u) { if (xb_ld(&(bar)[XB_TMO])) break; if (_sp > XB_SPIN_CAP) { atomicAdd(&(bar)[XB_TMO], 1u); break; } } } } while (0)
struct XcdBarrier { unsigned* bar; unsigned x; volatile LAS unsigned* st; };
__device__ __forceinline__ XcdBarrier xcd_barrier_post(unsigned* bar, volatile LAS unsigned* st) {
    XcdBarrier b; b.bar = bar; b.x = xb_xcc_id(); b.st = st;
    if (threadIdx.x == 0) (void)xb_add(&bar[XB_XCNT(b.x)], 1u);
    return b;
}
__device__ __forceinline__ void xcd_barrier_complete(unsigned* bar, unsigned x, unsigned& nloc, unsigned& nx) {
    const unsigned G = gridDim.x * gridDim.y * gridDim.z;
    unsigned sum, cnt, mine, sp = 0u;
    for (;;) {
        sum = 0u; cnt = 0u; mine = 0u;
#pragma unroll
        for (unsigned j = 0; j < 16; ++j) { const unsigned c = xb_ld(&bar[XB_XCNT(j)]); sum += c; cnt += (c > 0u) ? 1u : 0u; mine = (j == x) ? c : mine; }
        if (sum == G) break;
        __builtin_amdgcn_s_sleep(1);
        if ((++sp & 255u) == 0u) { if (xb_ld(&bar[XB_TMO])) break; if (sp > XB_SPIN_CAP) { atomicAdd(&bar[XB_TMO], 1u); break; } }
    }
    nloc = mine > 0u ? mine : 1u; nx = cnt > 0u ? cnt : 1u;
}
__device__ __forceinline__ void xcd_barrier(const XcdBarrier& b) {
    asm volatile("s_waitcnt vmcnt(0)" ::: "memory");
    __syncthreads();
    if (threadIdx.x == 0) {
        unsigned* bar = b.bar;
        __builtin_amdgcn_s_waitcnt(0);
        unsigned nloc = b.st[0], nx = b.st[1];
        if (nloc == 0u) { xcd_barrier_complete(bar, b.x, nloc, nx); b.st[0] = nloc; b.st[1] = nx; }
        const unsigned old = xb_add(&bar[XB_XSUB(b.x)], 1u);
        const unsigned gen = old / nloc;
        if (old + 1u == (gen + 1u) * nloc) {
            __builtin_amdgcn_fence(__ATOMIC_RELEASE, "agent");
            asm volatile("s_waitcnt vmcnt(0)" ::: "memory");
            const unsigned og = xb_add(&bar[XB_TOP], 1u);
            const unsigned tg = og / nx;
            if (og + 1u == (tg + 1u) * nx) xb_add(&bar[XB_TOPGEN], 1u);
            else XB_SPIN(xb_ld(&bar[XB_TOPGEN]) == tg, bar);
            __builtin_amdgcn_fence(__ATOMIC_ACQUIRE, "agent");
            xb_add(&bar[XB_XGEN(b.x)], 1u);
            asm volatile("s_waitcnt vmcnt(0)" ::: "memory");
        } else {
            XB_SPIN(xb_ld(&bar[XB_XGEN(b.x)]) == gen, bar);
            __builtin_amdgcn_fence(__ATOMIC_ACQUIRE, "agent");
            asm volatile("s_waitcnt vmcnt(0)" ::: "memory");
        }
    }
    __syncthreads();
}

struct Args { const float* in[26]; float* out; unsigned char* ws; int ph_lo, ph_hi; };
struct Ctx {
    LAS unsigned char* lds;
    const float* in[26]; float* out; unsigned char* ws;
    int tid, lane, wave, bid, nblk;
};
#define WSP(T_, off) ((T_*)(C.ws + (off)))

__device__ __forceinline__ void conv_item(const float* colp, int ldw, const float* gain, bf16_t* WT, int K, int k0, int n0, LAS float* scr, int lane) {
#pragma unroll 8
    for (int i = 0; i < 32; ++i) {
        const int kk = 2 * i + (lane >> 5);
        float v = colp ? colp[(size_t)(k0 + kk) * ldw] : 0.f;
        if (gain) v *= gain[k0 + kk];
        scr[kk * 33 + (lane & 31)] = v;
    }
    asm volatile("s_waitcnt lgkmcnt(0)" ::: "memory");
    const int c = lane & 7;
#pragma unroll
    for (int j = 0; j < 4; ++j) {
        const int n = (lane >> 3) + 8 * j; const LAS float* s = scr + (8 * c) * 33 + n;
        u32x4 o; o.x = pk2(s[0 * 33], s[1 * 33]); o.y = pk2(s[2 * 33], s[3 * 33]); o.z = pk2(s[4 * 33], s[5 * 33]); o.w = pk2(s[6 * 33], s[7 * 33]);
        *(u32x4*)(WT + (size_t)(n0 + n) * K + k0 + 8 * c) = o;
    }
    asm volatile("s_waitcnt lgkmcnt(0)" ::: "memory");
}

__device__ __forceinline__ void phase_prologue(Ctx& C) {
    LAS float* scr = (LAS float*)(C.lds + C.wave * 16384);
    const int gw = C.bid * NWAVES + C.wave, NGW = C.nblk * NWAVES, lane = C.lane;
    constexpr int I0 = 16 * 72, I1 = 6 * 24, I2 = 4 * 32, I3 = 16 * 32, I4 = 16 * 64, I5 = 16 * 32, I6 = 16 * 2, I7 = 16 * 32, I8 = 4 * 32, I9 = 16 * 32, I10 = 8 * 32;
    constexpr int E0 = 2 * I0, E1 = E0 + 2 * I1, E2 = E1 + 2 * I2, E3 = E2 + 2 * I3, E4 = E3 + 2 * I4, E5 = E4 + 2 * I5, E6 = E5 + 4 * I6, E7 = E6 + 4 * I7, E8 = E7 + 4 * I8,
                  E9 = E8 + 128 * I9, E10 = E9 + 128 * I10;
    for (int it = gw; it < E10; it += NGW) {
        const int nl = lane & 31;
        if (it < E0) {
            const int j = it / I0, r = it % I0, kb = r / 72, nb = r % 72, np = nb * 32 + nl;
            int n;
            if (np < 1920) n = np; else if (np < 1952) { const int q = np - 1920; n = 2176 + (q & 1) * 16 + (q >> 1); } else if (np < 2048) n = -1; else n = 1920 + (np - 2048);
            const float* base = C.in[5] + (size_t)j * D * EIN;
            conv_item(n >= 0 ? base + n : nullptr, EIN, C.in[3] + (2 * j) * D, WSP(bf16_t, WS_WINE) + (size_t)j * EINP * D, D, kb * 64, nb * 32, scr, lane);
        } else if (it < E1) {
            const int r0 = it - E0, j = r0 / I1, r = r0 % I1, kb = r / 24, nb = r % 24, np = nb * 32 + nl;
            const int hd = np / 96, dd = np % 96; int n = np;
            if (dd >= 64) { const int q = dd - 64; n = hd * 96 + 64 + (q & 1) * 16 + (q >> 1); }
            conv_item(C.in[8] + (size_t)j * QR * 768 + n, 768, C.in[7] + j * QR, WSP(bf16_t, WS_WQ) + (size_t)j * 768 * QR, QR, kb * 64, nb * 32, scr, lane);
        } else if (it < E2) {
            const int r0 = it - E1, j = r0 / I2, r = r0 % I2, kb = r / 32, nb = r % 32, np = nb * 32 + nl;
            conv_item(C.in[10] + (size_t)j * KVR * 1024 + np, 1024, C.in[9] + j * KVR, WSP(bf16_t, WS_WKV) + (size_t)j * 1024 * KVR, KVR, kb * 64, nb * 32, scr, lane);
        } else if (it < E3) {
            const int r0 = it - E2, j = r0 / I3, r = r0 % I3, kb = r / 32, nb = r % 32, np = nb * 32 + nl;
            conv_item(C.in[11] + (size_t)j * D * D + np, D, nullptr, WSP(bf16_t, WS_WOE) + (size_t)j * D * D, D, kb * 64, nb * 32, scr, lane);
        } else if (it < E4) {
            const int r0 = it - E3, j = r0 / I4, r = r0 % I4, kb = r / 64, nb = r % 64, np = nb * 32 + nl;
            conv_item(C.in[12] + (size_t)j * D * 2048 + np, 2048, C.in[3] + (2 * j + 1) * D, WSP(bf16_t, WS_WINO) + (size_t)j * 2048 * D, D, kb * 64, nb * 32, scr, lane);
        } else if (it < E5) {
            const int r0 = it - E4, j = r0 / I5, r = r0 % I5, kb = r / 32, nb = r % 32, np = nb * 32 + nl;
            conv_item(C.in[16] + (size_t)j * D * D + np, D, nullptr, WSP(bf16_t, WS_WOO) + (size_t)j * D * D, D, kb * 64, nb * 32, scr, lane);
        } else if (it < E6) {
            const int r0 = it - E5, l = r0 / I6, r = r0 % I6, kb = r / 2, nb = r % 2, np = nb * 32 + nl;
            const float* cp = nullptr; int ld = 4;
            if (np < 4) { cp = C.in[17] + (size_t)l * D * 4 + np; ld = 4; } else if (np < 36) { cp = C.in[18] + (size_t)l * D * 32 + (np - 4); ld = 32; }
            conv_item(cp, ld, C.in[4] + l * D, WSP(bf16_t, WS_WR) + (size_t)l * 64 * D, D, kb * 64, nb * 32, scr, lane);
        } else if (it < E7) {
            const int r0 = it - E6, l = r0 / I7, r = r0 % I7, kb = r / 32, nb = r % 32, np = nb * 32 + nl;
            conv_item(C.in[23] + (size_t)l * D * D + np, D, C.in[22] + l * D, WSP(bf16_t, WS_WG) + (size_t)l * D * D, D, kb * 64, nb * 32, scr, lane);
        } else if (it < E8) {
            const int r0 = it - E7, l = r0 / I8, r = r0 % I8, kb = r / 32, nb = r % 32, np = nb * 32 + nl;
            conv_item(C.in[24] + (size_t)l * PLE * D + np, D, nullptr, WSP(bf16_t, WS_WP) + (size_t)l * D * PLE, PLE, kb * 64, nb * 32, scr, lane);
        } else if (it < E9) {
            const int r0 = it - E8, m = r0 / I9, r = r0 % I9, kb = r / 32, nb = r % 32, np = nb * 32 + nl;
            const int l = m >> 5, blk = np >> 3, rr = np & 7;
            const float* cp = (rr < 4) ? C.in[19] + (size_t)m * D * DEXP + blk * 4 + rr : C.in[20] + (size_t)m * D * DEXP + blk * 4 + (rr - 4);
            conv_item(cp, DEXP, C.in[4] + l * D, WSP(bf16_t, WS_WGU) + (size_t)m * D * D, D, kb * 64, nb * 32, scr, lane);
        } else {
            const int r0 = it - E9, m = r0 / I10, r = r0 % I10, kb = r / 32, nb = r % 32, np = nb * 32 + nl;
            conv_item(C.in[21] + (size_t)m * DEXP * D + np, D, nullptr, WSP(bf16_t, WS_WDN) + (size_t)m * D * DEXP, DEXP, kb * 64, nb * 32, scr, lane);
        }
    }
    {
        float* H = WSP(float, WS_H); bf16_t* HB = WSP(bf16_t, WS_HB0); float* SS = WSP(float, WS_SSQ0);
        for (int m = gw; m < T; m += NGW) {
            const f32x4* xr = (const f32x4*)(C.in[0] + (size_t)m * D) + lane; f32x4* hr = (f32x4*)(H + (size_t)m * D) + lane;
            u32x2* ob = (u32x2*)(HB + (size_t)m * D) + lane; float s = 0.f;
#pragma unroll
            for (int j = 0; j < 4; ++j) { const f32x4 v = xr[64 * j]; hr[64 * j] = v; s += (v.x * v.x + v.y * v.y) + (v.z * v.z + v.w * v.w); u32x2 o; o.x = pk2(v.x, v.y); o.y = pk2(v.z, v.w); ob[64 * j] = o; }
            s = wave_sum(s);
            if (lane < 16) SS[m * 16 + lane] = (lane == 0) ? s : 0.f;
        }
    }
    {
        const size_t n8 = (size_t)DEPTH * T * PLE / 8; const size_t gt = (size_t)C.bid * NTHREADS + C.tid, NGT = (size_t)C.nblk * NTHREADS;
        const f32x4* src = (const f32x4*)C.in[1]; u32x4* dst = WSP(u32x4, WS_PB);
        for (size_t i = gt; i < n8; i += NGT) { const f32x4 a = src[2 * i], b = src[2 * i + 1]; u32x4 o; o.x = pk2(a.x, a.y); o.y = pk2(a.z, a.w); o.z = pk2(b.x, b.y); o.w = pk2(b.z, b.w); dst[i] = o; }
    }
    {
        const int gt = C.bid * NTHREADS + C.tid, NGT = C.nblk * NTHREADS; const int* pos = (const int*)C.in[2]; float* R = WSP(float, WS_ROPE);
        for (int i = gt; i < T * 16; i += NGT) {
            const int t = i >> 4, f = i & 15;
            const int q = f & 3; double inv = (q == 0) ? 1.0 : (q == 1) ? 0.5623413251903491 : (q == 2) ? 0.31622776601683794 : 0.17782794100389228;
            const int dec = f >> 2; inv *= (dec == 0) ? 1.0 : (dec == 1) ? 0.1 : (dec == 2) ? 0.01 : 0.001;
            const double ang = (double)pos[t] * inv;
            const double n = __builtin_rint(ang * 0.15915494309189535);
            const double r = ang - n * 6.283185307179586, r2 = r * r;
            double sn = r, cs = 1.0, ts = r, tc = 1.0;
#pragma unroll
            for (int k = 1; k <= 13; ++k) { tc *= -r2 / (double)((2 * k - 1) * (2 * k)); cs += tc; ts *= -r2 / (double)((2 * k) * (2 * k + 1)); sn += ts; }
            R[2 * i] = (float)cs; R[2 * i + 1] = (float)sn;
        }
    }
    {
        const int gt = C.bid * NTHREADS + C.tid, NGT = C.nblk * NTHREADS; const float* src = C.in[14]; bf16_t* dst = WSP(bf16_t, WS_WS);
        for (int i = gt; i < 2 * 8 * 128 * 128; i += NGT) { const int s = i & 127, t = (i >> 7) & 127; dst[i] = (bf16_t)((s <= t) ? f2bf(src[i]) : 0u); }
    }
}

template <class RM, class Epi>
__device__ __forceinline__ void gemm_naive(Ctx& C, int N, int K, const RM& rm, const Epi& epi) {
    LAS float* As = (LAS float*)C.lds;
    LAS float* Bs = As + 32 * 132;
    const int tid = C.tid, ty = tid >> 4, tx = tid & 15;
    const int nct = N / 128, nunits = rm.ntiles128() * nct;
    for (int u = C.bid; u < nunits; u += C.nblk) {
        const int mt = u / nct, nt = u % nct, row0 = mt * 128, col0 = nt * 128;
        const bf16_t* Bt = rm.bt(row0);
        float acc[4][8];
#pragma unroll
        for (int i = 0; i < 4; ++i)
#pragma unroll
            for (int j = 0; j < 8; ++j) acc[i][j] = 0.f;
        const int lr = tid >> 2, kc = (tid & 3) * 8;
        const bf16_t* ap = rm.arow(row0 + lr);
        const bf16_t* bp = Bt + (size_t)(col0 + lr) * K;
        for (int k0 = 0; k0 < K; k0 += 32) {
            float av[8], bv[8];
            if (ap) { const u32x4 w = *(const u32x4*)(ap + k0 + kc); unpack8(w, av); } else {
#pragma unroll
                for (int i = 0; i < 8; ++i) av[i] = 0.f; }
            { const u32x4 w = *(const u32x4*)(bp + k0 + kc); unpack8(w, bv); }
            __syncthreads();
#pragma unroll
            for (int i = 0; i < 8; ++i) { As[(kc + i) * 132 + lr] = av[i]; Bs[(kc + i) * 132 + lr] = bv[i]; }
            __syncthreads();
#pragma unroll 4
            for (int k = 0; k < 32; ++k) {
                const f32x4 a = *(const LAS f32x4*)(As + k * 132 + ty * 4);
                const f32x4 b0 = *(const LAS f32x4*)(Bs + k * 132 + tx * 8), b1 = *(const LAS f32x4*)(Bs + k * 132 + tx * 8 + 4);
                const float aa[4] = {a.x, a.y, a.z, a.w}; const float bb[8] = {b0.x, b0.y, b0.z, b0.w, b1.x, b1.y, b1.z, b1.w};
#pragma unroll
                for (int i = 0; i < 4; ++i)
#pragma unroll
                    for (int j = 0; j < 8; ++j) acc[i][j] += aa[i] * bb[j];
            }
        }
#pragma unroll
        for (int i = 0; i < 4; ++i) {
            const int srow = row0 + ty * 4 + i;
            const typename Epi::Row rw = epi.row(srow);
            float ss = epi(srow, col0 + tx * 8, acc[i], rw);
            ss += __shfl_xor(ss, 1); ss += __shfl_xor(ss, 2); ss += __shfl_xor(ss, 4);
            if ((tx & 7) == 0) epi.rowsum(srow, (col0 + tx * 8) >> 6, ss);
        }
    }
    __syncthreads();
}

struct DenseRM {
    const bf16_t* A; const bf16_t* Bt; int K;
    __device__ __forceinline__ int ntiles128() const { return T / 128; }
    __device__ __forceinline__ const bf16_t* arow(int r) const { return A + (size_t)r * K; }
    __device__ __forceinline__ const bf16_t* bt(int) const { return Bt; }
};
struct MoeTab { LAS int* ebase; LAS int* tile2e; LAS int* ecnt; };
__device__ __forceinline__ MoeTab moe_tables(Ctx& C, int layer) {
    MoeTab mt; mt.ebase = (LAS int*)(C.lds + LDS_MISC - 2048); mt.tile2e = mt.ebase + 64; mt.ecnt = mt.tile2e + 192;
    __syncthreads();
    if (C.tid == 0) {
        const unsigned* cnt = WSP(unsigned, WS_CTL) + CW_CNT + layer * 64; int b = 0;
        for (int e = 0; e < NEXP; ++e) { const int c = (int)__hip_atomic_load(cnt + e, __ATOMIC_RELAXED, __HIP_MEMORY_SCOPE_AGENT); mt.ecnt[e] = c; mt.ebase[e] = b; const int nt = (c + 255) >> 8;
            for (int t = 0; t < nt; ++t) mt.tile2e[b + t] = e; b += nt; }
        mt.ebase[NEXP] = b;
    }
    __syncthreads();
    return mt;
}
struct MoeRow { int e, pos, tok; };
__device__ __forceinline__ MoeRow moe_row(const MoeTab& mt, const int* list, int srow) {
    MoeRow r; const int t256 = srow >> 8; r.e = mt.tile2e[t256]; r.pos = (t256 - mt.ebase[r.e]) * 256 + (srow & 255);
    r.tok = (r.pos < mt.ecnt[r.e]) ? list[r.e * T + r.pos] : -1; return r;
}
struct MoeGatherRM {
    MoeTab mt; const int* list; const bf16_t* HB; const bf16_t* W;
    __device__ __forceinline__ int ntiles128() const { return mt.ebase[NEXP] * 2; }
    __device__ __forceinline__ const bf16_t* arow(int r) const { const MoeRow m = moe_row(mt, list, r); return m.tok >= 0 ? HB + (size_t)m.tok * D : nullptr; }
    __device__ __forceinline__ const bf16_t* bt(int r0) const { return W + (size_t)mt.tile2e[r0 >> 8] * D * D; }
};
struct MoeDownRM {
    MoeTab mt; const bf16_t* ACT; const bf16_t* W;
    __device__ __forceinline__ int ntiles128() const { return mt.ebase[NEXP] * 2; }
    __device__ __forceinline__ const bf16_t* arow(int r) const { return ACT + (size_t)r * DEXP; }
    __device__ __forceinline__ const bf16_t* bt(int r0) const { return W + (size_t)mt.tile2e[r0 >> 8] * D * DEXP; }
};

__device__ __forceinline__ float rs_from(const float* ss, int n, float inv_n) { float s = 0.f; for (int i = 0; i < n; ++i) s += ss[i]; return rsqrtf(s * inv_n + EPS); }
struct RowS { float s; };
struct EpiE1 {
    const float* ssq_h; bf16_t* P3; bf16_t* CQ; bf16_t* CKV; bf16_t* KPE; float* ssqx; const float* rope;
    typedef RowS Row;
    __device__ __forceinline__ Row row(int r) const { Row w; w.s = rs_from(ssq_h + r * 16, 16, 1.f / D); return w; }
    __device__ __forceinline__ float operator()(int r, int col, const float* v, const Row& w) const {
        float x[8];
#pragma unroll
        for (int i = 0; i < 8; ++i) x[i] = v[i] * w.s;
        float ss = 0.f;
        if (col < 1536) { *(u32x4*)(P3 + (size_t)r * 1536 + col) = pack8(x); }
        else if (col < 1920) { *(u32x4*)(CQ + (size_t)r * QR + (col - 1536)) = pack8(x);
#pragma unroll
            for (int i = 0; i < 8; ++i) ss += x[i] * x[i]; }
        else if (col < 1952) { const int f0 = (col - 1920) >> 1; float o[8];
#pragma unroll
            for (int i = 0; i < 4; ++i) { const float c = rope[(r * 16 + f0 + i) * 2], s = rope[(r * 16 + f0 + i) * 2 + 1]; o[2 * i] = x[2 * i] * c - x[2 * i + 1] * s; o[2 * i + 1] = x[2 * i + 1] * c + x[2 * i] * s; }
            *(u32x4*)(KPE + (size_t)r * 32 + (col - 1920)) = pack8(o); }
        else if (col < 2048) { }
        else { *(u32x4*)(CKV + (size_t)r * KVR + (col - 2048)) = pack8(x);
#pragma unroll
            for (int i = 0; i < 8; ++i) ss += x[i] * x[i]; }
        return ss;
    }
    __device__ __forceinline__ void rowsum(int r, int slot, float ss) const { ssqx[r * 36 + slot] = ss; }
};
struct EpiQ {
    const float* ssqx; bf16_t* Q; const float* rope;
    typedef RowS Row;
    __device__ __forceinline__ Row row(int r) const { Row w; w.s = rs_from(ssqx + r * 36 + 24, 8, 1.f / QR) * QSCALE; return w; }
    __device__ __forceinline__ float operator()(int r, int col, const float* v, const Row& w) const {
        float x[8];
#pragma unroll
        for (int i = 0; i < 8; ++i) x[i] = v[i] * w.s;
        const int dd = col % 96;
        if (dd >= 64) { const int f0 = (dd - 64) >> 1; float o[8];
#pragma unroll
            for (int i = 0; i < 4; ++i) { const float c = rope[(r * 16 + f0 + i) * 2], s = rope[(r * 16 + f0 + i) * 2 + 1]; o[2 * i] = x[2 * i] * c - x[2 * i + 1] * s; o[2 * i + 1] = x[2 * i + 1] * c + x[2 * i] * s; }
            *(u32x4*)(Q + (size_t)r * 768 + col) = pack8(o);
        } else *(u32x4*)(Q + (size_t)r * 768 + col) = pack8(x);
        return 0.f;
    }
    __device__ __forceinline__ void rowsum(int, int, float) const {}
};
struct EpiKV {
    const float* ssqx; bf16_t* KV;
    typedef RowS Row;
    __device__ __forceinline__ Row row(int r) const { Row w; w.s = rs_from(ssqx + r * 36 + 32, 4, 1.f / KVR); return w; }
    __device__ __forceinline__ float operator()(int r, int col, const float* v, const Row& w) const {
        float x[8];
#pragma unroll
        for (int i = 0; i < 8; ++i) x[i] = v[i] * w.s;
        *(u32x4*)(KV + (size_t)r * 1024 + col) = pack8(x); return 0.f;
    }
    __device__ __forceinline__ void rowsum(int, int, float) const {}
};
struct EpiRes {
    float* H; bf16_t* HB; float* ssq;
    typedef RowS Row;
    __device__ __forceinline__ Row row(int) const { Row w; w.s = 1.f; return w; }
    __device__ __forceinline__ float operator()(int r, int col, const float* v, const Row&) const {
        f32x4* hp = (f32x4*)(H + (size_t)r * D + col); const f32x4 a = hp[0], b = hp[1];
        float x[8] = {a.x + v[0], a.y + v[1], a.z + v[2], a.w + v[3], b.x + v[4], b.y + v[5], b.z + v[6], b.w + v[7]};
        hp[0] = (f32x4){x[0], x[1], x[2], x[3]}; hp[1] = (f32x4){x[4], x[5], x[6], x[7]};
        *(u32x4*)(HB + (size_t)r * D + col) = pack8(x);
        float ss = 0.f;
#pragma unroll
        for (int i = 0; i < 8; ++i) ss += x[i] * x[i];
        return ss;
    }
    __device__ __forceinline__ void rowsum(int r, int slot, float ss) const { ssq[r * 16 + slot] = ss; }
};
struct EpiGelu {
    const float* ssq_h; bf16_t* Z; float* ssqx;
    typedef RowS Row;
    __device__ __forceinline__ Row row(int r) const { Row w; w.s = rs_from(ssq_h + r * 16, 16, 1.f / D); return w; }
    __device__ __forceinline__ float operator()(int r, int col, const float* v, const Row& w) const {
        float x[8]; float ss = 0.f;
#pragma unroll
        for (int i = 0; i < 8; ++i) { x[i] = gelu_tanh(v[i] * w.s); ss += x[i] * x[i]; }
        *(u32x4*)(Z + (size_t)r * 2048 + col) = pack8(x);
        return col >= 1024 ? ss : 0.f;
    }
    __device__ __forceinline__ void rowsum(int r, int slot, float ss) const { ssqx[r * 36 + slot] = ss; }
};
struct RowM { float s; int ok; };
struct EpiGU {
    MoeTab mt; const int* list; const float* rffn; bf16_t* ACT;
    typedef RowM Row;
    __device__ __forceinline__ Row row(int r) const { const MoeRow m = moe_row(mt, list, r); Row w; w.ok = m.tok >= 0; w.s = w.ok ? rffn[m.tok] : 0.f; return w; }
    __device__ __forceinline__ float operator()(int r, int col, const float* v, const Row& w) const {
        float a[4];
#pragma unroll
        for (int i = 0; i < 4; ++i) { const float g = v[i] * w.s, u = v[4 + i] * w.s; a[i] = g * sigmoidf_(g) * u; }
        u32x2 o; o.x = pk2(a[0], a[1]); o.y = pk2(a[2], a[3]);
        *(u32x2*)(ACT + (size_t)r * DEXP + (col >> 1)) = o;
        return 0.f;
    }
    __device__ __forceinline__ void rowsum(int, int, float) const {}
};
struct EpiDown {
    MoeTab mt; const int* list; const float* lw; bf16_t* Y;
    typedef RowM Row;
    __device__ __forceinline__ Row row(int r) const { const MoeRow m = moe_row(mt, list, r); Row w; w.ok = m.tok >= 0; w.s = w.ok ? lw[m.e * T + m.pos] : 0.f; return w; }
    __device__ __forceinline__ float operator()(int r, int col, const float* v, const Row& w) const {
        if (w.ok) { float x[8];
#pragma unroll
            for (int i = 0; i < 8; ++i) x[i] = v[i] * w.s;
            *(u32x4*)(Y + (size_t)r * D + col) = pack8(x); }
        return 0.f;
    }
    __device__ __forceinline__ void rowsum(int, int, float) const {}
};
struct EpiPP {
    bf16_t* PP;
    typedef RowS Row;
    __device__ __forceinline__ Row row(int) const { Row w; w.s = 1.f; return w; }
    __device__ __forceinline__ float operator()(int r, int col, const float* v, const Row&) const { *(u32x4*)(PP + (size_t)r * D + col) = pack8(v); return 0.f; }
    __device__ __forceinline__ void rowsum(int, int, float) const {}
};
struct EpiPLE {
    const float* ssq_in; const bf16_t* PP; float* H; bf16_t* HB; float* ssq;
    typedef RowS Row;
    __device__ __forceinline__ Row row(int r) const { Row w; w.s = rs_from(ssq_in + r * 16, 16, 1.f / D); return w; }
    __device__ __forceinline__ float operator()(int r, int col, const float* v, const Row& w) const {
        float pp[8]; unpack8(*(const u32x4*)(PP + (size_t)r * D + col), pp);
        f32x4* hp = (f32x4*)(H + (size_t)r * D + col); const f32x4 a = hp[0], b = hp[1];
        const float h0[8] = {a.x, a.y, a.z, a.w, b.x, b.y, b.z, b.w};
        float x[8]; float ss = 0.f;
#pragma unroll
        for (int i = 0; i < 8; ++i) { x[i] = h0[i] + sigmoidf_(v[i] * w.s) * pp[i]; ss += x[i] * x[i]; }
        hp[0] = (f32x4){x[0], x[1], x[2], x[3]}; hp[1] = (f32x4){x[4], x[5], x[6], x[7]};
        *(u32x4*)(HB + (size_t)r * D + col) = pack8(x);
        return ss;
    }
    __device__ __forceinline__ void rowsum(int r, int slot, float ss) const { ssq[r * 16 + slot] = ss; }
};

__device__ __forceinline__ void phase_conv(Ctx& C, int j) {
    const bf16_t* P3 = WSP(bf16_t, WS_P3); bf16_t* MIX = WSP(bf16_t, WS_MIX); const float* cw = C.in[6] + (size_t)j * 3 * 512;
    const int gt = C.bid * NTHREADS + C.tid, NGT = C.nblk * NTHREADS;
    for (int i = gt; i < T * 64; i += NGT) {
        const int t = i >> 6, c = (i & 63) * 8, s = t & (SEQ - 1);
        float acc[8];
#pragma unroll
        for (int q = 0; q < 8; ++q) acc[q] = 0.f;
#pragma unroll
        for (int k = 0; k < 3; ++k) {
            const int dt = 2 - k;
            if (s - dt >= 0) {
                float xc[8], gc[8]; unpack8(*(const u32x4*)(P3 + (size_t)(t - dt) * 1536 + c), xc); unpack8(*(const u32x4*)(P3 + (size_t)(t - dt) * 1536 + 1024 + c), gc);
#pragma unroll
                for (int q = 0; q < 8; ++q) acc[q] += cw[k * 512 + c + q] * (gc[q] * xc[q]);
            }
        }
        float gb[8]; unpack8(*(const u32x4*)(P3 + (size_t)t * 1536 + 512 + c), gb);
#pragma unroll
        for (int q = 0; q < 8; ++q) acc[q] *= gb[q];
        *(u32x4*)(MIX + (size_t)t * D + c) = pack8(acc);
    }
}

__device__ __forceinline__ void phase_attn_naive(Ctx& C) {
    const bf16_t* Q = WSP(bf16_t, WS_Q); const bf16_t* KV = WSP(bf16_t, WS_KV); const bf16_t* KPE = WSP(bf16_t, WS_KPE); bf16_t* MIX = WSP(bf16_t, WS_MIX);
    LAS float* Ks = (LAS float*)C.lds;
    LAS float* Vs = Ks + 64 * 97;
    LAS float* Qs = Vs + 64 * 64;
    LAS float* Ps = Qs + 64 * 96;
    const int tid = C.tid, lane = C.lane, wave = C.wave;
    const int nunits = NBATCH * NH * (SEQ / 64);
    for (int u = C.bid; u < nunits; u += C.nblk) {
        const int qb = (SEQ / 64 - 1) - (u / (NBATCH * NH)), bh = u % (NBATCH * NH), b = bh / NH, h = bh % NH;
        const int t0 = b * SEQ + qb * 64;
        __syncthreads();
        for (int i = tid; i < 64 * 12; i += NTHREADS) { const int r = i / 12, c8 = (i % 12) * 8; float v[8]; unpack8(*(const u32x4*)(Q + (size_t)(t0 + r) * 768 + h * 96 + c8), v);
#pragma unroll
            for (int q = 0; q < 8; ++q) Qs[r * 96 + c8 + q] = v[q]; }
        float m[8], l[8], o[8];
#pragma unroll
        for (int i = 0; i < 8; ++i) { m[i] = -1e30f; l[i] = 0.f; o[i] = 0.f; }
        for (int kt = 0; kt <= qb; ++kt) {
            const int k0 = b * SEQ + kt * 64;
            __syncthreads();
            for (int i = tid; i < 64 * 20; i += NTHREADS) { const int r = i / 20, c = i % 20; float v[8];
                if (c < 8) { unpack8(*(const u32x4*)(KV + (size_t)(k0 + r) * 1024 + h * 128 + c * 8), v);
#pragma unroll
                    for (int q = 0; q < 8; ++q) Ks[r * 97 + c * 8 + q] = v[q]; }
                else if (c < 12) { unpack8(*(const u32x4*)(KPE + (size_t)(k0 + r) * 32 + (c - 8) * 8), v);
#pragma unroll
                    for (int q = 0; q < 8; ++q) Ks[r * 97 + c * 8 + q] = v[q]; }
                else { unpack8(*(const u32x4*)(KV + (size_t)(k0 + r) * 1024 + h * 128 + 64 + (c - 12) * 8), v);
#pragma unroll
                    for (int q = 0; q < 8; ++q) Vs[r * 64 + (c - 12) * 8 + q] = v[q]; } }
            __syncthreads();
#pragma unroll
            for (int qi = 0; qi < 8; ++qi) {
                const int qr = wave * 8 + qi;
                float s = 0.f;
                for (int d = 0; d < 96; ++d) s += Qs[qr * 96 + d] * Ks[lane * 97 + d];
                if (kt == qb && lane > qr) s = -1e30f;
                const float mn = fmaxf(m[qi], wave_max(s));
                const float p = exp2f(s - mn), al = exp2f(m[qi] - mn);
                const float pb = rbf(p);
                l[qi] = l[qi] * al + wave_sum(p); m[qi] = mn;
                Ps[wave * 64 + lane] = pb;
                asm volatile("s_waitcnt lgkmcnt(0)" ::: "memory");
                float acc = 0.f;
                for (int k = 0; k < 64; ++k) acc += Ps[wave * 64 + k] * Vs[k * 64 + lane];
                o[qi] = o[qi] * al + acc;
                asm volatile("s_waitcnt lgkmcnt(0)" ::: "memory");
            }
        }
#pragma unroll
        for (int qi = 0; qi < 8; ++qi) MIX[(size_t)(t0 + wave * 8 + qi) * D + 512 + h * 64 + lane] = (bf16_t)f2bf(o[qi] / l[qi]);
    }
    __syncthreads();
}

__device__ __forceinline__ void phase_sg_naive(Ctx& C, int j) {
    const bf16_t* Z = WSP(bf16_t, WS_Z); const float* ssqx = WSP(float, WS_SSQX); const bf16_t* WS = WSP(bf16_t, WS_WS) + (size_t)j * 8 * 128 * 128; bf16_t* MIX = WSP(bf16_t, WS_MIX);
    const float* vg = C.in[13] + j * D; const float* bs = C.in[15] + (size_t)j * 8 * 128;
    LAS float* Wt = (LAS float*)C.lds;
    LAS float* Vn = Wt + 128 * 129;
    const int tid = C.tid;
    for (int u = C.bid; u < NBATCH * 32 * 8; u += C.nblk) {
        const int g = u & 7, bc = u >> 3, t0 = bc * 128;
        __syncthreads();
        for (int i = tid; i < 128 * 16; i += NTHREADS) { const int r = i >> 4, c8 = (i & 15) * 8; float v[8];
            unpack8(*(const u32x4*)(WS + (size_t)g * 16384 + r * 128 + c8), v);
#pragma unroll
            for (int q = 0; q < 8; ++q) Wt[r * 129 + c8 + q] = v[q];
            unpack8(*(const u32x4*)(Z + (size_t)(t0 + r) * 2048 + 1024 + g * 128 + c8), v);
            const float rv = rs_from(ssqx + (t0 + r) * 36 + 16, 16, 1.f / 1024);
#pragma unroll
            for (int q = 0; q < 8; ++q) Vn[r * 128 + c8 + q] = rbf(v[q] * rv * vg[g * 128 + c8 + q]); }
        __syncthreads();
        const int t = tid >> 2, d0 = (tid & 3) * 32;
        float acc[32];
#pragma unroll
        for (int i = 0; i < 32; ++i) acc[i] = 0.f;
        for (int s = 0; s <= t; ++s) { const float w = Wt[t * 129 + s];
#pragma unroll
            for (int i = 0; i < 32; ++i) acc[i] += w * Vn[s * 128 + d0 + i]; }
        const float bias = bs[g * 128 + t];
#pragma unroll
        for (int i8 = 0; i8 < 4; ++i8) { float uu[8], o[8]; unpack8(*(const u32x4*)(Z + (size_t)(t0 + t) * 2048 + g * 128 + d0 + i8 * 8), uu);
#pragma unroll
            for (int q = 0; q < 8; ++q) o[q] = uu[q] * (acc[i8 * 8 + q] + bias);
            *(u32x4*)(MIX + (size_t)(t0 + t) * D + g * 128 + d0 + i8 * 8) = pack8(o); }
    }
    __syncthreads();
}

__device__ __forceinline__ void phase_router(Ctx& C, int layer) {
    const bf16_t* HB = WSP(bf16_t, WS_HB0); const float* ssq = WSP(float, WS_SSQ0); const bf16_t* WR = WSP(bf16_t, WS_WR) + (size_t)layer * 64 * D;
    int* tok_e = WSP(int, WS_TOK); int* tok_pos = tok_e + 2 * T; float* rffn = (float*)(tok_pos + 2 * T);
    int* list = WSP(int, WS_LIST); float* lw = WSP(float, WS_LW); unsigned* cnt = WSP(unsigned, WS_CTL) + CW_CNT + layer * 64;
    LAS u32x4* Wl = (LAS u32x4*)C.lds;
    const int lane = C.lane;
    __syncthreads();
    for (int i = C.tid; i < 36 * 128; i += NTHREADS) Wl[i] = *(const u32x4*)(WR + (size_t)i * 8);
    __syncthreads();
    const int gw = C.bid * NWAVES + C.wave, NGW = C.nblk * NWAVES;
    for (int m = gw; m < T; m += NGW) {
        const float r = rs_from(ssq + m * 16, 16, 1.f / D);
        float x0[8], x1[8];
        unpack8(*(const u32x4*)(HB + (size_t)m * D + lane * 8), x0); unpack8(*(const u32x4*)(HB + (size_t)m * D + 512 + lane * 8), x1);
        LAS float* lgs = (LAS float*)(C.lds + 36 * 128 * 16) + C.wave * 64;
#pragma unroll 2
        for (int n = 0; n < 36; ++n) {
            float w0[8], w1[8]; unpack8(Wl[n * 128 + lane], w0); unpack8(Wl[n * 128 + 64 + lane], w1);
            float s = 0.f;
#pragma unroll
            for (int i = 0; i < 8; ++i) s += x0[i] * w0[i] + x1[i] * w1[i];
            s = wave_sum(s) * r;
            if (lane == 0) lgs[n] = s;
        }
        asm volatile("s_waitcnt lgkmcnt(0)" ::: "memory");
        const float g0 = lgs[0], g1 = lgs[1], g2 = lgs[2], g3 = lgs[3];
        int g = 0; float gm = g0;
        if (g1 > gm) { gm = g1; g = 1; }
        if (g2 > gm) { gm = g2; g = 2; }
        if (g3 > gm) { gm = g3; g = 3; }
        const float gs = __expf(g0 - gm) + __expf(g1 - gm) + __expf(g2 - gm) + __expf(g3 - gm);
        const float gw_ = 1.0f / gs;
        float el[8];
#pragma unroll
        for (int q = 0; q < 8; ++q) el[q] = lgs[4 + g * 8 + q];
        asm volatile("s_waitcnt lgkmcnt(0)" ::: "memory");
        int i1 = 0; float m1 = el[0];
#pragma unroll
        for (int q = 1; q < 8; ++q) if (el[q] > m1) { m1 = el[q]; i1 = q; }
        int i2 = -1; float m2 = -3.0e38f;
#pragma unroll
        for (int q = 0; q < 8; ++q) if (q != i1 && el[q] > m2) { m2 = el[q]; i2 = q; }
        const float e2 = __expf(m2 - m1), p1 = 1.0f / (1.0f + e2), p2 = e2 / (1.0f + e2);
        if (lane == 0) {
            rffn[m] = r;
            const int ea = g * 8 + i1, eb = g * 8 + i2;
            const int pa = (int)atomicAdd(cnt + ea, 1u), pb = (int)atomicAdd(cnt + eb, 1u);
            list[ea * T + pa] = m; lw[ea * T + pa] = gw_ * p1; list[eb * T + pb] = m; lw[eb * T + pb] = gw_ * p2;
            tok_e[2 * m] = ea; tok_e[2 * m + 1] = eb; tok_pos[2 * m] = pa; tok_pos[2 * m + 1] = pb;
        }
    }
    __syncthreads();
}

__device__ __forceinline__ void phase_combine(Ctx& C, int layer) {
    const MoeTab mt = moe_tables(C, layer);
    float* H = WSP(float, WS_H); bf16_t* HB = WSP(bf16_t, WS_HB1); float* SS = WSP(float, WS_SSQ1); const bf16_t* Y = WSP(bf16_t, WS_Y);
    const int* tok_e = WSP(int, WS_TOK); const int* tok_pos = tok_e + 2 * T;
    const int gw = C.bid * NWAVES + C.wave, NGW = C.nblk * NWAVES, lane = C.lane;
    for (int m = gw; m < T; m += NGW) {
        const int ea = tok_e[2 * m], eb = tok_e[2 * m + 1];
        const size_t sa = (size_t)mt.ebase[ea] * 256 + tok_pos[2 * m], sb = (size_t)mt.ebase[eb] * 256 + tok_pos[2 * m + 1];
        f32x4* hr = (f32x4*)(H + (size_t)m * D) + lane; const u32x2* ya = (const u32x2*)(Y + sa * D) + lane; const u32x2* yb = (const u32x2*)(Y + sb * D) + lane;
        u32x2* ob = (u32x2*)(HB + (size_t)m * D) + lane; float s = 0.f;
#pragma unroll
        for (int j = 0; j < 4; ++j) {
            f32x4 v = hr[64 * j]; const u32x2 a = ya[64 * j], b = yb[64 * j];
            v.x += bf2f(a.x & 0xffffu) + bf2f(b.x & 0xffffu); v.y += bf2f(a.x >> 16) + bf2f(b.x >> 16); v.z += bf2f(a.y & 0xffffu) + bf2f(b.y & 0xffffu); v.w += bf2f(a.y >> 16) + bf2f(b.y >> 16);
            hr[64 * j] = v; s += (v.x * v.x + v.y * v.y) + (v.z * v.z + v.w * v.w); u32x2 o; o.x = pk2(v.x, v.y); o.y = pk2(v.z, v.w); ob[64 * j] = o;
        }
        s = wave_sum(s);
        if (lane < 16) SS[m * 16 + lane] = (lane == 0) ? s : 0.f;
    }
    __syncthreads();
}

__device__ __forceinline__ void phase_final(Ctx& C) {
    const float* H = WSP(float, WS_H); const float* SS = WSP(float, WS_SSQ0); const float* g = C.in[25];
    const int gw = C.bid * NWAVES + C.wave, NGW = C.nblk * NWAVES, lane = C.lane;
    for (int m = gw; m < T; m += NGW) {
        const float r = rs_from(SS + m * 16, 16, 1.f / D);
        const f32x4* hr = (const f32x4*)(H + (size_t)m * D) + lane; f32x4* o = (f32x4*)(C.out + (size_t)m * D) + lane; const f32x4* gg = (const f32x4*)g + lane;
#pragma unroll
        for (int j = 0; j < 4; ++j) { const f32x4 v = hr[64 * j], w = gg[64 * j]; o[64 * j] = (f32x4){v.x * r * w.x, v.y * r * w.y, v.z * r * w.z, v.w * r * w.w}; }
    }
}

constexpr int NPHASES = 42;
__device__ __forceinline__ void run_phase(Ctx& C, int ph) {
    if (ph == 0) { phase_prologue(C); return; }
    if (ph == NPHASES - 1) { phase_final(C); return; }
    const int layer = (ph - 1) / 10, sub = (ph - 1) % 10, j = layer >> 1; const bool even = (layer & 1) == 0;
    float* H = WSP(float, WS_H); bf16_t* HB0 = WSP(bf16_t, WS_HB0); bf16_t* HB1 = WSP(bf16_t, WS_HB1); float* SSQ0 = WSP(float, WS_SSQ0); float* SSQ1 = WSP(float, WS_SSQ1); float* SSQX = WSP(float, WS_SSQX);
    const float* ROPE = WSP(float, WS_ROPE); bf16_t* MIX = WSP(bf16_t, WS_MIX);
    switch (sub) {
    case 0:
        if (even) { DenseRM rm{HB0, WSP(bf16_t, WS_WINE) + (size_t)j * EINP * D, D}; EpiE1 e{SSQ0, WSP(bf16_t, WS_P3), WSP(bf16_t, WS_CQ), WSP(bf16_t, WS_CKV), WSP(bf16_t, WS_KPE), SSQX, ROPE}; gemm_naive(C, EINP, D, rm, e); }
        else { DenseRM rm{HB0, WSP(bf16_t, WS_WINO) + (size_t)j * 2048 * D, D}; EpiGelu e{SSQ0, WSP(bf16_t, WS_Z), SSQX}; gemm_naive(C, 2048, D, rm, e); }
        break;
    case 1:
        if (even) {
            { DenseRM rm{WSP(bf16_t, WS_CQ), WSP(bf16_t, WS_WQ) + (size_t)j * 768 * QR, QR}; EpiQ e{SSQX, WSP(bf16_t, WS_Q), ROPE}; gemm_naive(C, 768, QR, rm, e); }
            { DenseRM rm{WSP(bf16_t, WS_CKV), WSP(bf16_t, WS_WKV) + (size_t)j * 1024 * KVR, KVR}; EpiKV e{SSQX, WSP(bf16_t, WS_KV)}; gemm_naive(C, 1024, KVR, rm, e); }
            phase_conv(C, j);
        } else phase_sg_naive(C, j);
        break;
    case 2:
        if (even) phase_attn_naive(C);
        break;
    case 3: {
        DenseRM rm{MIX, (even ? WSP(bf16_t, WS_WOE) : WSP(bf16_t, WS_WOO)) + (size_t)j * D * D, D}; EpiRes e{H, HB0, SSQ0}; gemm_naive(C, D, D, rm, e);
        break; }
    case 4: phase_router(C, layer); break;
    case 5: { const MoeTab mt = moe_tables(C, layer); const int* tok_e = WSP(int, WS_TOK);
        MoeGatherRM rm{mt, WSP(int, WS_LIST), HB0, WSP(bf16_t, WS_WGU) + (size_t)layer * NEXP * D * D}; EpiGU e{mt, WSP(int, WS_LIST), (const float*)(tok_e + 4 * T), WSP(bf16_t, WS_ACT)}; gemm_naive(C, D, D, rm, e);
        break; }
    case 6: { const MoeTab mt = moe_tables(C, layer);
        MoeDownRM rm{mt, WSP(bf16_t, WS_ACT), WSP(bf16_t, WS_WDN) + (size_t)layer * NEXP * D * DEXP}; EpiDown e{mt, WSP(int, WS_LIST), WSP(float, WS_LW), WSP(bf16_t, WS_Y)}; gemm_naive(C, D, DEXP, rm, e);
        break; }
    case 7: phase_combine(C, layer); break;
    case 8: { DenseRM rm{WSP(bf16_t, WS_PB) + (size_t)layer * T * PLE, WSP(bf16_t, WS_WP) + (size_t)layer * D * PLE, PLE}; EpiPP e{WSP(bf16_t, WS_PP)}; gemm_naive(C, D, PLE, rm, e); break; }
    case 9: { DenseRM rm{HB1, WSP(bf16_t, WS_WG) + (size_t)layer * D * D, D}; EpiPLE e{SSQ1, WSP(bf16_t, WS_PP), H, HB0, SSQ0}; gemm_naive(C, D, D, rm, e); break; }
    }
}
__host__ __device__ inline bool phase_is_nop(int ph) { if (ph == 0 || ph == NPHASES - 1) return false; const int layer = (ph - 1) / 10, sub = (ph - 1) % 10; return (layer & 1) && sub == 2; }

__global__ void __launch_bounds__(NTHREADS, 2) fwd_kernel(Args args) {
    extern __shared__ __attribute__((aligned(16))) unsigned char lds_raw[];
    Ctx C;
    C.lds = (LAS unsigned char*)lds_raw;
    C.tid = threadIdx.x; C.lane = C.tid & 63; C.wave = __builtin_amdgcn_readfirstlane(C.tid >> 6);
    C.bid = blockIdx.x; C.nblk = gridDim.x;
#pragma unroll
    for (int i = 0; i < 26; ++i) C.in[i] = args.in[i];
    C.out = args.out; C.ws = args.ws;
    volatile LAS unsigned* misc = (volatile LAS unsigned*)(C.lds + LDS_MISC);
    if (C.tid < 64) misc[C.tid] = 0u;
    __syncthreads();
#if MEGA
    XcdBarrier bar = xcd_barrier_post(WSP(unsigned, WS_CTL) + CW_BAR, misc + 8);
#endif
    for (int ph = args.ph_lo; ph < args.ph_hi; ++ph) {
        if (phase_is_nop(ph)) continue;
        run_phase(C, ph);
#if MEGA
        if (ph + 1 < args.ph_hi) xcd_barrier(bar);
#endif
    }
}

extern "C" void kernel_launch(void* const* d_in, const int* in_sizes, int n_in, void* d_out, int out_size, void* d_ws, size_t ws_size, hipStream_t stream) {
    static int grid = 0;
    if (grid == 0) {
        if (n_in != 26 || out_size != T * D || ws_size < WS_END) { fprintf(stderr, "kernel_launch: unexpected shapes (n_in %d out %d ws %zu)\n", n_in, out_size, ws_size); grid = -1; return; }
        int dev = 0, cus = 0;
        if (hipGetDevice(&dev) != hipSuccess || hipDeviceGetAttribute(&cus, hipDeviceAttributeMultiprocessorCount, dev) != hipSuccess) { grid = -1; return; }
        if (hipFuncSetAttribute((const void*)fwd_kernel, hipFuncAttributeMaxDynamicSharedMemorySize, LDS_BYTES) != hipSuccess) { fprintf(stderr, "kernel_launch: hipFuncSetAttribute failed\n"); grid = -1; return; }
        grid = cus;
    }
    if (grid < 0) return;
    (void)hipMemsetAsync((char*)d_ws + WS_CTL, 0, CTL_ZERO_BYTES, stream);
    Args a{};
    for (int i = 0; i < 26; ++i) a.in[i] = (const float*)d_in[i];
    a.out = (float*)d_out; a.ws = (unsigned char*)d_ws;
#if MEGA
    a.ph_lo = 0; a.ph_hi = NPHASES;
    hipLaunchKernelGGL(fwd_kernel, dim3(grid), dim3(NTHREADS), LDS_BYTES, stream, a);
#else
    for (int ph = 0; ph < NPHASES; ++ph) {
        if (phase_is_nop(ph)) continue;
        a.ph_lo = ph; a.ph_hi = ph + 1;
        hipLaunchKernelGGL(fwd_kernel, dim3(grid), dim3(NTHREADS), LDS_BYTES, stream, a);
    }
#endif
}
```

```cpp
#include <hip/hip_runtime.h>
#include <cstdio>
#include <cstdint>

#ifndef MEGA
#define MEGA 1
#endif

#define LAS __attribute__((address_space(3)))
#define GAS __attribute__((address_space(1)))
typedef unsigned short bf16_t;
typedef float f32x4 __attribute__((ext_vector_type(4)));
typedef unsigned u32x4 __attribute__((ext_vector_type(4)));
typedef unsigned u32x2 __attribute__((ext_vector_type(2)));
typedef short bf16x8 __attribute__((ext_vector_type(8)));

constexpr int T = 16384, D = 1024, SEQ = 4096, NBATCH = 4, DEPTH = 4;
constexpr int EIN = 2208, EINP = 2304;
constexpr int NH = 8, DQK = 96, DV = 64;
constexpr int QR = 384, KVR = 256;
constexpr int NEXP = 32, DEXP = 512;
constexpr int PLE = 256;
constexpr float EPS = 1e-6f;
constexpr int NWAVES = 8, NTHREADS = 512;
constexpr int MOE_ROWS = 40960;
constexpr float QSCALE = 0.10206207261596577f * 1.4426950408889634f;

constexpr size_t MiB = 1u << 20;
constexpr size_t WS_CTL = 0, CTL_ZERO_BYTES = 1 * MiB;
constexpr size_t WS_WINE = 1 * MiB;
constexpr size_t WS_WQ = 10 * MiB;
constexpr size_t WS_WKV = 12 * MiB;
constexpr size_t WS_WOE = 13 * MiB;
constexpr size_t WS_WINO = 17 * MiB;
constexpr size_t WS_WOO = 25 * MiB;
constexpr size_t WS_WS = 29 * MiB;
constexpr size_t WS_WR = 30 * MiB;
constexpr size_t WS_WG = 31 * MiB;
constexpr size_t WS_WP = 39 * MiB;
constexpr size_t WS_WGU = 41 * MiB;
constexpr size_t WS_WDN = 297 * MiB;
constexpr size_t WS_H = 425 * MiB;
constexpr size_t WS_HB0 = 489 * MiB;
constexpr size_t WS_HB1 = 521 * MiB;
constexpr size_t WS_SSQ0 = 553 * MiB;
constexpr size_t WS_SSQ1 = 554 * MiB;
constexpr size_t WS_SSQX = 555 * MiB;
constexpr size_t WS_ROPE = 558 * MiB;
constexpr size_t WS_PB = 560 * MiB;
constexpr size_t WS_P3 = 592 * MiB;
constexpr size_t WS_CQ = 640 * MiB;
constexpr size_t WS_CKV = 652 * MiB;
constexpr size_t WS_KPE = 660 * MiB;
constexpr size_t WS_Z = 592 * MiB;
constexpr size_t WS_Q = 661 * MiB;
constexpr size_t WS_KV = 685 * MiB;
constexpr size_t WS_MIX = 717 * MiB;
constexpr size_t WS_LIST = 749 * MiB;
constexpr size_t WS_LW = 751 * MiB;
constexpr size_t WS_TOK = 753 * MiB;
constexpr size_t WS_ACT = 754 * MiB;
constexpr size_t WS_Y = 794 * MiB;
constexpr size_t WS_PP = 874 * MiB;
constexpr size_t WS_END = 906 * MiB;

constexpr int CW_CNT = 64;
constexpr int CW_BAR = 4096;

constexpr int LDS_BYTES = 147456;
constexpr int LDS_MISC = LDS_BYTES - 256;

__device__ __forceinline__ float bf2f(unsigned b) { return __uint_as_float(b << 16); }
__device__ __forceinline__ unsigned f2bf(float f) { unsigned u = __float_as_uint(f); return (u + 0x7fffu + ((u >> 16) & 1u)) >> 16; }
__device__ __forceinline__ unsigned pk2(float lo, float hi) { return f2bf(lo) | (f2bf(hi) << 16); }
__device__ __forceinline__ void unpack8(const u32x4 w, float* v) {
    v[0] = __uint_as_float(w.x << 16); v[1] = __uint_as_float(w.x & 0xffff0000u);
    v[2] = __uint_as_float(w.y << 16); v[3] = __uint_as_float(w.y & 0xffff0000u);
    v[4] = __uint_as_float(w.z << 16); v[5] = __uint_as_float(w.z & 0xffff0000u);
    v[6] = __uint_as_float(w.w << 16); v[7] = __uint_as_float(w.w & 0xffff0000u);
}
__device__ __forceinline__ u32x4 pack8(const float* v) { u32x4 w; w.x = pk2(v[0], v[1]); w.y = pk2(v[2], v[3]); w.z = pk2(v[4], v[5]); w.w = pk2(v[6], v[7]); return w; }
__device__ __forceinline__ float rbf(float f) { return bf2f(f2bf(f)); }
__device__ __forceinline__ float wave_sum(float v) {
#pragma unroll
    for (int o = 1; o < 64; o <<= 1) v += __shfl_xor(v, o);
    return v;
}
__device__ __forceinline__ float wave_max(float v) {
#pragma unroll
    for (int o = 1; o < 64; o <<= 1) v = fmaxf(v, __shfl_xor(v, o));
    return v;
}
__device__ __forceinline__ float sigmoidf_(float x) { return 1.0f / (1.0f + __expf(-x)); }
__device__ __forceinline__ float gelu_tanh(float x) {
    const float u = 0.7978845608028654f * (x + 0.044715f * x * x * x);
    const float e = __expf(2.0f * u);
    const float th = 1.0f - 2.0f / (e + 1.0f);
    return 0.5f * x * (1.0f + th);
}

#define XB_TMO      128
#define XB_XCNT(j)  (256  + 64 * (j))
#define XB_XSUB(j)  (1280 + 64 * (j))
#define XB_XGEN(j)  (2304 + 64 * (j))
#define XB_TOP      3328
#define XB_TOPGEN   3392
#define XCD_BAR_WORDS 3456
#define XB_SPIN_CAP (1u << 22)
__device__ __forceinline__ unsigned xb_ld(unsigned* p)              { return __hip_atomic_load(p, __ATOMIC_RELAXED, __HIP_MEMORY_SCOPE_AGENT); }
__device__ __forceinline__ unsigned xb_add(unsigned* p, unsigned v) { return __hip_atomic_fetch_add(p, v, __ATOMIC_RELAXED, __HIP_MEMORY_SCOPE_AGENT); }
__device__ __forceinline__ unsigned xb_xcc_id() { return (unsigned)__builtin_amdgcn_s_getreg((3 << 11) | 20) & 0xFu; }
#define XB_SPIN(cond, bar) do { unsigned _sp = 0; while (cond) { __builtin_amdgcn_s_sleep(1); \
    if ((++_sp & 255u) == 0u) { if (xb_ld(&(bar)[XB_TMO])) break; if (_sp > XB_SPIN_CAP) { atomicAdd(&(bar)[XB_TMO], 1u); break; } } } } while (0)
struct XcdBarrier { unsigned* bar; unsigned x; volatile LAS unsigned* st; };
__device__ __forceinline__ XcdBarrier xcd_barrier_post(unsigned* bar, volatile LAS unsigned* st) {
    XcdBarrier b; b.bar = bar; b.x = xb_xcc_id(); b.st = st;
    if (threadIdx.x == 0) (void)xb_add(&bar[XB_XCNT(b.x)], 1u);
    return b;
}
__device__ __forceinline__ void xcd_barrier_complete(unsigned* bar, unsigned x, unsigned& nloc, unsigned& nx) {
    const unsigned G = gridDim.x * gridDim.y * gridDim.z;
    unsigned sum, cnt, mine, sp = 0u;
    for (;;) {
        sum = 0u; cnt = 0u; mine = 0u;
#pragma unroll
        for (unsigned j = 0; j < 16; ++j) { const unsigned c = xb_ld(&bar[XB_XCNT(j)]); sum += c; cnt += (c > 0u) ? 1u : 0u; mine = (j == x) ? c : mine; }
        if (sum == G) break;
        __builtin_amdgcn_s_sleep(1);
        if ((++sp & 255u) == 0u) { if (xb_ld(&bar[XB_TMO])) break; if (sp > XB_SPIN_CAP) { atomicAdd(&bar[XB_TMO], 1u); break; } }
    }
    nloc = mine > 0u ? mine : 1u; nx = cnt > 0u ? cnt : 1u;
}
__device__ __forceinline__ void xcd_barrier(const XcdBarrier& b) {
    asm volatile("s_waitcnt vmcnt(0)" ::: "memory");
    __syncthreads();
    if (threadIdx.x == 0) {
        unsigned* bar = b.bar;
        __builtin_amdgcn_s_waitcnt(0);
        unsigned nloc = b.st[0], nx = b.st[1];
        if (nloc == 0u) { xcd_barrier_complete(bar, b.x, nloc, nx); b.st[0] = nloc; b.st[1] = nx; }
        const unsigned old = xb_add(&bar[XB_XSUB(b.x)], 1u);
        const unsigned gen = old / nloc;
        if (old + 1u == (gen + 1u) * nloc) {
            __builtin_amdgcn_fence(__ATOMIC_RELEASE, "agent");
            asm volatile("s_waitcnt vmcnt(0)" ::: "memory");
            const unsigned og = xb_add(&bar[XB_TOP], 1u);
            const unsigned tg = og / nx;
            if (og + 1u == (tg + 1u) * nx) xb_add(&bar[XB_TOPGEN], 1u);
            else XB_SPIN(xb_ld(&bar[XB_TOPGEN]) == tg, bar);
            __builtin_amdgcn_fence(__ATOMIC_ACQUIRE, "agent");
            xb_add(&bar[XB_XGEN(b.x)], 1u);
            asm volatile("s_waitcnt vmcnt(0)" ::: "memory");
        } else {
            XB_SPIN(xb_ld(&bar[XB_XGEN(b.x)]) == gen, bar);
            __builtin_amdgcn_fence(__ATOMIC_ACQUIRE, "agent");
            asm volatile("s_waitcnt vmcnt(0)" ::: "memory");
        }
    }
    __syncthreads();
}

struct Args { const float* in[26]; float* out; unsigned char* ws; int ph_lo, ph_hi; };
struct Ctx {
    LAS unsigned char* lds;
    const float* in[26]; float* out; unsigned char* ws;
    int tid, lane, wave, bid, nblk;
};
#define WSP(T_, off) ((T_*)(C.ws + (off)))

__device__ __forceinline__ void conv_item(const float* colp, int ldw, const float* gain, bf16_t* WT, int K, int k0, int n0, LAS float* scr, int lane) {
#pragma unroll 8
    for (int i = 0; i < 32; ++i) {
        const int kk = 2 * i + (lane >> 5);
        float v = colp ? colp[(size_t)(k0 + kk) * ldw] : 0.f;
        if (gain) v *= gain[k0 + kk];
        scr[kk * 33 + (lane & 31)] = v;
    }
    asm volatile("s_waitcnt lgkmcnt(0)" ::: "memory");
    const int c = lane & 7;
#pragma unroll
    for (int j = 0; j < 4; ++j) {
        const int n = (lane >> 3) + 8 * j; const LAS float* s = scr + (8 * c) * 33 + n;
        u32x4 o; o.x = pk2(s[0 * 33], s[1 * 33]); o.y = pk2(s[2 * 33], s[3 * 33]); o.z = pk2(s[4 * 33], s[5 * 33]); o.w = pk2(s[6 * 33], s[7 * 33]);
        *(u32x4*)(WT + (size_t)(n0 + n) * K + k0 + 8 * c) = o;
    }
    asm volatile("s_waitcnt lgkmcnt(0)" ::: "memory");
}

__device__ __forceinline__ void phase_prologue(Ctx& C) {
    LAS float* scr = (LAS float*)(C.lds + C.wave * 16384);
    const int gw = C.bid * NWAVES + C.wave, NGW = C.nblk * NWAVES, lane = C.lane;
    constexpr int I0 = 16 * 72, I1 = 6 * 24, I2 = 4 * 32, I3 = 16 * 32, I4 = 16 * 64, I5 = 16 * 32, I6 = 16 * 2, I7 = 16 * 32, I8 = 4 * 32, I9 = 16 * 32, I10 = 8 * 32;
    constexpr int E0 = 2 * I0, E1 = E0 + 2 * I1, E2 = E1 + 2 * I2, E3 = E2 + 2 * I3, E4 = E3 + 2 * I4, E5 = E4 + 2 * I5, E6 = E5 + 4 * I6, E7 = E6 + 4 * I7, E8 = E7 + 4 * I8,
                  E9 = E8 + 128 * I9, E10 = E9 + 128 * I10;
    for (int it = gw; it < E10; it += NGW) {
        const int nl = lane & 31;
        if (it < E0) {
            const int j = it / I0, r = it % I0, kb = r / 72, nb = r % 72, np = nb * 32 + nl;
            int n;
            if (np < 1920) n = np; else if (np < 1952) { const int q = np - 1920; n = 2176 + (q & 1) * 16 + (q >> 1); } else if (np < 2048) n = -1; else n = 1920 + (np - 2048);
            const float* base = C.in[5] + (size_t)j * D * EIN;
            conv_item(n >= 0 ? base + n : nullptr, EIN, C.in[3] + (2 * j) * D, WSP(bf16_t, WS_WINE) + (size_t)j * EINP * D, D, kb * 64, nb * 32, scr, lane);
        } else if (it < E1) {
            const int r0 = it - E0, j = r0 / I1, r = r0 % I1, kb = r / 24, nb = r % 24, np = nb * 32 + nl;
            const int hd = np / 96, dd = np % 96; int n = np;
            if (dd >= 64) { const int q = dd - 64; n = hd * 96 + 64 + (q & 1) * 16 + (q >> 1); }
            conv_item(C.in[8] + (size_t)j * QR * 768 + n, 768, C.in[7] + j * QR, WSP(bf16_t, WS_WQ) + (size_t)j * 768 * QR, QR, kb * 64, nb * 32, scr, lane);
        } else if (it < E2) {
            const int r0 = it - E1, j = r0 / I2, r = r0 % I2, kb = r / 32, nb = r % 32, np = nb * 32 + nl;
            conv_item(C.in[10] + (size_t)j * KVR * 1024 + np, 1024, C.in[9] + j * KVR, WSP(bf16_t, WS_WKV) + (size_t)j * 1024 * KVR, KVR, kb * 64, nb * 32, scr, lane);
        } else if (it < E3) {
            const int r0 = it - E2, j = r0 / I3, r = r0 % I3, kb = r / 32, nb = r % 32, np = nb * 32 + nl;
            conv_item(C.in[11] + (size_t)j * D * D + np, D, nullptr, WSP(bf16_t, WS_WOE) + (size_t)j * D * D, D, kb * 64, nb * 32, scr, lane);
        } else if (it < E4) {
            const int r0 = it - E3, j = r0 / I4, r = r0 % I4, kb = r / 64, nb = r % 64, np = nb * 32 + nl;
            conv_item(C.in[12] + (size_t)j * D * 2048 + np, 2048, C.in[3] + (2 * j + 1) * D, WSP(bf16_t, WS_WINO) + (size_t)j * 2048 * D, D, kb * 64, nb * 32, scr, lane);
        } else if (it < E5) {
            const int r0 = it - E4, j = r0 / I5, r = r0 % I5, kb = r / 32, nb = r % 32, np = nb * 32 + nl;
            conv_item(C.in[16] + (size_t)j * D * D + np, D, nullptr, WSP(bf16_t, WS_WOO) + (size_t)j * D * D, D, kb * 64, nb * 32, scr, lane);
        } else if (it < E6) {
            const int r0 = it - E5, l = r0 / I6, r = r0 % I6, kb = r / 2, nb = r % 2, np = nb * 32 + nl;
            const float* cp = nullptr; int ld = 4;
            if (np < 4) { cp = C.in[17] + (size_t)l * D * 4 + np; ld = 4; } else if (np < 36) { cp = C.in[18] + (size_t)l * D * 32 + (np - 4); ld = 32; }
            conv_item(cp, ld, C.in[4] + l * D, WSP(bf16_t, WS_WR) + (size_t)l * 64 * D, D, kb * 64, nb * 32, scr, lane);
        } else if (it < E7) {
            const int r0 = it - E6, l = r0 / I7, r = r0 % I7, kb = r / 32, nb = r % 32, np = nb * 32 + nl;
            conv_item(C.in[23] + (size_t)l * D * D + np, D, C.in[22] + l * D, WSP(bf16_t, WS_WG) + (size_t)l * D * D, D, kb * 64, nb * 32, scr, lane);
        } else if (it < E8) {
            const int r0 = it - E7, l = r0 / I8, r = r0 % I8, kb = r / 32, nb = r % 32, np = nb * 32 + nl;
            conv_item(C.in[24] + (size_t)l * PLE * D + np, D, nullptr, WSP(bf16_t, WS_WP) + (size_t)l * D * PLE, PLE, kb * 64, nb * 32, scr, lane);
        } else if (it < E9) {
            const int r0 = it - E8, m = r0 / I9, r = r0 % I9, kb = r / 32, nb = r % 32, np = nb * 32 + nl;
            const int l = m >> 5, blk = np >> 3, rr = np & 7;
            const float* cp = (rr < 4) ? C.in[19] + (size_t)m * D * DEXP + blk * 4 + rr : C.in[20] + (size_t)m * D * DEXP + blk * 4 + (rr - 4);
            conv_item(cp, DEXP, C.in[4] + l * D, WSP(bf16_t, WS_WGU) + (size_t)m * D * D, D, kb * 64, nb * 32, scr, lane);
        } else {
            const int r0 = it - E9, m = r0 / I10, r = r0 % I10, kb = r / 32, nb = r % 32, np = nb * 32 + nl;
            conv_item(C.in[21] + (size_t)m * DEXP * D + np, D, nullptr, WSP(bf16_t, WS_WDN) + (size_t)m * D * DEXP, DEXP, kb * 64, nb * 32, scr, lane);
        }
    }
    {
        float* H = WSP(float, WS_H); bf16_t* HB = WSP(bf16_t, WS_HB0); float* SS = WSP(float, WS_SSQ0);
        for (int m = gw; m < T; m += NGW) {
            const f32x4* xr = (const f32x4*)(C.in[0] + (size_t)m * D) + lane; f32x4* hr = (f32x4*)(H + (size_t)m * D) + lane;
            u32x2* ob = (u32x2*)(HB + (size_t)m * D) + lane; float s = 0.f;
#pragma unroll
            for (int j = 0; j < 4; ++j) { const f32x4 v = xr[64 * j]; hr[64 * j] = v; s += (v.x * v.x + v.y * v.y) + (v.z * v.z + v.w * v.w); u32x2 o; o.x = pk2(v.x, v.y); o.y = pk2(v.z, v.w); ob[64 * j] = o; }
            s = wave_sum(s);
            if (lane < 16) SS[m * 16 + lane] = (lane == 0) ? s : 0.f;
        }
    }
    {
        const size_t n8 = (size_t)DEPTH * T * PLE / 8; const size_t gt = (size_t)C.bid * NTHREADS + C.tid, NGT = (size_t)C.nblk * NTHREADS;
        const f32x4* src = (const f32x4*)C.in[1]; u32x4* dst = WSP(u32x4, WS_PB);
        for (size_t i = gt; i < n8; i += NGT) { const f32x4 a = src[2 * i], b = src[2 * i + 1]; u32x4 o; o.x = pk2(a.x, a.y); o.y = pk2(a.z, a.w); o.z = pk2(b.x, b.y); o.w = pk2(b.z, b.w); dst[i] = o; }
    }
    {
        const int gt = C.bid * NTHREADS + C.tid, NGT = C.nblk * NTHREADS; const int* pos = (const int*)C.in[2]; float* R = WSP(float, WS_ROPE);
        for (int i = gt; i < T * 16; i += NGT) {
            const int t = i >> 4, f = i & 15;
            const int q = f & 3; double inv = (q == 0) ? 1.0 : (q == 1) ? 0.5623413251903491 : (q == 2) ? 0.31622776601683794 : 0.17782794100389228;
            const int dec = f >> 2; inv *= (dec == 0) ? 1.0 : (dec == 1) ? 0.1 : (dec == 2) ? 0.01 : 0.001;
            const double ang = (double)pos[t] * inv;
            const double n = __builtin_rint(ang * 0.15915494309189535);
            const double r = ang - n * 6.283185307179586, r2 = r * r;
            double sn = r, cs = 1.0, ts = r, tc = 1.0;
#pragma unroll
            for (int k = 1; k <= 13; ++k) { tc *= -r2 / (double)((2 * k - 1) * (2 * k)); cs += tc; ts *= -r2 / (double)((2 * k) * (2 * k + 1)); sn += ts; }
            R[2 * i] = (float)cs; R[2 * i + 1] = (float)sn;
        }
    }
    {
        const int gt = C.bid * NTHREADS + C.tid, NGT = C.nblk * NTHREADS; const float* src = C.in[14]; bf16_t* dst = WSP(bf16_t, WS_WS);
        for (int i = gt; i < 2 * 8 * 128 * 128; i += NGT) { const int s = i & 127, t = (i >> 7) & 127; dst[i] = (bf16_t)((s <= t) ? f2bf(src[i]) : 0u); }
    }
}

template <class RM, class Epi>
__device__ __forceinline__ void gemm_naive(Ctx& C, int N, int K, const RM& rm, const Epi& epi) {
    LAS float* As = (LAS float*)C.lds;
    LAS float* Bs = As + 32 * 132;
    const int tid = C.tid, ty = tid >> 4, tx = tid & 15;
    const int nct = N / 128, nunits = rm.ntiles128() * nct;
    for (int u = C.bid; u < nunits; u += C.nblk) {
        const int mt = u / nct, nt = u % nct, row0 = mt * 128, col0 = nt * 128;
        const bf16_t* Bt = rm.bt(row0);
        float acc[4][8];
#pragma unroll
        for (int i = 0; i < 4; ++i)
#pragma unroll
            for (int j = 0; j < 8; ++j) acc[i][j] = 0.f;
        const int lr = tid >> 2, kc = (tid & 3) * 8;
        const bf16_t* ap = rm.arow(row0 + lr);
        const bf16_t* bp = Bt + (size_t)(col0 + lr) * K;
        for (int k0 = 0; k0 < K; k0 += 32) {
            float av[8], bv[8];
            if (ap) { const u32x4 w = *(const u32x4*)(ap + k0 + kc); unpack8(w, av); } else {
#pragma unroll
                for (int i = 0; i < 8; ++i) av[i] = 0.f; }
            { const u32x4 w = *(const u32x4*)(bp + k0 + kc); unpack8(w, bv); }
            __syncthreads();
#pragma unroll
            for (int i = 0; i < 8; ++i) { As[(kc + i) * 132 + lr] = av[i]; Bs[(kc + i) * 132 + lr] = bv[i]; }
            __syncthreads();
#pragma unroll 4
            for (int k = 0; k < 32; ++k) {
                const f32x4 a = *(const LAS f32x4*)(As + k * 132 + ty * 4);
                const f32x4 b0 = *(const LAS f32x4*)(Bs + k * 132 + tx * 8), b1 = *(const LAS f32x4*)(Bs + k * 132 + tx * 8 + 4);
                const float aa[4] = {a.x, a.y, a.z, a.w}; const float bb[8] = {b0.x, b0.y, b0.z, b0.w, b1.x, b1.y, b1.z, b1.w};
#pragma unroll
                for (int i = 0; i < 4; ++i)
#pragma unroll
                    for (int j = 0; j < 8; ++j) acc[i][j] += aa[i] * bb[j];
            }
        }
#pragma unroll
        for (int i = 0; i < 4; ++i) {
            const int srow = row0 + ty * 4 + i;
            const typename Epi::Row rw = epi.row(srow);
            float ss = epi(srow, col0 + tx * 8, acc[i], rw);
            ss += __shfl_xor(ss, 1); ss += __shfl_xor(ss, 2); ss += __shfl_xor(ss, 4);
            if ((tx & 7) == 0) epi.rowsum(srow, (col0 + tx * 8) >> 6, ss);
        }
    }
    __syncthreads();
}

struct DenseRM {
    const bf16_t* A; const bf16_t* Bt; int K;
    __device__ __forceinline__ int ntiles128() const { return T / 128; }
    __device__ __forceinline__ const bf16_t* arow(int r) const { return A + (size_t)r * K; }
    __device__ __forceinline__ const bf16_t* bt(int) const { return Bt; }
};
struct MoeTab { LAS int* ebase; LAS int* tile2e; LAS int* ecnt; };
__device__ __forceinline__ MoeTab moe_tables(Ctx& C, int layer) {
    MoeTab mt; mt.ebase = (LAS int*)(C.lds + LDS_MISC - 2048); mt.tile2e = mt.ebase + 64; mt.ecnt = mt.tile2e + 192;
    __syncthreads();
    if (C.tid == 0) {
        const unsigned* cnt = WSP(unsigned, WS_CTL) + CW_CNT + layer * 64; int b = 0;
        for (int e = 0; e < NEXP; ++e) { const int c = (int)__hip_atomic_load(cnt + e, __ATOMIC_RELAXED, __HIP_MEMORY_SCOPE_AGENT); mt.ecnt[e] = c; mt.ebase[e] = b; const int nt = (c + 255) >> 8;
            for (int t = 0; t < nt; ++t) mt.tile2e[b + t] = e; b += nt; }
        mt.ebase[NEXP] = b;
    }
    __syncthreads();
    return mt;
}
struct MoeRow { int e, pos, tok; };
__device__ __forceinline__ MoeRow moe_row(const MoeTab& mt, const int* list, int srow) {
    MoeRow r; const int t256 = srow >> 8; r.e = mt.tile2e[t256]; r.pos = (t256 - mt.ebase[r.e]) * 256 + (srow & 255);
    r.tok = (r.pos < mt.ecnt[r.e]) ? list[r.e * T + r.pos] : -1; return r;
}
struct MoeGatherRM {
    MoeTab mt; const int* list; const bf16_t* HB; const bf16_t* W;
    __device__ __forceinline__ int ntiles128() const { return mt.ebase[NEXP] * 2; }
    __device__ __forceinline__ const bf16_t* arow(int r) const { const MoeRow m = moe_row(mt, list, r); return m.tok >= 0 ? HB + (size_t)m.tok * D : nullptr; }
    __device__ __forceinline__ const bf16_t* bt(int r0) const { return W + (size_t)mt.tile2e[r0 >> 8] * D * D; }
};
struct MoeDownRM {
    MoeTab mt; const bf16_t* ACT; const bf16_t* W;
    __device__ __forceinline__ int ntiles128() const { return mt.ebase[NEXP] * 2; }
    __device__ __forceinline__ const bf16_t* arow(int r) const { return ACT + (size_t)r * DEXP; }
    __device__ __forceinline__ const bf16_t* bt(int r0) const { return W + (size_t)mt.tile2e[r0 >> 8] * D * DEXP; }
};

__device__ __forceinline__ float rs_from(const float* ss, int n, float inv_n) { float s = 0.f; for (int i = 0; i < n; ++i) s += ss[i]; return rsqrtf(s * inv_n + EPS); }
struct RowS { float s; };
struct EpiE1 {
    const float* ssq_h; bf16_t* P3; bf16_t* CQ; bf16_t* CKV; bf16_t* KPE; float* ssqx; const float* rope;
    typedef RowS Row;
    __device__ __forceinline__ Row row(int r) const { Row w; w.s = rs_from(ssq_h + r * 16, 16, 1.f / D); return w; }
    __device__ __forceinline__ float operator()(int r, int col, const float* v, const Row& w) const {
        float x[8];
#pragma unroll
        for (int i = 0; i < 8; ++i) x[i] = v[i] * w.s;
        float ss = 0.f;
        if (col < 1536) { *(u32x4*)(P3 + (size_t)r * 1536 + col) = pack8(x); }
        else if (col < 1920) { *(u32x4*)(CQ + (size_t)r * QR + (col - 1536)) = pack8(x);
#pragma unroll
            for (int i = 0; i < 8; ++i) ss += x[i] * x[i]; }
        else if (col < 1952) { const int f0 = (col - 1920) >> 1; float o[8];
#pragma unroll
            for (int i = 0; i < 4; ++i) { const float c = rope[(r * 16 + f0 + i) * 2], s = rope[(r * 16 + f0 + i) * 2 + 1]; o[2 * i] = x[2 * i] * c - x[2 * i + 1] * s; o[2 * i + 1] = x[2 * i + 1] * c + x[2 * i] * s; }
            *(u32x4*)(KPE + (size_t)r * 32 + (col - 1920)) = pack8(o); }
        else if (col < 2048) { }
        else { *(u32x4*)(CKV + (size_t)r * KVR + (col - 2048)) = pack8(x);
#pragma unroll
            for (int i = 0; i < 8; ++i) ss += x[i] * x[i]; }
        return ss;
    }
    __device__ __forceinline__ void rowsum(int r, int slot, float ss) const { ssqx[r * 36 + slot] = ss; }
};
struct EpiQ {
    const float* ssqx; bf16_t* Q; const float* rope;
    typedef RowS Row;
    __device__ __forceinline__ Row row(int r) const { Row w; w.s = rs_from(ssqx + r * 36 + 24, 8, 1.f / QR) * QSCALE; return w; }
    __device__ __forceinline__ float operator()(int r, int col, const float* v, const Row& w) const {
        float x[8];
#pragma unroll
        for (int i = 0; i < 8; ++i) x[i] = v[i] * w.s;
        const int dd = col % 96;
        if (dd >= 64) { const int f0 = (dd - 64) >> 1; float o[8];
#pragma unroll
            for (int i = 0; i < 4; ++i) { const float c = rope[(r * 16 + f0 + i) * 2], s = rope[(r * 16 + f0 + i) * 2 + 1]; o[2 * i] = x[2 * i] * c - x[2 * i + 1] * s; o[2 * i + 1] = x[2 * i + 1] * c + x[2 * i] * s; }
            *(u32x4*)(Q + (size_t)r * 768 + col) = pack8(o);
        } else *(u32x4*)(Q + (size_t)r * 768 + col) = pack8(x);
        return 0.f;
    }
    __device__ __forceinline__ void rowsum(int, int, float) const {}
};
struct EpiKV {
    const float* ssqx; bf16_t* KV;
    typedef RowS Row;
    __device__ __forceinline__ Row row(int r) const { Row w; w.s = rs_from(ssqx + r * 36 + 32, 4, 1.f / KVR); return w; }
    __device__ __forceinline__ float operator()(int r, int col, const float* v, const Row& w) const {
        float x[8];
#pragma unroll
        for (int i = 0; i < 8; ++i) x[i] = v[i] * w.s;
        *(u32x4*)(KV + (size_t)r * 1024 + col) = pack8(x); return 0.f;
    }
    __device__ __forceinline__ void rowsum(int, int, float) const {}
};
struct EpiRes {
    float* H; bf16_t* HB; float* ssq;
    typedef RowS Row;
    __device__ __forceinline__ Row row(int) const { Row w; w.s = 1.f; return w; }
    __device__ __forceinline__ float operator()(int r, int col, const float* v, const Row&) const {
        f32x4* hp = (f32x4*)(H + (size_t)r * D + col); const f32x4 a = hp[0], b = hp[1];
        float x[8] = {a.x + v[0], a.y + v[1], a.z + v[2], a.w + v[3], b.x + v[4], b.y + v[5], b.z + v[6], b.w + v[7]};
        hp[0] = (f32x4){x[0], x[1], x[2], x[3]}; hp[1] = (f32x4){x[4], x[5], x[6], x[7]};
        *(u32x4*)(HB + (size_t)r * D + col) = pack8(x);
        float ss = 0.f;
#pragma unroll
        for (int i = 0; i < 8; ++i) ss += x[i] * x[i];
        return ss;
    }
    __device__ __forceinline__ void rowsum(int r, int slot, float ss) const { ssq[r * 16 + slot] = ss; }
};
struct EpiGelu {
    const float* ssq_h; bf16_t* Z; float* ssqx;
    typedef RowS Row;
    __device__ __forceinline__ Row row(int r) const { Row w; w.s = rs_from(ssq_h + r * 16, 16, 1.f / D); return w; }
    __device__ __forceinline__ float operator()(int r, int col, const float* v, const Row& w) const {
        float x[8]; float ss = 0.f;
#pragma unroll
        for (int i = 0; i < 8; ++i) { x[i] = gelu_tanh(v[i] * w.s); ss += x[i] * x[i]; }
        *(u32x4*)(Z + (size_t)r * 2048 + col) = pack8(x);
        return col >= 1024 ? ss : 0.f;
    }
    __device__ __forceinline__ void rowsum(int r, int slot, float ss) const { ssqx[r * 36 + slot] = ss; }
};
struct RowM { float s; int ok; };
struct EpiGU {
    MoeTab mt; const int* list; const float* rffn; bf16_t* ACT;
    typedef RowM Row;
    __device__ __forceinline__ Row row(int r) const { const MoeRow m = moe_row(mt, list, r); Row w; w.ok = m.tok >= 0; w.s = w.ok ? rffn[m.tok] : 0.f; return w; }
    __device__ __forceinline__ float operator()(int r, int col, const float* v, const Row& w) const {
        float a[4];
#pragma unroll
        for (int i = 0; i < 4; ++i) { const float g = v[i] * w.s, u = v[4 + i] * w.s; a[i] = g * sigmoidf_(g) * u; }
        u32x2 o; o.x = pk2(a[0], a[1]); o.y = pk2(a[2], a[3]);
        *(u32x2*)(ACT + (size_t)r * DEXP + (col >> 1)) = o;
        return 0.f;
    }
    __device__ __forceinline__ void rowsum(int, int, float) const {}
};
struct EpiDown {
    MoeTab mt; const int* list; const float* lw; bf16_t* Y;
    typedef RowM Row;
    __device__ __forceinline__ Row row(int r) const { const MoeRow m = moe_row(mt, list, r); Row w; w.ok = m.tok >= 0; w.s = w.ok ? lw[m.e * T + m.pos] : 0.f; return w; }
    __device__ __forceinline__ float operator()(int r, int col, const float* v, const Row& w) const {
        if (w.ok) { float x[8];
#pragma unroll
            for (int i = 0; i < 8; ++i) x[i] = v[i] * w.s;
            *(u32x4*)(Y + (size_t)r * D + col) = pack8(x); }
        return 0.f;
    }
    __device__ __forceinline__ void rowsum(int, int, float) const {}
};
struct EpiPP {
    bf16_t* PP;
    typedef RowS Row;
    __device__ __forceinline__ Row row(int) const { Row w; w.s = 1.f; return w; }
    __device__ __forceinline__ float operator()(int r, int col, const float* v, const Row&) const { *(u32x4*)(PP + (size_t)r * D + col) = pack8(v); return 0.f; }
    __device__ __forceinline__ void rowsum(int, int, float) const {}
};
struct EpiPLE {
    const float* ssq_in; const bf16_t* PP; float* H; bf16_t* HB; float* ssq;
    typedef RowS Row;
    __device__ __forceinline__ Row row(int r) const { Row w; w.s = rs_from(ssq_in + r * 16, 16, 1.f / D); return w; }
    __device__ __forceinline__ float operator()(int r, int col, const float* v, const Row& w) const {
        float pp[8]; unpack8(*(const u32x4*)(PP + (size_t)r * D + col), pp);
        f32x4* hp = (f32x4*)(H + (size_t)r * D + col); const f32x4 a = hp[0], b = hp[1];
        const float h0[8] = {a.x, a.y, a.z, a.w, b.x, b.y, b.z, b.w};
        float x[8]; float ss = 0.f;
#pragma unroll
        for (int i = 0; i < 8; ++i) { x[i] = h0[i] + sigmoidf_(v[i] * w.s) * pp[i]; ss += x[i] * x[i]; }
        hp[0] = (f32x4){x[0], x[1], x[2], x[3]}; hp[1] = (f32x4){x[4], x[5], x[6], x[7]};
        *(u32x4*)(HB + (size_t)r * D + col) = pack8(x);
        return ss;
    }
    __device__ __forceinline__ void rowsum(int r, int slot, float ss) const { ssq[r * 16 + slot] = ss; }
};

__device__ __forceinline__ void phase_conv(Ctx& C, int j) {
    const bf16_t* P3 = WSP(bf16_t, WS_P3); bf16_t* MIX = WSP(bf16_t, WS_MIX); const float* cw = C.in[6] + (size_t)j * 3 * 512;
    const int gt = C.bid * NTHREADS + C.tid, NGT = C.nblk * NTHREADS;
    for (int i = gt; i < T * 64; i += NGT) {
        const int t = i >> 6, c = (i & 63) * 8, s = t & (SEQ - 1);
        float acc[8];
#pragma unroll
        for (int q = 0; q < 8; ++q) acc[q] = 0.f;
#pragma unroll
        for (int k = 0; k < 3; ++k) {
            const int dt = 2 - k;
            if (s - dt >= 0) {
                float xc[8], gc[8]; unpack8(*(const u32x4*)(P3 + (size_t)(t - dt) * 1536 + c), xc); unpack8(*(const u32x4*)(P3 + (size_t)(t - dt) * 1536 + 1024 + c), gc);
#pragma unroll
                for (int q = 0; q < 8; ++q) acc[q] += cw[k * 512 + c + q] * (gc[q] * xc[q]);
            }
        }
        float gb[8]; unpack8(*(const u32x4*)(P3 + (size_t)t * 1536 + 512 + c), gb);
#pragma unroll
        for (int q = 0; q < 8; ++q) acc[q] *= gb[q];
        *(u32x4*)(MIX + (size_t)t * D + c) = pack8(acc);
    }
}

__device__ __forceinline__ void phase_attn_naive(Ctx& C) {
    const bf16_t* Q = WSP(bf16_t, WS_Q); const bf16_t* KV = WSP(bf16_t, WS_KV); const bf16_t* KPE = WSP(bf16_t, WS_KPE); bf16_t* MIX = WSP(bf16_t, WS_MIX);
    LAS float* Ks = (LAS float*)C.lds;
    LAS float* Vs = Ks + 64 * 97;
    LAS float* Qs = Vs + 64 * 64;
    LAS float* Ps = Qs + 64 * 96;
    const int tid = C.tid, lane = C.lane, wave = C.wave;
    const int nunits = NBATCH * NH * (SEQ / 64);
    for (int u = C.bid; u < nunits; u += C.nblk) {
        const int qb = (SEQ / 64 - 1) - (u / (NBATCH * NH)), bh = u % (NBATCH * NH), b = bh / NH, h = bh % NH;
        const int t0 = b * SEQ + qb * 64;
        __syncthreads();
        for (int i = tid; i < 64 * 12; i += NTHREADS) { const int r = i / 12, c8 = (i % 12) * 8; float v[8]; unpack8(*(const u32x4*)(Q + (size_t)(t0 + r) * 768 + h * 96 + c8), v);
#pragma unroll
            for (int q = 0; q < 8; ++q) Qs[r * 96 + c8 + q] = v[q]; }
        float m[8], l[8], o[8];
#pragma unroll
        for (int i = 0; i < 8; ++i) { m[i] = -1e30f; l[i] = 0.f; o[i] = 0.f; }
        for (int kt = 0; kt <= qb; ++kt) {
            const int k0 = b * SEQ + kt * 64;
            __syncthreads();
            for (int i = tid; i < 64 * 20; i += NTHREADS) { const int r = i / 20, c = i % 20; float v[8];
                if (c < 8) { unpack8(*(const u32x4*)(KV + (size_t)(k0 + r) * 1024 + h * 128 + c * 8), v);
#pragma unroll
                    for (int q = 0; q < 8; ++q) Ks[r * 97 + c * 8 + q] = v[q]; }
                else if (c < 12) { unpack8(*(const u32x4*)(KPE + (size_t)(k0 + r) * 32 + (c - 8) * 8), v);
#pragma unroll
                    for (int q = 0; q < 8; ++q) Ks[r * 97 + c * 8 + q] = v[q]; }
                else { unpack8(*(const u32x4*)(KV + (size_t)(k0 + r) * 1024 + h * 128 + 64 + (c - 12) * 8), v);
#pragma unroll
                    for (int q = 0; q < 8; ++q) Vs[r * 64 + (c - 12) * 8 + q] = v[q]; } }
            __syncthreads();
#pragma unroll
            for (int qi = 0; qi < 8; ++qi) {
                const int qr = wave * 8 + qi;
                float s = 0.f;
                for (int d = 0; d < 96; ++d) s += Qs[qr * 96 + d] * Ks[lane * 97 + d];
                if (kt == qb && lane > qr) s = -1e30f;
                const float mn = fmaxf(m[qi], wave_max(s));
                const float p = exp2f(s - mn), al = exp2f(m[qi] - mn);
                const float pb = rbf(p);
                l[qi] = l[qi] * al + wave_sum(p); m[qi] = mn;
                Ps[wave * 64 + lane] = pb;
                asm volatile("s_waitcnt lgkmcnt(0)" ::: "memory");
                float acc = 0.f;
                for (int k = 0; k < 64; ++k) acc += Ps[wave * 64 + k] * Vs[k * 64 + lane];
                o[qi] = o[qi] * al + acc;
                asm volatile("s_waitcnt lgkmcnt(0)" ::: "memory");
            }
        }
#pragma unroll
        for (int qi = 0; qi < 8; ++qi) MIX[(size_t)(t0 + wave * 8 + qi) * D + 512 + h * 64 + lane] = (bf16_t)f2bf(o[qi] / l[qi]);
    }
    __syncthreads();
}

__device__ __forceinline__ void phase_sg_naive(Ctx& C, int j) {
    const bf16_t* Z = WSP(bf16_t, WS_Z); const float* ssqx = WSP(float, WS_SSQX); const bf16_t* WS = WSP(bf16_t, WS_WS) + (size_t)j * 8 * 128 * 128; bf16_t* MIX = WSP(bf16_t, WS_MIX);
    const float* vg = C.in[13] + j * D; const float* bs = C.in[15] + (size_t)j * 8 * 128;
    LAS float* Wt = (LAS float*)C.lds;
    LAS float* Vn = Wt + 128 * 129;
    const int tid = C.tid;
    for (int u = C.bid; u < NBATCH * 32 * 8; u += C.nblk) {
        const int g = u & 7, bc = u >> 3, t0 = bc * 128;
        __syncthreads();
        for (int i = tid; i < 128 * 16; i += NTHREADS) { const int r = i >> 4, c8 = (i & 15) * 8; float v[8];
            unpack8(*(const u32x4*)(WS + (size_t)g * 16384 + r * 128 + c8), v);
#pragma unroll
            for (int q = 0; q < 8; ++q) Wt[r * 129 + c8 + q] = v[q];
            unpack8(*(const u32x4*)(Z + (size_t)(t0 + r) * 2048 + 1024 + g * 128 + c8), v);
            const float rv = rs_from(ssqx + (t0 + r) * 36 + 16, 16, 1.f / 1024);
#pragma unroll
            for (int q = 0; q < 8; ++q) Vn[r * 128 + c8 + q] = rbf(v[q] * rv * vg[g * 128 + c8 + q]); }
        __syncthreads();
        const int t = tid >> 2, d0 = (tid & 3) * 32;
        float acc[32];
#pragma unroll
        for (int i = 0; i < 32; ++i) acc[i] = 0.f;
        for (int s = 0; s <= t; ++s) { const float w = Wt[t * 129 + s];
#pragma unroll
            for (int i = 0; i < 32; ++i) acc[i] += w * Vn[s * 128 + d0 + i]; }
        const float bias = bs[g * 128 + t];
#pragma unroll
        for (int i8 = 0; i8 < 4; ++i8) { float uu[8], o[8]; unpack8(*(const u32x4*)(Z + (size_t)(t0 + t) * 2048 + g * 128 + d0 + i8 * 8), uu);
#pragma unroll
            for (int q = 0; q < 8; ++q) o[q] = uu[q] * (acc[i8 * 8 + q] + bias);
            *(u32x4*)(MIX + (size_t)(t0 + t) * D + g * 128 + d0 + i8 * 8) = pack8(o); }
    }
    __syncthreads();
}

__device__ __forceinline__ void phase_router(Ctx& C, int layer) {
    const bf16_t* HB = WSP(bf16_t, WS_HB0); const float* ssq = WSP(float, WS_SSQ0); const bf16_t* WR = WSP(bf16_t, WS_WR) + (size_t)layer * 64 * D;
    int* tok_e = WSP(int, WS_TOK); int* tok_pos = tok_e + 2 * T; float* rffn = (float*)(tok_pos + 2 * T);
    int* list = WSP(int, WS_LIST); float* lw = WSP(float, WS_LW); unsigned* cnt = WSP(unsigned, WS_CTL) + CW_CNT + layer * 64;
    LAS u32x4* Wl = (LAS u32x4*)C.lds;
    const int lane = C.lane;
    __syncthreads();
    for (int i = C.tid; i < 36 * 128; i += NTHREADS) Wl[i] = *(const u32x4*)(WR + (size_t)i * 8);
    __syncthreads();
    const int gw = C.bid * NWAVES + C.wave, NGW = C.nblk * NWAVES;
    for (int m = gw; m < T; m += NGW) {
        const float r = rs_from(ssq + m * 16, 16, 1.f / D);
        float x0[8], x1[8];
        unpack8(*(const u32x4*)(HB + (size_t)m * D + lane * 8), x0); unpack8(*(const u32x4*)(HB + (size_t)m * D + 512 + lane * 8), x1);
        LAS float* lgs = (LAS float*)(C.lds + 36 * 128 * 16) + C.wave * 64;
#pragma unroll 2
        for (int n = 0; n < 36; ++n) {
            float w0[8], w1[8]; unpack8(Wl[n * 128 + lane], w0); unpack8(Wl[n * 128 + 64 + lane], w1);
            float s = 0.f;
#pragma unroll
            for (int i = 0; i < 8; ++i) s += x0[i] * w0[i] + x1[i] * w1[i];
            s = wave_sum(s) * r;
            if (lane == 0) lgs[n] = s;
        }
        asm volatile("s_waitcnt lgkmcnt(0)" ::: "memory");
        const float g0 = lgs[0], g1 = lgs[1], g2 = lgs[2], g3 = lgs[3];
        int g = 0; float gm = g0;
        if (g1 > gm) { gm = g1; g = 1; }
        if (g2 > gm) { gm = g2; g = 2; }
        if (g3 > gm) { gm = g3; g = 3; }
        const float gs = __expf(g0 - gm) + __expf(g1 - gm) + __expf(g2 - gm) + __expf(g3 - gm);
        const float gw_ = 1.0f / gs;
        float el[8];
#pragma unroll
        for (int q = 0; q < 8; ++q) el[q] = lgs[4 + g * 8 + q];
        asm volatile("s_waitcnt lgkmcnt(0)" ::: "memory");
        int i1 = 0; float m1 = el[0];
#pragma unroll
        for (int q = 1; q < 8; ++q) if (el[q] > m1) { m1 = el[q]; i1 = q; }
        int i2 = -1; float m2 = -3.0e38f;
#pragma unroll
        for (int q = 0; q < 8; ++q) if (q != i1 && el[q] > m2) { m2 = el[q]; i2 = q; }
        const float e2 = __expf(m2 - m1), p1 = 1.0f / (1.0f + e2), p2 = e2 / (1.0f + e2);
        if (lane == 0) {
            rffn[m] = r;
            const int ea = g * 8 + i1, eb = g * 8 + i2;
            const int pa = (int)atomicAdd(cnt + ea, 1u), pb = (int)atomicAdd(cnt + eb, 1u);
            list[ea * T + pa] = m; lw[ea * T + pa] = gw_ * p1; list[eb * T + pb] = m; lw[eb * T + pb] = gw_ * p2;
            tok_e[2 * m] = ea; tok_e[2 * m + 1] = eb; tok_pos[2 * m] = pa; tok_pos[2 * m + 1] = pb;
        }
    }
    __syncthreads();
}

__device__ __forceinline__ void phase_combine(Ctx& C, int layer) {
    const MoeTab mt = moe_tables(C, layer);
    float* H = WSP(float, WS_H); bf16_t* HB = WSP(bf16_t, WS_HB1); float* SS = WSP(float, WS_SSQ1); const bf16_t* Y = WSP(bf16_t, WS_Y);
    const int* tok_e = WSP(int, WS_TOK); const int* tok_pos = tok_e + 2 * T;
    const int gw = C.bid * NWAVES + C.wave, NGW = C.nblk * NWAVES, lane = C.lane;
    for (int m = gw; m < T; m += NGW) {
        const int ea = tok_e[2 * m], eb = tok_e[2 * m + 1];
        const size_t sa = (size_t)mt.ebase[ea] * 256 + tok_pos[2 * m], sb = (size_t)mt.ebase[eb] * 256 + tok_pos[2 * m + 1];
        f32x4* hr = (f32x4*)(H + (size_t)m * D) + lane; const u32x2* ya = (const u32x2*)(Y + sa * D) + lane; const u32x2* yb = (const u32x2*)(Y + sb * D) + lane;
        u32x2* ob = (u32x2*)(HB + (size_t)m * D) + lane; float s = 0.f;
#pragma unroll
        for (int j = 0; j < 4; ++j) {
            f32x4 v = hr[64 * j]; const u32x2 a = ya[64 * j], b = yb[64 * j];
            v.x += bf2f(a.x & 0xffffu) + bf2f(b.x & 0xffffu); v.y += bf2f(a.x >> 16) + bf2f(b.x >> 16); v.z += bf2f(a.y & 0xffffu) + bf2f(b.y & 0xffffu); v.w += bf2f(a.y >> 16) + bf2f(b.y >> 16);
            hr[64 * j] = v; s += (v.x * v.x + v.y * v.y) + (v.z * v.z + v.w * v.w); u32x2 o; o.x = pk2(v.x, v.y); o.y = pk2(v.z, v.w); ob[64 * j] = o;
        }
        s = wave_sum(s);
        if (lane < 16) SS[m * 16 + lane] = (lane == 0) ? s : 0.f;
    }
    __syncthreads();
}

__device__ __forceinline__ void phase_final(Ctx& C) {
    const float* H = WSP(float, WS_H); const float* SS = WSP(float, WS_SSQ0); const float* g = C.in[25];
    const int gw = C.bid * NWAVES + C.wave, NGW = C.nblk * NWAVES, lane = C.lane;
    for (int m = gw; m < T; m += NGW) {
        const float r = rs_from(SS + m * 16, 16, 1.f / D);
        const f32x4* hr = (const f32x4*)(H + (size_t)m * D) + lane; f32x4* o = (f32x4*)(C.out + (size_t)m * D) + lane; const f32x4* gg = (const f32x4*)g + lane;
#pragma unroll
        for (int j = 0; j < 4; ++j) { const f32x4 v = hr[64 * j], w = gg[64 * j]; o[64 * j] = (f32x4){v.x * r * w.x, v.y * r * w.y, v.z * r * w.z, v.w * r * w.w}; }
    }
}

constexpr int NPHASES = 42;
__device__ __forceinline__ void run_phase(Ctx& C, int ph) {
    if (ph == 0) { phase_prologue(C); return; }
    if (ph == NPHASES - 1) { phase_final(C); return; }
    const int layer = (ph - 1) / 10, sub = (ph - 1) % 10, j = layer >> 1; const bool even = (layer & 1) == 0;
    float* H = WSP(float, WS_H); bf16_t* HB0 = WSP(bf16_t, WS_HB0); bf16_t* HB1 = WSP(bf16_t, WS_HB1); float* SSQ0 = WSP(float, WS_SSQ0); float* SSQ1 = WSP(float, WS_SSQ1); float* SSQX = WSP(float, WS_SSQX);
    const float* ROPE = WSP(float, WS_ROPE); bf16_t* MIX = WSP(bf16_t, WS_MIX);
    switch (sub) {
    case 0:
        if (even) { DenseRM rm{HB0, WSP(bf16_t, WS_WINE) + (size_t)j * EINP * D, D}; EpiE1 e{SSQ0, WSP(bf16_t, WS_P3), WSP(bf16_t, WS_CQ), WSP(bf16_t, WS_CKV), WSP(bf16_t, WS_KPE), SSQX, ROPE}; gemm_naive(C, EINP, D, rm, e); }
        else { DenseRM rm{HB0, WSP(bf16_t, WS_WINO) + (size_t)j * 2048 * D, D}; EpiGelu e{SSQ0, WSP(bf16_t, WS_Z), SSQX}; gemm_naive(C, 2048, D, rm, e); }
        break;
    case 1:
        if (even) {
            { DenseRM rm{WSP(bf16_t, WS_CQ), WSP(bf16_t, WS_WQ) + (size_t)j * 768 * QR, QR}; EpiQ e{SSQX, WSP(bf16_t, WS_Q), ROPE}; gemm_naive(C, 768, QR, rm, e); }
            { DenseRM rm{WSP(bf16_t, WS_CKV), WSP(bf16_t, WS_WKV) + (size_t)j * 1024 * KVR, KVR}; EpiKV e{SSQX, WSP(bf16_t, WS_KV)}; gemm_naive(C, 1024, KVR, rm, e); }
            phase_conv(C, j);
        } else phase_sg_naive(C, j);
        break;
    case 2:
        if (even) phase_attn_naive(C);
        break;
    case 3: {
        DenseRM rm{MIX, (even ? WSP(bf16_t, WS_WOE) : WSP(bf16_t, WS_WOO)) + (size_t)j * D * D, D}; EpiRes e{H, HB0, SSQ0}; gemm_naive(C, D, D, rm, e);
        break; }
    case 4: phase_router(C, layer); break;
    case 5: { const MoeTab mt = moe_tables(C, layer); const int* tok_e = WSP(int, WS_TOK);
        MoeGatherRM rm{mt, WSP(int, WS_LIST), HB0, WSP(bf16_t, WS_WGU) + (size_t)layer * NEXP * D * D}; EpiGU e{mt, WSP(int, WS_LIST), (const float*)(tok_e + 4 * T), WSP(bf16_t, WS_ACT)}; gemm_naive(C, D, D, rm, e);
        break; }
    case 6: { const MoeTab mt = moe_tables(C, layer);
        MoeDownRM rm{mt, WSP(bf16_t, WS_ACT), WSP(bf16_t, WS_WDN) + (size_t)layer * NEXP * D * DEXP}; EpiDown e{mt, WSP(int, WS_LIST), WSP(float, WS_LW), WSP(bf16_t, WS_Y)}; gemm_naive(C, D, DEXP, rm, e);
        break; }
    case 7: phase_combine(C, layer); break;
    case 8: { DenseRM rm{WSP(bf16_t, WS_PB) + (size_t)layer * T * PLE, WSP(bf16_t, WS_WP) + (size_t)layer * D * PLE, PLE}; EpiPP e{WSP(bf16_t, WS_PP)}; gemm_naive(C, D, PLE, rm, e); break; }
    case 9: { DenseRM rm{HB1, WSP(bf16_t, WS_WG) + (size_t)layer * D * D, D}; EpiPLE e{SSQ1, WSP(bf16_t, WS_PP), H, HB0, SSQ0}; gemm_naive(C, D, D, rm, e); break; }
    }
}
__host__ __device__ inline bool phase_is_nop(int ph) { if (ph == 0 || ph == NPHASES - 1) return false; const int layer = (ph - 1) / 10, sub = (ph - 1) % 10; return (layer & 1) && sub == 2; }

__global__ void __launch_bounds__(NTHREADS, 2) fwd_kernel(Args args) {
    extern __shared__ __attribute__((aligned(16))) unsigned char lds_raw[];
    Ctx C;
    C.lds = (LAS unsigned char*)lds_raw;
    C.tid = threadIdx.x; C.lane = C.tid & 63; C.wave = __builtin_amdgcn_readfirstlane(C.tid >> 6);
    C.bid = blockIdx.x; C.nblk = gridDim.x;
#pragma unroll
    for (int i = 0; i < 26; ++i) C.in[i] = args.in[i];
    C.out = args.out; C.ws = args.ws;
    volatile LAS unsigned* misc = (volatile LAS unsigned*)(C.lds + LDS_MISC);
    if (C.tid < 64) misc[C.tid] = 0u;
    __syncthreads();
#if MEGA
    XcdBarrier bar = xcd_barrier_post(WSP(unsigned, WS_CTL) + CW_BAR, misc + 8);
#endif
    for (int ph = args.ph_lo; ph < args.ph_hi; ++ph) {
        if (phase_is_nop(ph)) continue;
        run_phase(C, ph);
#if MEGA
        if (ph + 1 < args.ph_hi) xcd_barrier(bar);
#endif
    }
}

extern "C" void kernel_launch(void* const* d_in, const int* in_sizes, int n_in, void* d_out, int out_size, void* d_ws, size_t ws_size, hipStream_t stream) {
    static int grid = 0;
    if (grid == 0) {
        if (n_in != 26 || out_size != T * D || ws_size < WS_END) { fprintf(stderr, "kernel_launch: unexpected shapes (n_in %d out %d ws %zu)\n", n_in, out_size, ws_size); grid = -1; return; }
        int dev = 0, cus = 0;
        if (hipGetDevice(&dev) != hipSuccess || hipDeviceGetAttribute(&cus, hipDeviceAttributeMultiprocessorCount, dev) != hipSuccess) { grid = -1; return; }
        if (hipFuncSetAttribute((const void*)fwd_kernel, hipFuncAttributeMaxDynamicSharedMemorySize, LDS_BYTES) != hipSuccess) { fprintf(stderr, "kernel_launch: hipFuncSetAttribute failed\n"); grid = -1; return; }
        grid = cus;
    }
    if (grid < 0) return;
    (void)hipMemsetAsync((char*)d_ws + WS_CTL, 0, CTL_ZERO_BYTES, stream);
    Args a{};
    for (int i = 0; i < 26; ++i) a.in[i] = (const float*)d_in[i];
    a.out = (float*)d_out; a.ws = (unsigned char*)d_ws;
#if MEGA
    a.ph_lo = 0; a.ph_hi = NPHASES;
    hipLaunchKernelGGL(fwd_kernel, dim3(grid), dim3(NTHREADS), LDS_BYTES, stream, a);
#else
    for (int ph = 0; ph < NPHASES; ++ph) {
        if (phase_is_nop(ph)) continue;
        a.ph_lo = ph; a.ph_hi = ph + 1;
        hipLaunchKernelGGL(fwd_kernel, dim3(grid), dim3(NTHREADS), LDS_BYTES, stream, a);
    }
#endif
}
```

```cpp
#include <hip/hip_runtime.h>
#include <cstdio>
#include <cstdint>

#ifndef FASTMASK
#define FASTMASK 0x1ff
#endif
#ifndef MEGA
#define MEGA 1
#endif

#define LAS __attribute__((address_space(3)))
#define GAS __attribute__((address_space(1)))
typedef unsigned short bf16_t;
typedef float f32x4 __attribute__((ext_vector_type(4)));
typedef unsigned u32x4 __attribute__((ext_vector_type(4)));
typedef unsigned u32x2 __attribute__((ext_vector_type(2)));
typedef short bf16x8 __attribute__((ext_vector_type(8)));

constexpr int T = 16384, D = 1024, SEQ = 4096, NBATCH = 4, DEPTH = 4;
constexpr int EIN = 2208, EINP = 2304;
constexpr int NH = 8, DQK = 96, DV = 64;
constexpr int QR = 384, KVR = 256;
constexpr int NEXP = 32, DEXP = 512;
constexpr int PLE = 256;
constexpr float EPS = 1e-6f;
constexpr int NWAVES = 8, NTHREADS = 512;
constexpr int MOE_ROWS = 40960;
constexpr float QSCALE = 0.10206207261596577f * 1.4426950408889634f;

constexpr size_t MiB = 1u << 20;
constexpr size_t WS_CTL = 0, CTL_ZERO_BYTES = 1 * MiB;
constexpr size_t WS_WINE = 1 * MiB;
constexpr size_t WS_WQ = 10 * MiB;
constexpr size_t WS_WKV = 12 * MiB;
constexpr size_t WS_WOE = 13 * MiB;
constexpr size_t WS_WINO = 17 * MiB;
constexpr size_t WS_WOO = 25 * MiB;
constexpr size_t WS_WS = 29 * MiB;
constexpr size_t WS_WR = 30 * MiB;
constexpr size_t WS_WG = 31 * MiB;
constexpr size_t WS_WP = 39 * MiB;
constexpr size_t WS_WGU = 41 * MiB;
constexpr size_t WS_WDN = 297 * MiB;
constexpr size_t WS_H = 425 * MiB;
constexpr size_t WS_HB0 = 489 * MiB;
constexpr size_t WS_HB1 = 521 * MiB;
constexpr size_t WS_SSQ0 = 553 * MiB;
constexpr size_t WS_SSQ1 = 554 * MiB;
constexpr size_t WS_SSQX = 555 * MiB;
constexpr size_t WS_ROPE = 558 * MiB;
constexpr size_t WS_PB = 560 * MiB;
constexpr size_t WS_P3 = 592 * MiB;
constexpr size_t WS_CQ = 640 * MiB;
constexpr size_t WS_CKV = 652 * MiB;
constexpr size_t WS_KPE = 660 * MiB;
constexpr size_t WS_Z = 592 * MiB;
constexpr size_t WS_Q = 661 * MiB;
constexpr size_t WS_KV = 685 * MiB;
constexpr size_t WS_MIX = 717 * MiB;
constexpr size_t WS_LIST = 749 * MiB;
constexpr size_t WS_LW = 751 * MiB;
constexpr size_t WS_TOK = 753 * MiB;
constexpr size_t WS_ACT = 754 * MiB;
constexpr size_t WS_Y = 794 * MiB;
constexpr size_t WS_PP = 874 * MiB;
constexpr size_t WS_PAR = 906 * MiB;
constexpr int PAR_CONV = 0, PAR_VN = 3072, PAR_BS = 5120, PAR_FN = 7168, PAR_N = 8192;
constexpr size_t WS_END = 907 * MiB;

constexpr int CW_CNT = 64;
constexpr int CW_BAR = 4096;

constexpr int LDS_BYTES = 147456;
constexpr int LDS_MISC = LDS_BYTES - 256;

__device__ __forceinline__ float bf2f(unsigned b) { return __uint_as_float(b << 16); }
__device__ __forceinline__ unsigned f2bf(float f) { unsigned u = __float_as_uint(f); return (u + 0x7fffu + ((u >> 16) & 1u)) >> 16; }
__device__ __forceinline__ unsigned pk2(float lo, float hi) { return f2bf(lo) | (f2bf(hi) << 16); }
__device__ __forceinline__ void unpack8(const u32x4 w, float* v) {
    v[0] = __uint_as_float(w.x << 16); v[1] = __uint_as_float(w.x & 0xffff0000u);
    v[2] = __uint_as_float(w.y << 16); v[3] = __uint_as_float(w.y & 0xffff0000u);
    v[4] = __uint_as_float(w.z << 16); v[5] = __uint_as_float(w.z & 0xffff0000u);
    v[6] = __uint_as_float(w.w << 16); v[7] = __uint_as_float(w.w & 0xffff0000u);
}
__device__ __forceinline__ u32x4 pack8(const float* v) { u32x4 w; w.x = pk2(v[0], v[1]); w.y = pk2(v[2], v[3]); w.z = pk2(v[4], v[5]); w.w = pk2(v[6], v[7]); return w; }
__device__ __forceinline__ float rbf(float f) { return bf2f(f2bf(f)); }
__device__ __forceinline__ float wave_sum(float v) {
#pragma unroll
    for (int o = 1; o < 64; o <<= 1) v += __shfl_xor(v, o);
    return v;
}
__device__ __forceinline__ float wave_max(float v) {
#pragma unroll
    for (int o = 1; o < 64; o <<= 1) v = fmaxf(v, __shfl_xor(v, o));
    return v;
}
__device__ __forceinline__ float sigmoidf_(float x) { return 1.0f / (1.0f + __expf(-x)); }
__device__ __forceinline__ float gelu_tanh(float x) {
    const float u = 0.7978845608028654f * (x + 0.044715f * x * x * x);
    const float e = __expf(2.0f * u);
    const float th = 1.0f - 2.0f / (e + 1.0f);
    return 0.5f * x * (1.0f + th);
}

#define XB_TMO      128
#define XB_XCNT(j)  (256  + 64 * (j))
#define XB_XSUB(j)  (1280 + 64 * (j))
#define XB_XGEN(j)  (2304 + 64 * (j))
#define XB_TOP      3328
#define XB_TOPGEN   3392
#define XCD_BAR_WORDS 3456
#define XB_SPIN_CAP (1u << 22)
__device__ __forceinline__ unsigned xb_ld(unsigned* p)              { return __hip_atomic_load(p, __ATOMIC_RELAXED, __HIP_MEMORY_SCOPE_AGENT); }
__device__ __forceinline__ unsigned xb_add(unsigned* p, unsigned v) { return __hip_atomic_fetch_add(p, v, __ATOMIC_RELAXED, __HIP_MEMORY_SCOPE_AGENT); }
__device__ __forceinline__ unsigned xb_xcc_id() { return (unsigned)__builtin_amdgcn_s_getreg((3 << 11) | 20) & 0xFu; }
#define XB_SPIN(cond, bar) do { unsigned _sp = 0; while (cond) { __builtin_amdgcn_s_sleep(1); \
    if ((++_sp & 255u) == 0u) { if (xb_ld(&(bar)[XB_TMO])) break; if (_sp > XB_SPIN_CAP) { atomicAdd(&(bar)[XB_TMO], 1u); break; } } } } while (0)
struct XcdBarrier { unsigned* bar; unsigned x; volatile LAS unsigned* st; };
__device__ __forceinline__ XcdBarrier xcd_barrier_post(unsigned* bar, volatile LAS unsigned* st) {
    XcdBarrier b; b.bar = bar; b.x = xb_xcc_id(); b.st = st;
    if (threadIdx.x == 0) (void)xb_add(&bar[XB_XCNT(b.x)], 1u);
    return b;
}
__device__ __forceinline__ void xcd_barrier_complete(unsigned* bar, unsigned x, unsigned& nloc, unsigned& nx) {
    const unsigned G = gridDim.x * gridDim.y * gridDim.z;
    unsigned sum, cnt, mine, sp = 0u;
    for (;;) {
        sum = 0u; cnt = 0u; mine = 0u;
#pragma unroll
        for (unsigned j = 0; j < 16; ++j) { const unsigned c = xb_ld(&bar[XB_XCNT(j)]); sum += c; cnt += (c > 0u) ? 1u : 0u; mine = (j == x) ? c : mine; }
        if (sum == G) break;
        __builtin_amdgcn_s_sleep(1);
        if ((++sp & 255u) == 0u) { if (xb_ld(&bar[XB_TMO])) break; if (sp > XB_SPIN_CAP) { atomicAdd(&bar[XB_TMO], 1u); break; } }
    }
    nloc = mine > 0u ? mine : 1u; nx = cnt > 0u ? cnt : 1u;
}
__device__ __forceinline__ void xcd_barrier(const XcdBarrier& b) {
    asm volatile("s_waitcnt vmcnt(0)" ::: "memory");
    __syncthreads();
    if (threadIdx.x == 0) {
        unsigned* bar = b.bar;
        __builtin_amdgcn_s_waitcnt(0);
        unsigned nloc = b.st[0], nx = b.st[1];
        if (nloc == 0u) { xcd_barrier_complete(bar, b.x, nloc, nx); b.st[0] = nloc; b.st[1] = nx; }
        const unsigned old = xb_add(&bar[XB_XSUB(b.x)], 1u);
        const unsigned gen = old / nloc;
        if (old + 1u == (gen + 1u) * nloc) {
            __builtin_amdgcn_fence(__ATOMIC_RELEASE, "agent");
            asm volatile("s_waitcnt vmcnt(0)" ::: "memory");
            const unsigned og = xb_add(&bar[XB_TOP], 1u);
            const unsigned tg = og / nx;
            if (og + 1u == (tg + 1u) * nx) xb_add(&bar[XB_TOPGEN], 1u);
            else XB_SPIN(xb_ld(&bar[XB_TOPGEN]) == tg, bar);
            __builtin_amdgcn_fence(__ATOMIC_ACQUIRE, "agent");
            xb_add(&bar[XB_XGEN(b.x)], 1u);
            asm volatile("s_waitcnt vmcnt(0)" ::: "memory");
        } else {
            XB_SPIN(xb_ld(&bar[XB_XGEN(b.x)]) == gen, bar);
            __builtin_amdgcn_fence(__ATOMIC_ACQUIRE, "agent");
            asm volatile("s_waitcnt vmcnt(0)" ::: "memory");
        }
    }
    __syncthreads();
}

struct Args { const float* in[26]; float* out; unsigned char* ws; int ph_lo, ph_hi; };
struct Ctx {
    LAS unsigned char* lds;
    const Args* a; unsigned char* ws;
    int tid, lane, wave, bid, nblk;
};
#define WSP(T_, off) ((T_*)(C.ws + (off)))

__device__ __forceinline__ void conv_item(const float* colp, int ldw, const float* gain, bf16_t* WT, int K, int k0, int n0, LAS float* scr, int lane) {
#pragma unroll 8
    for (int i = 0; i < 32; ++i) {
        const int kk = 2 * i + (lane >> 5);
        float v = colp ? colp[(size_t)(k0 + kk) * ldw] : 0.f;
        if (gain) v *= gain[k0 + kk];
        scr[kk * 33 + (lane & 31)] = v;
    }
    asm volatile("s_waitcnt lgkmcnt(0)" ::: "memory");
    const int c = lane & 7;
#pragma unroll
    for (int j = 0; j < 4; ++j) {
        const int n = (lane >> 3) + 8 * j; const LAS float* s = scr + (8 * c) * 33 + n;
        u32x4 o; o.x = pk2(s[0 * 33], s[1 * 33]); o.y = pk2(s[2 * 33], s[3 * 33]); o.z = pk2(s[4 * 33], s[5 * 33]); o.w = pk2(s[6 * 33], s[7 * 33]);
        *(u32x4*)(WT + (size_t)(n0 + n) * K + k0 + 8 * c) = o;
    }
    asm volatile("s_waitcnt lgkmcnt(0)" ::: "memory");
}

__device__ __forceinline__ void phase_prologue(Ctx& C) {
    LAS float* scr = (LAS float*)(C.lds + C.wave * 16384);
    const int gw = C.bid * NWAVES + C.wave, NGW = C.nblk * NWAVES, lane = C.lane;
    constexpr int I0 = 16 * 72, I1 = 6 * 24, I2 = 4 * 32, I3 = 16 * 32, I4 = 16 * 64, I5 = 16 * 32, I6 = 16 * 2, I7 = 16 * 32, I8 = 4 * 32, I9 = 16 * 32, I10 = 8 * 32;
    constexpr int E0 = 2 * I0, E1 = E0 + 2 * I1, E2 = E1 + 2 * I2, E3 = E2 + 2 * I3, E4 = E3 + 2 * I4, E5 = E4 + 2 * I5, E6 = E5 + 4 * I6, E7 = E6 + 4 * I7, E8 = E7 + 4 * I8,
                  E9 = E8 + 128 * I9, E10 = E9 + 128 * I10;
    for (int it = gw; it < E10; it += NGW) {
        const int nl = lane & 31;
        if (it < E0) {
            const int j = it / I0, r = it % I0, kb = r / 72, nb = r % 72, np = nb * 32 + nl;
            int n;
            if (np < 1920) n = np; else if (np < 1952) { const int q = np - 1920; n = 2176 + (q & 1) * 16 + (q >> 1); } else if (np < 2048) n = -1; else n = 1920 + (np - 2048);
            const float* base = C.a->in[5] + (size_t)j * D * EIN;
            conv_item(n >= 0 ? base + n : nullptr, EIN, C.a->in[3] + (2 * j) * D, WSP(bf16_t, WS_WINE) + (size_t)j * EINP * D, D, kb * 64, nb * 32, scr, lane);
        } else if (it < E1) {
            const int r0 = it - E0, j = r0 / I1, r = r0 % I1, kb = r / 24, nb = r % 24, np = nb * 32 + nl;
            const int hd = np / 96, dd = np % 96; int n = np;
            if (dd >= 64) { const int q = dd - 64; n = hd * 96 + 64 + (q & 1) * 16 + (q >> 1); }
            conv_item(C.a->in[8] + (size_t)j * QR * 768 + n, 768, C.a->in[7] + j * QR, WSP(bf16_t, WS_WQ) + (size_t)j * 768 * QR, QR, kb * 64, nb * 32, scr, lane);
        } else if (it < E2) {
            const int r0 = it - E1, j = r0 / I2, r = r0 % I2, kb = r / 32, nb = r % 32, np = nb * 32 + nl;
            conv_item(C.a->in[10] + (size_t)j * KVR * 1024 + np, 1024, C.a->in[9] + j * KVR, WSP(bf16_t, WS_WKV) + (size_t)j * 1024 * KVR, KVR, kb * 64, nb * 32, scr, lane);
        } else if (it < E3) {
            const int r0 = it - E2, j = r0 / I3, r = r0 % I3, kb = r / 32, nb = r % 32, np = nb * 32 + nl;
            conv_item(C.a->in[11] + (size_t)j * D * D + np, D, nullptr, WSP(bf16_t, WS_WOE) + (size_t)j * D * D, D, kb * 64, nb * 32, scr, lane);
        } else if (it < E4) {
            const int r0 = it - E3, j = r0 / I4, r = r0 % I4, kb = r / 64, nb = r % 64, np = nb * 32 + nl;
            conv_item(C.a->in[12] + (size_t)j * D * 2048 + np, 2048, C.a->in[3] + (2 * j + 1) * D, WSP(bf16_t, WS_WINO) + (size_t)j * 2048 * D, D, kb * 64, nb * 32, scr, lane);
        } else if (it < E5) {
            const int r0 = it - E4, j = r0 / I5, r = r0 % I5, kb = r / 32, nb = r % 32, np = nb * 32 + nl;
            conv_item(C.a->in[16] + (size_t)j * D * D + np, D, nullptr, WSP(bf16_t, WS_WOO) + (size_t)j * D * D, D, kb * 64, nb * 32, scr, lane);
        } else if (it < E6) {
            const int r0 = it - E5, l = r0 / I6, r = r0 % I6, kb = r / 2, nb = r % 2, np = nb * 32 + nl;
            const float* cp = nullptr; int ld = 4;
            if (np < 4) { cp = C.a->in[17] + (size_t)l * D * 4 + np; ld = 4; } else if (np < 36) { cp = C.a->in[18] + (size_t)l * D * 32 + (np - 4); ld = 32; }
            conv_item(cp, ld, C.a->in[4] + l * D, WSP(bf16_t, WS_WR) + (size_t)l * 64 * D, D, kb * 64, nb * 32, scr, lane);
        } else if (it < E7) {
            const int r0 = it - E6, l = r0 / I7, r = r0 % I7, kb = r / 32, nb = r % 32, np = nb * 32 + nl;
            conv_item(C.a->in[23] + (size_t)l * D * D + np, D, C.a->in[22] + l * D, WSP(bf16_t, WS_WG) + (size_t)l * D * D, D, kb * 64, nb * 32, scr, lane);
        } else if (it < E8) {
            const int r0 = it - E7, l = r0 / I8, r = r0 % I8, kb = r / 32, nb = r % 32, np = nb * 32 + nl;
            conv_item(C.a->in[24] + (size_t)l * PLE * D + np, D, nullptr, WSP(bf16_t, WS_WP) + (size_t)l * D * PLE, PLE, kb * 64, nb * 32, scr, lane);
        } else if (it < E9) {
            const int r0 = it - E8, m = r0 / I9, r = r0 % I9, kb = r / 32, nb = r % 32, np = nb * 32 + nl;
            const int l = m >> 5, blk = np >> 3, rr = np & 7;
            const float* cp = (rr < 4) ? C.a->in[19] + (size_t)m * D * DEXP + blk * 4 + rr : C.a->in[20] + (size_t)m * D * DEXP + blk * 4 + (rr - 4);
            conv_item(cp, DEXP, C.a->in[4] + l * D, WSP(bf16_t, WS_WGU) + (size_t)m * D * D, D, kb * 64, nb * 32, scr, lane);
        } else {
            const int r0 = it - E9, m = r0 / I10, r = r0 % I10, kb = r / 32, nb = r % 32, np = nb * 32 + nl;
            conv_item(C.a->in[21] + (size_t)m * DEXP * D + np, D, nullptr, WSP(bf16_t, WS_WDN) + (size_t)m * D * DEXP, DEXP, kb * 64, nb * 32, scr, lane);
        }
    }
    {
        float* H = WSP(float, WS_H); bf16_t* HB = WSP(bf16_t, WS_HB0); float* SS = WSP(float, WS_SSQ0);
        for (int m = gw; m < T; m += NGW) {
            const f32x4* xr = (const f32x4*)(C.a->in[0] + (size_t)m * D) + lane; f32x4* hr = (f32x4*)(H + (size_t)m * D) + lane;
            u32x2* ob = (u32x2*)(HB + (size_t)m * D) + lane; float s = 0.f;
#pragma unroll
            for (int j = 0; j < 4; ++j) { const f32x4 v = xr[64 * j]; hr[64 * j] = v; s += (v.x * v.x + v.y * v.y) + (v.z * v.z + v.w * v.w); u32x2 o; o.x = pk2(v.x, v.y); o.y = pk2(v.z, v.w); ob[64 * j] = o; }
            s = wave_sum(s);
            if (lane < 16) SS[m * 16 + lane] = (lane == 0) ? s : 0.f;
        }
    }
    {
        const size_t n8 = (size_t)DEPTH * T * PLE / 8; const size_t gt = (size_t)C.bid * NTHREADS + C.tid, NGT = (size_t)C.nblk * NTHREADS;
        const f32x4* src = (const f32x4*)C.a->in[1]; u32x4* dst = WSP(u32x4, WS_PB);
        for (size_t i = gt; i < n8; i += NGT) { const f32x4 a = src[2 * i], b = src[2 * i + 1]; u32x4 o; o.x = pk2(a.x, a.y); o.y = pk2(a.z, a.w); o.z = pk2(b.x, b.y); o.w = pk2(b.z, b.w); dst[i] = o; }
    }
    {
        const int gt = C.bid * NTHREADS + C.tid, NGT = C.nblk * NTHREADS; const int* pos = (const int*)C.a->in[2]; float* R = WSP(float, WS_ROPE);
        for (int i = gt; i < T * 16; i += NGT) {
            const int t = i >> 4, f = i & 15;
            const int q = f & 3; double inv = (q == 0) ? 1.0 : (q == 1) ? 0.5623413251903491 : (q == 2) ? 0.31622776601683794 : 0.17782794100389228;
            const int dec = f >> 2; inv *= (dec == 0) ? 1.0 : (dec == 1) ? 0.1 : (dec == 2) ? 0.01 : 0.001;
            const double ang = (double)pos[t] * inv;
            const double n = __builtin_rint(ang * 0.15915494309189535);
            const double r = ang - n * 6.283185307179586, r2 = r * r;
            double sn = r, cs = 1.0, ts = r, tc = 1.0;
#pragma unroll
            for (int k = 1; k <= 13; ++k) { tc *= -r2 / (double)((2 * k - 1) * (2 * k)); cs += tc; ts *= -r2 / (double)((2 * k) * (2 * k + 1)); sn += ts; }
            R[2 * i] = (float)cs; R[2 * i + 1] = (float)sn;
        }
    }
    {
        const int gt = C.bid * NTHREADS + C.tid, NGT = C.nblk * NTHREADS; float* PR = WSP(float, WS_PAR);
        for (int i = gt; i < PAR_N; i += NGT) {
            float v;
            if (i < PAR_VN) v = C.a->in[6][i]; else if (i < PAR_BS) v = C.a->in[13][i - PAR_VN]; else if (i < PAR_FN) v = C.a->in[15][i - PAR_BS]; else v = C.a->in[25][i - PAR_FN];
            PR[i] = v;
        }
    }
    {
        const int gt = C.bid * NTHREADS + C.tid, NGT = C.nblk * NTHREADS; const float* src = C.a->in[14]; bf16_t* dst = WSP(bf16_t, WS_WS);
        for (int i = gt; i < 2 * 8 * 128 * 128; i += NGT) { const int s = i & 127, t = (i >> 7) & 127; dst[i] = (bf16_t)((s <= t) ? f2bf(src[i]) : 0u); }
    }
}

template <class RM, class Epi>
__device__ __forceinline__ void gemm_naive(Ctx& C, int N, int K, const RM& rm, const Epi& epi) {
    LAS float* As = (LAS float*)C.lds;
    LAS float* Bs = As + 32 * 132;
    const int tid = C.tid, ty = tid >> 4, tx = tid & 15;
    const int nct = N / 128, nunits = rm.ntiles128() * nct;
    for (int u = C.bid; u < nunits; u += C.nblk) {
        const int mt = u / nct, nt = u % nct, row0 = mt * 128, col0 = nt * 128;
        const bf16_t* Bt = rm.bt(row0);
        float acc[4][8];
#pragma unroll
        for (int i = 0; i < 4; ++i)
#pragma unroll
            for (int j = 0; j < 8; ++j) acc[i][j] = 0.f;
        const int lr = tid >> 2, kc = (tid & 3) * 8;
        const bf16_t* ap = rm.arow(row0 + lr);
        const bf16_t* bp = Bt + (size_t)(col0 + lr) * K;
        for (int k0 = 0; k0 < K; k0 += 32) {
            float av[8], bv[8];
            if (ap) { const u32x4 w = *(const u32x4*)(ap + k0 + kc); unpack8(w, av); } else {
#pragma unroll
                for (int i = 0; i < 8; ++i) av[i] = 0.f; }
            { const u32x4 w = *(const u32x4*)(bp + k0 + kc); unpack8(w, bv); }
            __syncthreads();
#pragma unroll
            for (int i = 0; i < 8; ++i) { As[(kc + i) * 132 + lr] = av[i]; Bs[(kc + i) * 132 + lr] = bv[i]; }
            __syncthreads();
#pragma unroll 4
            for (int k = 0; k < 32; ++k) {
                const f32x4 a = *(const LAS f32x4*)(As + k * 132 + ty * 4);
                const f32x4 b0 = *(const LAS f32x4*)(Bs + k * 132 + tx * 8), b1 = *(const LAS f32x4*)(Bs + k * 132 + tx * 8 + 4);
                const float aa[4] = {a.x, a.y, a.z, a.w}; const float bb[8] = {b0.x, b0.y, b0.z, b0.w, b1.x, b1.y, b1.z, b1.w};
#pragma unroll
                for (int i = 0; i < 4; ++i)
#pragma unroll
                    for (int j = 0; j < 8; ++j) acc[i][j] += aa[i] * bb[j];
            }
        }
#pragma unroll
        for (int i = 0; i < 4; ++i) {
            const int srow = row0 + ty * 4 + i;
            const typename Epi::Row rw = epi.row(srow);
            float ss = epi(srow, col0 + tx * 8, acc[i], rw);
            ss += __shfl_xor(ss, 1); ss += __shfl_xor(ss, 2); ss += __shfl_xor(ss, 4);
            if ((tx & 7) == 0) epi.rowsum(srow, (col0 + tx * 8) >> 6, ss);
        }
    }
    __syncthreads();
}

struct DenseRM {
    const bf16_t* A; const bf16_t* Bt; int K;
    __device__ __forceinline__ int ntiles128() const { return T / 128; }
    __device__ __forceinline__ const bf16_t* arow(int r) const { return A + (size_t)r * K; }
    __device__ __forceinline__ const bf16_t* bt(int) const { return Bt; }
};
struct MoeTab { LAS int* ebase; LAS int* tile2e; LAS int* ecnt; };
__device__ __forceinline__ MoeTab moe_tables(Ctx& C, int layer) {
    MoeTab mt; mt.ebase = (LAS int*)(C.lds + LDS_MISC - 2048); mt.tile2e = mt.ebase + 64; mt.ecnt = mt.tile2e + 192;
    __syncthreads();
    if (C.tid == 0) {
        const unsigned* cnt = WSP(unsigned, WS_CTL) + CW_CNT + layer * 64; int b = 0;
        for (int e = 0; e < NEXP; ++e) { const int c = (int)__hip_atomic_load(cnt + e, __ATOMIC_RELAXED, __HIP_MEMORY_SCOPE_AGENT); mt.ecnt[e] = c; mt.ebase[e] = b; const int nt = (c + 255) >> 8;
            for (int t = 0; t < nt; ++t) mt.tile2e[b + t] = e; b += nt; }
        mt.ebase[NEXP] = b;
    }
    __syncthreads();
    return mt;
}
struct MoeRow { int e, pos, tok; };
__device__ __forceinline__ MoeRow moe_row(const MoeTab& mt, const int* list, int srow) {
    MoeRow r; const int t256 = srow >> 8; r.e = mt.tile2e[t256]; r.pos = (t256 - mt.ebase[r.e]) * 256 + (srow & 255);
    r.tok = (r.pos < mt.ecnt[r.e]) ? list[r.e * T + r.pos] : -1; return r;
}
struct MoeGatherRM {
    MoeTab mt; const int* list; const bf16_t* HB; const bf16_t* W;
    __device__ __forceinline__ int ntiles128() const { return mt.ebase[NEXP] * 2; }
    __device__ __forceinline__ const bf16_t* arow(int r) const { const MoeRow m = moe_row(mt, list, r); return m.tok >= 0 ? HB + (size_t)m.tok * D : nullptr; }
    __device__ __forceinline__ const bf16_t* bt(int r0) const { return W + (size_t)mt.tile2e[r0 >> 8] * D * D; }
};
struct MoeDownRM {
    MoeTab mt; const bf16_t* ACT; const bf16_t* W;
    __device__ __forceinline__ int ntiles128() const { return mt.ebase[NEXP] * 2; }
    __device__ __forceinline__ const bf16_t* arow(int r) const { return ACT + (size_t)r * DEXP; }
    __device__ __forceinline__ const bf16_t* bt(int r0) const { return W + (size_t)mt.tile2e[r0 >> 8] * D * DEXP; }
};

__device__ __forceinline__ float rs_from(const float* ss, int n, float inv_n) { float s = 0.f; for (int i = 0; i < n; ++i) s += ss[i]; return rsqrtf(s * inv_n + EPS); }
struct RowS { float s; };
struct EpiE1 {
    const float* ssq_h; bf16_t* P3; bf16_t* CQ; bf16_t* CKV; bf16_t* KPE; float* ssqx; const float* rope;
    typedef RowS Row;
    __device__ __forceinline__ Row row(int r) const { Row w; w.s = rs_from(ssq_h + r * 16, 16, 1.f / D); return w; }
    __device__ __forceinline__ float operator()(int r, int col, const float* v, const Row& w) const {
        float x[8];
#pragma unroll
        for (int i = 0; i < 8; ++i) x[i] = v[i] * w.s;
        float ss = 0.f;
        if (col < 1536) { *(u32x4*)(P3 + (size_t)r * 1536 + col) = pack8(x); }
        else if (col < 1920) { *(u32x4*)(CQ + (size_t)r * QR + (col - 1536)) = pack8(x);
#pragma unroll
            for (int i = 0; i < 8; ++i) ss += x[i] * x[i]; }
        else if (col < 1952) { const int f0 = (col - 1920) >> 1; float o[8];
#pragma unroll
            for (int i = 0; i < 4; ++i) { const float c = rope[(r * 16 + f0 + i) * 2], s = rope[(r * 16 + f0 + i) * 2 + 1]; o[2 * i] = x[2 * i] * c - x[2 * i + 1] * s; o[2 * i + 1] = x[2 * i + 1] * c + x[2 * i] * s; }
            *(u32x4*)(KPE + (size_t)r * 32 + (col - 1920)) = pack8(o); }
        else if (col < 2048) { }
        else { *(u32x4*)(CKV + (size_t)r * KVR + (col - 2048)) = pack8(x);
#pragma unroll
            for (int i = 0; i < 8; ++i) ss += x[i] * x[i]; }
        return ss;
    }
    __device__ __forceinline__ void rowsum(int r, int slot, float ss) const { ssqx[r * 36 + slot] = ss; }
};
struct EpiQ {
    const float* ssqx; bf16_t* Q; const float* rope;
    typedef RowS Row;
    __device__ __forceinline__ Row row(int r) const { Row w; w.s = rs_from(ssqx + r * 36 + 24, 8, 1.f / QR) * QSCALE; return w; }
    __device__ __forceinline__ float operator()(int r, int col, const float* v, const Row& w) const {
        float x[8];
#pragma unroll
        for (int i = 0; i < 8; ++i) x[i] = v[i] * w.s;
        const int dd = col % 96;
        if (dd >= 64) { const int f0 = (dd - 64) >> 1; float o[8];
#pragma unroll
            for (int i = 0; i < 4; ++i) { const float c = rope[(r * 16 + f0 + i) * 2], s = rope[(r * 16 + f0 + i) * 2 + 1]; o[2 * i] = x[2 * i] * c - x[2 * i + 1] * s; o[2 * i + 1] = x[2 * i + 1] * c + x[2 * i] * s; }
            *(u32x4*)(Q + (size_t)r * 768 + col) = pack8(o);
        } else *(u32x4*)(Q + (size_t)r * 768 + col) = pack8(x);
        return 0.f;
    }
    __device__ __forceinline__ void rowsum(int, int, float) const {}
};
struct EpiKV {
    const float* ssqx; bf16_t* KV;
    typedef RowS Row;
    __device__ __forceinline__ Row row(int r) const { Row w; w.s = rs_from(ssqx + r * 36 + 32, 4, 1.f / KVR); return w; }
    __device__ __forceinline__ float operator()(int r, int col, const float* v, const Row& w) const {
        float x[8];
#pragma unroll
        for (int i = 0; i < 8; ++i) x[i] = v[i] * w.s;
        *(u32x4*)(KV + (size_t)r * 1024 + col) = pack8(x); return 0.f;
    }
    __device__ __forceinline__ void rowsum(int, int, float) const {}
};
struct EpiRes {
    float* H; bf16_t* HB; float* ssq;
    typedef RowS Row;
    __device__ __forceinline__ Row row(int) const { Row w; w.s = 1.f; return w; }
    __device__ __forceinline__ float operator()(int r, int col, const float* v, const Row&) const {
        f32x4* hp = (f32x4*)(H + (size_t)r * D + col); const f32x4 a = hp[0], b = hp[1];
        float x[8] = {a.x + v[0], a.y + v[1], a.z + v[2], a.w + v[3], b.x + v[4], b.y + v[5], b.z + v[6], b.w + v[7]};
        hp[0] = (f32x4){x[0], x[1], x[2], x[3]}; hp[1] = (f32x4){x[4], x[5], x[6], x[7]};
        *(u32x4*)(HB + (size_t)r * D + col) = pack8(x);
        float ss = 0.f;
#pragma unroll
        for (int i = 0; i < 8; ++i) ss += x[i] * x[i];
        return ss;
    }
    __device__ __forceinline__ void rowsum(int r, int slot, float ss) const { ssq[r * 16 + slot] = ss; }
};
struct EpiGelu {
    const float* ssq_h; bf16_t* Z; float* ssqx;
    typedef RowS Row;
    __device__ __forceinline__ Row row(int r) const { Row w; w.s = rs_from(ssq_h + r * 16, 16, 1.f / D); return w; }
    __device__ __forceinline__ float operator()(int r, int col, const float* v, const Row& w) const {
        float x[8]; float ss = 0.f;
#pragma unroll
        for (int i = 0; i < 8; ++i) { x[i] = gelu_tanh(v[i] * w.s); ss += x[i] * x[i]; }
        *(u32x4*)(Z + (size_t)r * 2048 + col) = pack8(x);
        return col >= 1024 ? ss : 0.f;
    }
    __device__ __forceinline__ void rowsum(int r, int slot, float ss) const { ssqx[r * 36 + slot] = ss; }
};
struct RowM { float s; int ok; };
struct EpiGU {
    MoeTab mt; const int* list; const float* rffn; bf16_t* ACT;
    typedef RowM Row;
    __device__ __forceinline__ Row row(int r) const { const MoeRow m = moe_row(mt, list, r); Row w; w.ok = m.tok >= 0; w.s = w.ok ? rffn[m.tok] : 0.f; return w; }
    __device__ __forceinline__ float operator()(int r, int col, const float* v, const Row& w) const {
        float a[4];
#pragma unroll
        for (int i = 0; i < 4; ++i) { const float g = v[i] * w.s, u = v[4 + i] * w.s; a[i] = g * sigmoidf_(g) * u; }
        u32x2 o; o.x = pk2(a[0], a[1]); o.y = pk2(a[2], a[3]);
        *(u32x2*)(ACT + (size_t)r * DEXP + (col >> 1)) = o;
        return 0.f;
    }
    __device__ __forceinline__ void rowsum(int, int, float) const {}
};
struct EpiDown {
    MoeTab mt; const int* list; const float* lw; bf16_t* Y;
    typedef RowM Row;
    __device__ __forceinline__ Row row(int r) const { const MoeRow m = moe_row(mt, list, r); Row w; w.ok = m.tok >= 0; w.s = w.ok ? lw[m.e * T + m.pos] : 0.f; return w; }
    __device__ __forceinline__ float operator()(int r, int col, const float* v, const Row& w) const {
        if (w.ok) { float x[8];
#pragma unroll
            for (int i = 0; i < 8; ++i) x[i] = v[i] * w.s;
            *(u32x4*)(Y + (size_t)r * D + col) = pack8(x); }
        return 0.f;
    }
    __device__ __forceinline__ void rowsum(int, int, float) const {}
};
struct EpiPP {
    bf16_t* PP;
    typedef RowS Row;
    __device__ __forceinline__ Row row(int) const { Row w; w.s = 1.f; return w; }
    __device__ __forceinline__ float operator()(int r, int col, const float* v, const Row&) const { *(u32x4*)(PP + (size_t)r * D + col) = pack8(v); return 0.f; }
    __device__ __forceinline__ void rowsum(int, int, float) const {}
};
struct EpiPLE {
    const float* ssq_in; const bf16_t* PP; float* H; bf16_t* HB; float* ssq;
    typedef RowS Row;
    __device__ __forceinline__ Row row(int r) const { Row w; w.s = rs_from(ssq_in + r * 16, 16, 1.f / D); return w; }
    __device__ __forceinline__ float operator()(int r, int col, const float* v, const Row& w) const {
        float pp[8]; unpack8(*(const u32x4*)(PP + (size_t)r * D + col), pp);
        f32x4* hp = (f32x4*)(H + (size_t)r * D + col); const f32x4 a = hp[0], b = hp[1];
        const float h0[8] = {a.x, a.y, a.z, a.w, b.x, b.y, b.z, b.w};
        float x[8]; float ss = 0.f;
#pragma unroll
        for (int i = 0; i < 8; ++i) { x[i] = h0[i] + sigmoidf_(v[i] * w.s) * pp[i]; ss += x[i] * x[i]; }
        hp[0] = (f32x4){x[0], x[1], x[2], x[3]}; hp[1] = (f32x4){x[4], x[5], x[6], x[7]};
        *(u32x4*)(HB + (size_t)r * D + col) = pack8(x);
        return ss;
    }
    __device__ __forceinline__ void rowsum(int r, int slot, float ss) const { ssq[r * 16 + slot] = ss; }
};


namespace pg8 {
constexpr int BM = 256, BK = 64, HALF = 128, HTB = HALF * BK * 2, STAGE_BYTES = 8 * HTB, NXCD = 8, WGM = 8;
__host__ __device__ __forceinline__ int lds_byte(int r, int c) { const int st = (r >> 4) * 2 + (c >> 5), rr = r & 15, cc = c & 31, ob = rr * 64 + cc * 2; return st * 1024 + (ob ^ (((ob >> 9) & 1) << 5)); }
__host__ __device__ __forceinline__ void stage_rc(int b, int& R, int& C) { const int st = b / 1024, sb = b % 1024, swz = sb ^ (((sb >> 9) & 1) << 5); R = (st >> 1) * 16 + swz / 64; C = (st & 1) * 32 + (swz % 64) / 2; }
__host__ __device__ __forceinline__ int perm32(int rho) { const int n = rho >> 4, i = rho & 15; return 8 * (i >> 2) + 4 * n + (i & 3); }
struct Unit { int pm, pn; };
struct StaticOrder {
    int nM, nN, nwg, G, c;
    __device__ void init(int M, int N, int G_, int c_) { nM = M / BM; nN = N / BM; nwg = nM * nN; G = G_; c = c_; }
    __device__ bool next(int i, Unit& u) const {
        const long L = (long)i * G + c; if (L >= nwg) return false;
        int wgid = (int)L; { const int q = nwg / NXCD, r = nwg % NXCD, xcd = wgid % NXCD, off = wgid / NXCD; wgid = (xcd < r ? xcd * (q + 1) : r * (q + 1) + (xcd - r) * q) + off; }
        const int nig = WGM * nN, gid = wgid / nig, fm = gid * WGM, gsz = (nM - fm) < WGM ? (nM - fm) : WGM;
        u.pm = fm + ((wgid % nig) % gsz); u.pn = (wgid % nig) / gsz; return true;
    }
};
struct MoeOrder {
    int ntile, G, c;
    __device__ bool next(int i, Unit& u) const { const int L = i * G + c; if (L >= ntile * 4) return false; u.pm = L >> 2; u.pn = L & 3; return true; }
};
template <class Prob, class Epi, class Sched>
__device__ __forceinline__ void gemm_phase(LAS unsigned char* lds, int tid, const Prob& P, const Sched& S, const Epi& E) {
    constexpr bool GATHER = Prob::GATHER;
    const int wid = __builtin_amdgcn_readfirstlane(tid >> 6), lane = tid & 63, wr = wid >> 2, wc = wid & 3, fr = lane & 15, fq = lane >> 4;
    const int K = P.K, nt = K / BK;
    unsigned voffA[2], voffB[2]; int RA[2], CA2[2];
#pragma unroll
    for (int i = 0; i < 2; ++i) { int R, C; stage_rc(tid * 16 + i * 8192, R, C); const int Rb = (R & ~31) + perm32(R & 31);
        voffA[i] = (unsigned)(R * K + C) * 2u; voffB[i] = (unsigned)(Rb * K + C) * 2u; RA[i] = R; CA2[i] = C * 2; }
    const size_t kstep = (size_t)(BK * 2);
    const size_t hstep = (size_t)HALF * K * 2;
    const unsigned ldsw = (unsigned)wid * 1024u;
    const int aoff = lds_byte(wr * 64 + fr, fq * 8), boff = lds_byte(wc * 32 + fr, fq * 8);
#define PG8_SA(b, h) (((b) * 2 + (h)) * HTB)
#define PG8_SB(b, h) ((4 + (b) * 2 + (h)) * HTB)
#define PG8_STAGE2(bufoff, gbase, v0, v1) do { \
        __builtin_amdgcn_global_load_lds((const unsigned*)((const char*)(gbase) + (v0)), (LAS unsigned*)(lds + (bufoff) + ldsw), 16, 0, 0); \
        __builtin_amdgcn_global_load_lds((const unsigned*)((const char*)(gbase) + (v1)), (LAS unsigned*)(lds + (bufoff) + ldsw + 8192), 16, 0, 0); } while (0)
#define PG8_STAGE_B(bufoff, gbase) PG8_STAGE2(bufoff, gbase, voffB[0], voffB[1])
#define PG8_STAGE_A(bufoff, gbase, h, nx) do { if constexpr (GATHER) { PG8_STAGE2(bufoff, gbase, (nx) ? nvA[h][0] : cvA[h][0], (nx) ? nvA[h][1] : cvA[h][1]); } \
        else { PG8_STAGE2(bufoff, (gbase) + (h) * hstep, voffA[0], voffA[1]); } } while (0)
#define PG8_LDA(dst, b, h) do { _Pragma("unroll") for (int m = 0; m < 4; ++m) _Pragma("unroll") for (int k = 0; k < 2; ++k) dst[m][k] = *(const LAS bf16x8*)(lds + PG8_SA(b, h) + aoff + m * 2048 + k * 1024); } while (0)
#define PG8_LDB(dst, b, h) do { _Pragma("unroll") for (int n = 0; n < 2; ++n) _Pragma("unroll") for (int k = 0; k < 2; ++k) dst[n][k] = *(const LAS bf16x8*)(lds + PG8_SB(b, h) + boff + n * 2048 + k * 1024); } while (0)
#define PG8_MMA(ai, bj, At, Bt) do { __builtin_amdgcn_s_setprio(1); _Pragma("unroll") for (int m = 0; m < 4; ++m) _Pragma("unroll") for (int n = 0; n < 2; ++n) _Pragma("unroll") for (int k = 0; k < 2; ++k) \
        acc[ai][bj][m][n] = __builtin_amdgcn_mfma_f32_16x16x32_bf16(Bt[n][k], At[m][k], acc[ai][bj][m][n], 0, 0, 0); __builtin_amdgcn_s_setprio(0); } while (0)
#define PG8_WAIT_V(n) asm volatile("s_waitcnt vmcnt(" #n ")" ::: "memory")
#define PG8_WAIT_L(n) asm volatile("s_waitcnt lgkmcnt(" #n ")" ::: "memory")
#define PG8_BAR __builtin_amdgcn_s_barrier()
#define PG8_SCHED __builtin_amdgcn_sched_barrier(0)
    Unit cur, nxt; int ui = 0;
    if (!S.next(0, cur)) return;
    f32x4 acc[2][2][4][2];
#pragma unroll
    for (int a = 0; a < 2; ++a)
#pragma unroll
        for (int b = 0; b < 2; ++b)
#pragma unroll
            for (int m = 0; m < 4; ++m)
#pragma unroll
                for (int n = 0; n < 2; ++n) acc[a][b][m][n] = (f32x4){0.f, 0.f, 0.f, 0.f};
    bf16x8 At[4][2], B0[2][2], B1[2][2];
    unsigned cvA[2][2], nvA[2][2];
    if constexpr (GATHER) {
#pragma unroll
        for (int h = 0; h < 2; ++h)
#pragma unroll
            for (int i = 0; i < 2; ++i) { cvA[h][i] = P.arow_off(cur, h * HALF + RA[i]) + (unsigned)CA2[i]; nvA[h][i] = cvA[h][i]; }
    } else { cvA[0][0] = cvA[0][1] = cvA[1][0] = cvA[1][1] = 0u; nvA[0][0] = nvA[0][1] = nvA[1][0] = nvA[1][1] = 0u; }
    const char* cA = P.abase(cur); const char* cB = P.bbase(cur);
    PG8_STAGE_B(PG8_SB(0, 0), cB); PG8_STAGE_B(PG8_SB(0, 1), cB + hstep); PG8_STAGE_A(PG8_SA(0, 0), cA, 0, false); PG8_STAGE_A(PG8_SA(0, 1), cA, 1, false);
    if (wr == 1) PG8_BAR;
    PG8_WAIT_V(2); PG8_BAR;
    PG8_STAGE_B(PG8_SB(1, 0), cB + kstep); PG8_STAGE_A(PG8_SA(1, 0), cA + kstep, 0, false); PG8_STAGE_B(PG8_SB(1, 1), cB + hstep + kstep);
    PG8_WAIT_V(6); PG8_BAR;
    for (;;) {
        const bool has_next = S.next(ui + 1, nxt);
        const char* nA = has_next ? P.abase(nxt) : cA; const char* nB = has_next ? P.bbase(nxt) : cB;
        if constexpr (GATHER) {
            if (has_next) {
#pragma unroll
                for (int h = 0; h < 2; ++h)
#pragma unroll
                    for (int i = 0; i < 2; ++i) nvA[h][i] = P.arow_off(nxt, h * HALF + RA[i]) + (unsigned)CA2[i];
            }
        }
        for (int t = 0; t < nt; t += 2) {
            const bool last = (t == nt - 2);
            const char* a1 = cA + (size_t)(t + 1) * kstep;
            const char* a2 = last ? nA : cA + (size_t)(t + 2) * kstep; const char* b2 = last ? nB : cB + (size_t)(t + 2) * kstep;
            const char* a3 = a2 + kstep; const char* b3 = b2 + kstep;
            PG8_LDB(B0, 0, 0); PG8_LDB(B1, 0, 1); PG8_SCHED; PG8_LDA(At, 0, 0); PG8_STAGE_A(PG8_SA(1, 1), a1, 1, false);
            PG8_WAIT_V(8); PG8_WAIT_L(0); PG8_BAR; PG8_MMA(0, 0, At, B0); PG8_MMA(0, 1, At, B1); PG8_BAR; PG8_SCHED;
            PG8_LDA(At, 0, 1); PG8_STAGE_B(PG8_SB(0, 0), b2); PG8_STAGE_B(PG8_SB(0, 1), b2 + hstep); PG8_STAGE_A(PG8_SA(0, 0), a2, 0, last);
            PG8_WAIT_V(8); PG8_WAIT_L(0); PG8_BAR; PG8_MMA(1, 0, At, B0); PG8_MMA(1, 1, At, B1); PG8_BAR; PG8_SCHED;
            PG8_LDB(B0, 1, 0); PG8_LDB(B1, 1, 1); PG8_SCHED; PG8_LDA(At, 1, 0); PG8_STAGE_A(PG8_SA(0, 1), a2, 1, last);
            PG8_WAIT_V(8); PG8_WAIT_L(0); PG8_BAR; PG8_MMA(0, 0, At, B0); PG8_MMA(0, 1, At, B1); PG8_BAR; PG8_SCHED;
            PG8_LDA(At, 1, 1); PG8_STAGE_B(PG8_SB(1, 0), b3); PG8_STAGE_B(PG8_SB(1, 1), b3 + hstep); PG8_STAGE_A(PG8_SA(1, 0), a3, 0, last);
            PG8_WAIT_V(8); PG8_WAIT_L(0); PG8_BAR; PG8_MMA(1, 0, At, B0); PG8_MMA(1, 1, At, B1); PG8_BAR; PG8_SCHED;
        }
        if (wr == 0) PG8_BAR;
        { int fr_e = fr, fq_e = fq; asm volatile("" : "+v"(fr_e), "+v"(fq_e));
          E(acc, cur, wr, wc, fr_e, fq_e); }
        if (!has_next) break;
#pragma unroll
        for (int a = 0; a < 2; ++a)
#pragma unroll
            for (int b = 0; b < 2; ++b)
#pragma unroll
                for (int m = 0; m < 4; ++m)
#pragma unroll
                    for (int n = 0; n < 2; ++n) acc[a][b][m][n] = (f32x4){0.f, 0.f, 0.f, 0.f};
        cur = nxt; cA = nA; cB = nB; ++ui;
        if constexpr (GATHER) {
#pragma unroll
            for (int h = 0; h < 2; ++h)
#pragma unroll
                for (int i = 0; i < 2; ++i) cvA[h][i] = nvA[h][i];
        }
        if (wr == 1) PG8_BAR;
    }
    PG8_WAIT_V(0);
    PG8_BAR;
#undef PG8_SA
#undef PG8_SB
#undef PG8_STAGE2
#undef PG8_STAGE_A
#undef PG8_STAGE_B
#undef PG8_LDA
#undef PG8_LDB
#undef PG8_MMA
#undef PG8_WAIT_V
#undef PG8_WAIT_L
#undef PG8_BAR
#undef PG8_SCHED
}
template <class E> struct EpiAdapt {
    E e;
    __device__ __forceinline__ void operator()(const f32x4 (&acc)[2][2][4][2], const Unit& u, int wr, int wc, int fr, int fq) const {
#pragma unroll
        for (int ai = 0; ai < 2; ++ai)
#pragma unroll
            for (int m = 0; m < 4; ++m) {
                const int row = u.pm * BM + ai * HALF + wr * 64 + m * 16 + fr;
                const typename E::Row rw = e.row(row);
                float ss = 0.f;
#pragma unroll
                for (int bj = 0; bj < 2; ++bj) {
                    const int col = u.pn * BM + bj * HALF + wc * 32 + fq * 8;
                    const f32x4 a0 = acc[ai][bj][m][0], a1 = acc[ai][bj][m][1];
                    const float v[8] = {a0[0], a0[1], a0[2], a0[3], a1[0], a1[1], a1[2], a1[3]};
                    ss += e(row, col, v, rw);
                }
                ss += __shfl_xor(ss, 16); ss += __shfl_xor(ss, 32);
                if (fq == 0) e.rowsum(row, u.pn * 4 + wc, ss);
            }
    }
};
struct DenseProb {
    static constexpr bool GATHER = false;
    const bf16_t* A; const bf16_t* Bt; int K;
    __device__ __forceinline__ const char* abase(const Unit& u) const { return (const char*)A + (size_t)u.pm * BM * K * 2; }
    __device__ __forceinline__ unsigned arow_off(const Unit&, int) const { return 0u; }
    __device__ __forceinline__ const char* bbase(const Unit& u) const { return (const char*)Bt + (size_t)u.pn * BM * K * 2; }
};
}
struct MoeGatherProb {
    static constexpr bool GATHER = true;
    MoeTab mt; const int* list; const bf16_t* HB; const bf16_t* W; int K;
    __device__ __forceinline__ const char* abase(const pg8::Unit&) const { return (const char*)HB; }
    __device__ __forceinline__ unsigned arow_off(const pg8::Unit& u, int r) const { const MoeRow m = moe_row(mt, list, u.pm * 256 + r); return (unsigned)(m.tok >= 0 ? m.tok : 0) * (unsigned)(D * 2); }
    __device__ __forceinline__ const char* bbase(const pg8::Unit& u) const { return (const char*)W + ((size_t)mt.tile2e[u.pm] * D + (size_t)u.pn * 256) * D * 2; }
};
struct MoeDownProb {
    static constexpr bool GATHER = false;
    MoeTab mt; const bf16_t* ACT; const bf16_t* W; int K;
    __device__ __forceinline__ const char* abase(const pg8::Unit& u) const { return (const char*)ACT + (size_t)u.pm * 256 * DEXP * 2; }
    __device__ __forceinline__ unsigned arow_off(const pg8::Unit&, int) const { return 0u; }
    __device__ __forceinline__ const char* bbase(const pg8::Unit& u) const { return (const char*)W + ((size_t)mt.tile2e[u.pm] * D + (size_t)u.pn * 256) * DEXP * 2; }
};
template <class E> __device__ __forceinline__ void gemm_dense(Ctx& C, const bf16_t* A, const bf16_t* Bt, int N, int K, const E& e) {
    pg8::DenseProb P{A, Bt, K}; pg8::StaticOrder S; S.init(T, N, C.nblk, C.bid); pg8::EpiAdapt<E> ea{e};
    pg8::gemm_phase(C.lds, C.tid, P, S, ea);
}

__device__ __forceinline__ void phase_conv(Ctx& C, int j) {
    const bf16_t* P3 = WSP(bf16_t, WS_P3); bf16_t* MIX = WSP(bf16_t, WS_MIX); const float* cw = WSP(float, WS_PAR) + PAR_CONV + (size_t)j * 3 * 512;
    const int gt = C.bid * NTHREADS + C.tid, NGT = C.nblk * NTHREADS;
    for (int i = gt; i < T * 64; i += NGT) {
        const int t = i >> 6, c = (i & 63) * 8, s = t & (SEQ - 1);
        float acc[8];
#pragma unroll
        for (int q = 0; q < 8; ++q) acc[q] = 0.f;
#pragma unroll
        for (int k = 0; k < 3; ++k) {
            const int dt = 2 - k;
            if (s - dt >= 0) {
                float xc[8], gc[8]; unpack8(*(const u32x4*)(P3 + (size_t)(t - dt) * 1536 + c), xc); unpack8(*(const u32x4*)(P3 + (size_t)(t - dt) * 1536 + 1024 + c), gc);
#pragma unroll
                for (int q = 0; q < 8; ++q) acc[q] += cw[k * 512 + c + q] * (gc[q] * xc[q]);
            }
        }
        float gb[8]; unpack8(*(const u32x4*)(P3 + (size_t)t * 1536 + 512 + c), gb);
#pragma unroll
        for (int q = 0; q < 8; ++q) acc[q] *= gb[q];
        *(u32x4*)(MIX + (size_t)t * D + c) = pack8(acc);
    }
}

__device__ __forceinline__ void phase_attn_naive(Ctx& C) {
    const bf16_t* Q = WSP(bf16_t, WS_Q); const bf16_t* KV = WSP(bf16_t, WS_KV); const bf16_t* KPE = WSP(bf16_t, WS_KPE); bf16_t* MIX = WSP(bf16_t, WS_MIX);
    LAS float* Ks = (LAS float*)C.lds;
    LAS float* Vs = Ks + 64 * 97;
    LAS float* Qs = Vs + 64 * 64;
    LAS float* Ps = Qs + 64 * 96;
    const int tid = C.tid, lane = C.lane, wave = C.wave;
    const int nunits = NBATCH * NH * (SEQ / 64);
    for (int u = C.bid; u < nunits; u += C.nblk) {
        const int qb = (SEQ / 64 - 1) - (u / (NBATCH * NH)), bh = u % (NBATCH * NH), b = bh / NH, h = bh % NH;
        const int t0 = b * SEQ + qb * 64;
        __syncthreads();
        for (int i = tid; i < 64 * 12; i += NTHREADS) { const int r = i / 12, c8 = (i % 12) * 8; float v[8]; unpack8(*(const u32x4*)(Q + (size_t)(t0 + r) * 768 + h * 96 + c8), v);
#pragma unroll
            for (int q = 0; q < 8; ++q) Qs[r * 96 + c8 + q] = v[q]; }
        float m[8], l[8], o[8];
#pragma unroll
        for (int i = 0; i < 8; ++i) { m[i] = -1e30f; l[i] = 0.f; o[i] = 0.f; }
        for (int kt = 0; kt <= qb; ++kt) {
            const int k0 = b * SEQ + kt * 64;
            __syncthreads();
            for (int i = tid; i < 64 * 20; i += NTHREADS) { const int r = i / 20, c = i % 20; float v[8];
                if (c < 8) { unpack8(*(const u32x4*)(KV + (size_t)(k0 + r) * 1024 + h * 128 + c * 8), v);
#pragma unroll
                    for (int q = 0; q < 8; ++q) Ks[r * 97 + c * 8 + q] = v[q]; }
                else if (c < 12) { unpack8(*(const u32x4*)(KPE + (size_t)(k0 + r) * 32 + (c - 8) * 8), v);
#pragma unroll
                    for (int q = 0; q < 8; ++q) Ks[r * 97 + c * 8 + q] = v[q]; }
                else { unpack8(*(const u32x4*)(KV + (size_t)(k0 + r) * 1024 + h * 128 + 64 + (c - 12) * 8), v);
#pragma unroll
                    for (int q = 0; q < 8; ++q) Vs[r * 64 + (c - 12) * 8 + q] = v[q]; } }
            __syncthreads();
#pragma unroll
            for (int qi = 0; qi < 8; ++qi) {
                const int qr = wave * 8 + qi;
                float s = 0.f;
                for (int d = 0; d < 96; ++d) s += Qs[qr * 96 + d] * Ks[lane * 97 + d];
                if (kt == qb && lane > qr) s = -1e30f;
                const float mn = fmaxf(m[qi], wave_max(s));
                const float p = exp2f(s - mn), al = exp2f(m[qi] - mn);
                const float pb = rbf(p);
                l[qi] = l[qi] * al + wave_sum(p); m[qi] = mn;
                Ps[wave * 64 + lane] = pb;
                asm volatile("s_waitcnt lgkmcnt(0)" ::: "memory");
                float acc = 0.f;
                for (int k = 0; k < 64; ++k) acc += Ps[wave * 64 + k] * Vs[k * 64 + lane];
                o[qi] = o[qi] * al + acc;
                asm volatile("s_waitcnt lgkmcnt(0)" ::: "memory");
            }
        }
#pragma unroll
        for (int qi = 0; qi < 8; ++qi) MIX[(size_t)(t0 + wave * 8 + qi) * D + 512 + h * 64 + lane] = (bf16_t)f2bf(o[qi] / l[qi]);
    }
    __syncthreads();
}

__device__ __forceinline__ void phase_sg_naive(Ctx& C, int j) {
    const bf16_t* Z = WSP(bf16_t, WS_Z); const float* ssqx = WSP(float, WS_SSQX); const bf16_t* WS = WSP(bf16_t, WS_WS) + (size_t)j * 8 * 128 * 128; bf16_t* MIX = WSP(bf16_t, WS_MIX);
    const float* vg = WSP(float, WS_PAR) + PAR_VN + j * D; const float* bs = WSP(float, WS_PAR) + PAR_BS + (size_t)j * 8 * 128;
    LAS float* Wt = (LAS float*)C.lds;
    LAS float* Vn = Wt + 128 * 129;
    const int tid = C.tid;
    for (int u = C.bid; u < NBATCH * 32 * 8; u += C.nblk) {
        const int g = u & 7, bc = u >> 3, t0 = bc * 128;
        __syncthreads();
        for (int i = tid; i < 128 * 16; i += NTHREADS) { const int r = i >> 4, c8 = (i & 15) * 8; float v[8];
            unpack8(*(const u32x4*)(WS + (size_t)g * 16384 + r * 128 + c8), v);
#pragma unroll
            for (int q = 0; q < 8; ++q) Wt[r * 129 + c8 + q] = v[q];
            unpack8(*(const u32x4*)(Z + (size_t)(t0 + r) * 2048 + 1024 + g * 128 + c8), v);
            const float rv = rs_from(ssqx + (t0 + r) * 36 + 16, 16, 1.f / 1024);
#pragma unroll
            for (int q = 0; q < 8; ++q) Vn[r * 128 + c8 + q] = rbf(v[q] * rv * vg[g * 128 + c8 + q]); }
        __syncthreads();
        const int t = tid >> 2, d0 = (tid & 3) * 32;
        float acc[32];
#pragma unroll
        for (int i = 0; i < 32; ++i) acc[i] = 0.f;
        for (int s = 0; s <= t; ++s) { const float w = Wt[t * 129 + s];
#pragma unroll
            for (int i = 0; i < 32; ++i) acc[i] += w * Vn[s * 128 + d0 + i]; }
        const float bias = bs[g * 128 + t];
#pragma unroll
        for (int i8 = 0; i8 < 4; ++i8) { float uu[8], o[8]; unpack8(*(const u32x4*)(Z + (size_t)(t0 + t) * 2048 + g * 128 + d0 + i8 * 8), uu);
#pragma unroll
            for (int q = 0; q < 8; ++q) o[q] = uu[q] * (acc[i8 * 8 + q] + bias);
            *(u32x4*)(MIX + (size_t)(t0 + t) * D + g * 128 + d0 + i8 * 8) = pack8(o); }
    }
    __syncthreads();
}

__device__ __forceinline__ void phase_router(Ctx& C, int layer) {
    const bf16_t* HB = WSP(bf16_t, WS_HB0); const float* ssq = WSP(float, WS_SSQ0); const bf16_t* WR = WSP(bf16_t, WS_WR) + (size_t)layer * 64 * D;
    int* tok_e = WSP(int, WS_TOK); int* tok_pos = tok_e + 2 * T; float* rffn = (float*)(tok_pos + 2 * T);
    int* list = WSP(int, WS_LIST); float* lw = WSP(float, WS_LW); unsigned* cnt = WSP(unsigned, WS_CTL) + CW_CNT + layer * 64;
    LAS u32x4* Wl = (LAS u32x4*)C.lds;
    const int lane = C.lane;
    __syncthreads();
    for (int i = C.tid; i < 36 * 128; i += NTHREADS) Wl[i] = *(const u32x4*)(WR + (size_t)i * 8);
    __syncthreads();
    const int gw = C.bid * NWAVES + C.wave, NGW = C.nblk * NWAVES;
    for (int m = gw; m < T; m += NGW) {
        const float r = rs_from(ssq + m * 16, 16, 1.f / D);
        float x0[8], x1[8];
        unpack8(*(const u32x4*)(HB + (size_t)m * D + lane * 8), x0); unpack8(*(const u32x4*)(HB + (size_t)m * D + 512 + lane * 8), x1);
        LAS float* lgs = (LAS float*)(C.lds + 36 * 128 * 16) + C.wave * 64;
#pragma unroll 2
        for (int n = 0; n < 36; ++n) {
            float w0[8], w1[8]; unpack8(Wl[n * 128 + lane], w0); unpack8(Wl[n * 128 + 64 + lane], w1);
            float s = 0.f;
#pragma unroll
            for (int i = 0; i < 8; ++i) s += x0[i] * w0[i] + x1[i] * w1[i];
            s = wave_sum(s) * r;
            if (lane == 0) lgs[n] = s;
        }
        asm volatile("s_waitcnt lgkmcnt(0)" ::: "memory");
        const float g0 = lgs[0], g1 = lgs[1], g2 = lgs[2], g3 = lgs[3];
        int g = 0; float gm = g0;
        if (g1 > gm) { gm = g1; g = 1; }
        if (g2 > gm) { gm = g2; g = 2; }
        if (g3 > gm) { gm = g3; g = 3; }
        const float gs = __expf(g0 - gm) + __expf(g1 - gm) + __expf(g2 - gm) + __expf(g3 - gm);
        const float gw_ = 1.0f / gs;
        float el[8];
#pragma unroll
        for (int q = 0; q < 8; ++q) el[q] = lgs[4 + g * 8 + q];
        asm volatile("s_waitcnt lgkmcnt(0)" ::: "memory");
        int i1 = 0; float m1 = el[0];
#pragma unroll
        for (int q = 1; q < 8; ++q) if (el[q] > m1) { m1 = el[q]; i1 = q; }
        int i2 = -1; float m2 = -3.0e38f;
#pragma unroll
        for (int q = 0; q < 8; ++q) if (q != i1 && el[q] > m2) { m2 = el[q]; i2 = q; }
        const float e2 = __expf(m2 - m1), p1 = 1.0f / (1.0f + e2), p2 = e2 / (1.0f + e2);
        if (lane == 0) {
            rffn[m] = r;
            const int ea = g * 8 + i1, eb = g * 8 + i2;
            const int pa = (int)atomicAdd(cnt + ea, 1u), pb = (int)atomicAdd(cnt + eb, 1u);
            list[ea * T + pa] = m; lw[ea * T + pa] = gw_ * p1; list[eb * T + pb] = m; lw[eb * T + pb] = gw_ * p2;
            tok_e[2 * m] = ea; tok_e[2 * m + 1] = eb; tok_pos[2 * m] = pa; tok_pos[2 * m + 1] = pb;
        }
    }
    __syncthreads();
}

__device__ __forceinline__ void phase_combine(Ctx& C, int layer) {
    const MoeTab mt = moe_tables(C, layer);
    float* H = WSP(float, WS_H); bf16_t* HB = WSP(bf16_t, WS_HB1); float* SS = WSP(float, WS_SSQ1); const bf16_t* Y = WSP(bf16_t, WS_Y);
    const int* tok_e = WSP(int, WS_TOK); const int* tok_pos = tok_e + 2 * T;
    const int gw = C.bid * NWAVES + C.wave, NGW = C.nblk * NWAVES, lane = C.lane;
    for (int m = gw; m < T; m += NGW) {
        const int ea = tok_e[2 * m], eb = tok_e[2 * m + 1];
        const size_t sa = (size_t)mt.ebase[ea] * 256 + tok_pos[2 * m], sb = (size_t)mt.ebase[eb] * 256 + tok_pos[2 * m + 1];
        f32x4* hr = (f32x4*)(H + (size_t)m * D) + lane; const u32x2* ya = (const u32x2*)(Y + sa * D) + lane; const u32x2* yb = (const u32x2*)(Y + sb * D) + lane;
        u32x2* ob = (u32x2*)(HB + (size_t)m * D) + lane; float s = 0.f;
#pragma unroll
        for (int j = 0; j < 4; ++j) {
            f32x4 v = hr[64 * j]; const u32x2 a = ya[64 * j], b = yb[64 * j];
            v.x += bf2f(a.x & 0xffffu) + bf2f(b.x & 0xffffu); v.y += bf2f(a.x >> 16) + bf2f(b.x >> 16); v.z += bf2f(a.y & 0xffffu) + bf2f(b.y & 0xffffu); v.w += bf2f(a.y >> 16) + bf2f(b.y >> 16);
            hr[64 * j] = v; s += (v.x * v.x + v.y * v.y) + (v.z * v.z + v.w * v.w); u32x2 o; o.x = pk2(v.x, v.y); o.y = pk2(v.z, v.w); ob[64 * j] = o;
        }
        s = wave_sum(s);
        if (lane < 16) SS[m * 16 + lane] = (lane == 0) ? s : 0.f;
    }
    __syncthreads();
}

__device__ __forceinline__ void phase_final(Ctx& C, float* outp) {
    const float* H = WSP(float, WS_H); const float* SS = WSP(float, WS_SSQ0); const float* g = WSP(float, WS_PAR) + PAR_FN;
    const int gw = C.bid * NWAVES + C.wave, NGW = C.nblk * NWAVES, lane = C.lane;
    for (int m = gw; m < T; m += NGW) {
        const float r = rs_from(SS + m * 16, 16, 1.f / D);
        const f32x4* hr = (const f32x4*)(H + (size_t)m * D) + lane; f32x4* o = (f32x4*)(outp + (size_t)m * D) + lane; const f32x4* gg = (const f32x4*)g + lane;
#pragma unroll
        for (int j = 0; j < 4; ++j) { const f32x4 v = hr[64 * j], w = gg[64 * j]; o[64 * j] = (f32x4){v.x * r * w.x, v.y * r * w.y, v.z * r * w.z, v.w * r * w.w}; }
    }
}

constexpr int NPHASES = 42;
template <int ph> __device__ __forceinline__ void run_phase(Ctx& C) {
    constexpr int layer = (ph - 1) / 10, sub = (ph - 1) % 10, j = layer >> 1; constexpr bool even = (layer & 1) == 0;
    float* H = WSP(float, WS_H); bf16_t* HB0 = WSP(bf16_t, WS_HB0); bf16_t* HB1 = WSP(bf16_t, WS_HB1); float* SSQ0 = WSP(float, WS_SSQ0); float* SSQ1 = WSP(float, WS_SSQ1); float* SSQX = WSP(float, WS_SSQX);
    const float* ROPE = WSP(float, WS_ROPE); bf16_t* MIX = WSP(bf16_t, WS_MIX);
    switch (sub) {
    case 0:
        if (even) { const bf16_t* W = WSP(bf16_t, WS_WINE) + (size_t)j * EINP * D; EpiE1 e{SSQ0, WSP(bf16_t, WS_P3), WSP(bf16_t, WS_CQ), WSP(bf16_t, WS_CKV), WSP(bf16_t, WS_KPE), SSQX, ROPE};
            if (FASTMASK & 1) gemm_dense(C, HB0, W, EINP, D, e); else { DenseRM rm{HB0, W, D}; gemm_naive(C, EINP, D, rm, e); } }
        else { const bf16_t* W = WSP(bf16_t, WS_WINO) + (size_t)j * 2048 * D; EpiGelu e{SSQ0, WSP(bf16_t, WS_Z), SSQX};
            if (FASTMASK & 2) gemm_dense(C, HB0, W, 2048, D, e); else { DenseRM rm{HB0, W, D}; gemm_naive(C, 2048, D, rm, e); } }
        break;
    case 1:
        if (even) {
            { const bf16_t* W = WSP(bf16_t, WS_WQ) + (size_t)j * 768 * QR; EpiQ e{SSQX, WSP(bf16_t, WS_Q), ROPE};
              if (FASTMASK & 4) gemm_dense(C, WSP(bf16_t, WS_CQ), W, 768, QR, e); else { DenseRM rm{WSP(bf16_t, WS_CQ), W, QR}; gemm_naive(C, 768, QR, rm, e); } }
            { const bf16_t* W = WSP(bf16_t, WS_WKV) + (size_t)j * 1024 * KVR; EpiKV e{SSQX, WSP(bf16_t, WS_KV)};
              if (FASTMASK & 8) gemm_dense(C, WSP(bf16_t, WS_CKV), W, 1024, KVR, e); else { DenseRM rm{WSP(bf16_t, WS_CKV), W, KVR}; gemm_naive(C, 1024, KVR, rm, e); } }
            phase_conv(C, j);
        } else phase_sg_naive(C, j);
        break;
    case 2:
        if (even) phase_attn_naive(C);
        break;
    case 3: {
        const bf16_t* W = (even ? WSP(bf16_t, WS_WOE) : WSP(bf16_t, WS_WOO)) + (size_t)j * D * D; EpiRes e{H, HB0, SSQ0};
        if (FASTMASK & 16) gemm_dense(C, MIX, W, D, D, e); else { DenseRM rm{MIX, W, D}; gemm_naive(C, D, D, rm, e); }
        break; }
    case 4: phase_router(C, layer); break;
    case 5: { const MoeTab mt = moe_tables(C, layer); const int* tok_e = WSP(int, WS_TOK); const bf16_t* W = WSP(bf16_t, WS_WGU) + (size_t)layer * NEXP * D * D;
        EpiGU e{mt, WSP(int, WS_LIST), (const float*)(tok_e + 4 * T), WSP(bf16_t, WS_ACT)};
        if (FASTMASK & 32) { MoeGatherProb P{mt, WSP(int, WS_LIST), HB0, W, D}; pg8::MoeOrder S{mt.ebase[NEXP], C.nblk, C.bid}; pg8::EpiAdapt<EpiGU> ea{e}; pg8::gemm_phase(C.lds, C.tid, P, S, ea); }
        else { MoeGatherRM rm{mt, WSP(int, WS_LIST), HB0, W}; gemm_naive(C, D, D, rm, e); }
        break; }
    case 6: { const MoeTab mt = moe_tables(C, layer); const bf16_t* W = WSP(bf16_t, WS_WDN) + (size_t)layer * NEXP * D * DEXP;
        EpiDown e{mt, WSP(int, WS_LIST), WSP(float, WS_LW), WSP(bf16_t, WS_Y)};
        if (FASTMASK & 64) { MoeDownProb P{mt, WSP(bf16_t, WS_ACT), W, DEXP}; pg8::MoeOrder S{mt.ebase[NEXP], C.nblk, C.bid}; pg8::EpiAdapt<EpiDown> ea{e}; pg8::gemm_phase(C.lds, C.tid, P, S, ea); }
        else { MoeDownRM rm{mt, WSP(bf16_t, WS_ACT), W}; gemm_naive(C, D, DEXP, rm, e); }
        break; }
    case 7: phase_combine(C, layer); break;
    case 8: { const bf16_t* A = WSP(bf16_t, WS_PB) + (size_t)layer * T * PLE; const bf16_t* W = WSP(bf16_t, WS_WP) + (size_t)layer * D * PLE; EpiPP e{WSP(bf16_t, WS_PP)};
        if (FASTMASK & 128) gemm_dense(C, A, W, D, PLE, e); else { DenseRM rm{A, W, PLE}; gemm_naive(C, D, PLE, rm, e); }
        break; }
    case 9: { const bf16_t* W = WSP(bf16_t, WS_WG) + (size_t)layer * D * D; EpiPLE e{SSQ1, WSP(bf16_t, WS_PP), H, HB0, SSQ0};
        if (FASTMASK & 256) gemm_dense(C, HB1, W, D, D, e); else { DenseRM rm{HB1, W, D}; gemm_naive(C, D, D, rm, e); }
        break; }
    }
}
__host__ __device__ constexpr bool phase_is_nop(int ph) { return (ph != 0 && ph != NPHASES - 1) && ((((ph - 1) / 10) & 1) != 0) && (((ph - 1) % 10) == 2); }

__device__ __forceinline__ void phase_enter(Ctx& C, unsigned char* ws) {
    int t = threadIdx.x; asm volatile("" : "+v"(t)); C.tid = t; C.lane = t & 63; C.wave = __builtin_amdgcn_readfirstlane(t >> 6);
    unsigned char* w = ws; asm volatile("" : "+s"(w)); C.ws = w;
    int b = blockIdx.x; asm volatile("" : "+s"(b)); C.bid = b;
}
template <int PH> __device__ __forceinline__ void run_all(Ctx& C, unsigned char* ws, const XcdBarrier& bar) {
    if constexpr (PH < NPHASES - 1) {
        if constexpr (!phase_is_nop(PH)) { phase_enter(C, ws); run_phase<PH>(C); xcd_barrier(bar); }
        run_all<PH + 1>(C, ws, bar);
    }
}
template <int PH> __device__ __forceinline__ void run_one(Ctx& C, unsigned char* ws, int ph) {
    if constexpr (PH < NPHASES - 1) {
        if (ph == PH) { if constexpr (!phase_is_nop(PH)) { phase_enter(C, ws); run_phase<PH>(C); } }
        else run_one<PH + 1>(C, ws, ph);
    }
}
__global__ void __launch_bounds__(NTHREADS, 2) fwd_kernel(Args args) {
    extern __shared__ __attribute__((aligned(16))) unsigned char lds_raw[];
    Ctx C;
    C.lds = (LAS unsigned char*)lds_raw;
    C.a = &args; C.ws = args.ws;
    C.tid = threadIdx.x; C.lane = C.tid & 63; C.wave = __builtin_amdgcn_readfirstlane(C.tid >> 6);
    C.bid = blockIdx.x; C.nblk = gridDim.x;
    volatile LAS unsigned* misc = (volatile LAS unsigned*)(C.lds + LDS_MISC);
    if (C.tid < 64) misc[C.tid] = 0u;
    __syncthreads();
#if MEGA
    XcdBarrier bar = xcd_barrier_post(WSP(unsigned, WS_CTL) + CW_BAR, misc + 8);
#endif
#if MEGA
    int lo = 0; constexpr int hi = NPHASES;
#else
    int lo = args.ph_lo; const int hi = args.ph_hi;
#endif
#if MEGA
#define SEAM(p) do { if ((p) + 1 < hi) xcd_barrier(bar); } while (0)
#else
#define SEAM(p) do { } while (0)
#endif
    if (lo == 0) { phase_prologue(C); SEAM(0); lo = 1; }
#if MEGA
    run_all<1>(C, args.ws, bar);
#else
    run_one<1>(C, args.ws, lo);
#endif
    if (hi == NPHASES && lo <= NPHASES - 1) {
        int t = threadIdx.x; asm volatile("" : "+v"(t)); C.tid = t; C.lane = t & 63; C.wave = __builtin_amdgcn_readfirstlane(t >> 6);
        unsigned char* w = args.ws; asm volatile("" : "+s"(w)); C.ws = w;
        phase_final(C, args.out);
    }
#undef SEAM
}

extern "C" void kernel_launch(void* const* d_in, const int* in_sizes, int n_in, void* d_out, int out_size, void* d_ws, size_t ws_size, hipStream_t stream) {
    static int grid = 0;
    if (grid == 0) {
        if (n_in != 26 || out_size != T * D || ws_size < WS_END) { fprintf(stderr, "kernel_launch: unexpected shapes (n_in %d out %d ws %zu)\n", n_in, out_size, ws_size); grid = -1; return; }
        int dev = 0, cus = 0;
        if (hipGetDevice(&dev) != hipSuccess || hipDeviceGetAttribute(&cus, hipDeviceAttributeMultiprocessorCount, dev) != hipSuccess) { grid = -1; return; }
        if (hipFuncSetAttribute((const void*)fwd_kernel, hipFuncAttributeMaxDynamicSharedMemorySize, LDS_BYTES) != hipSuccess) { fprintf(stderr, "kernel_launch: hipFuncSetAttribute failed\n"); grid = -1; return; }
        grid = cus;
    }
    if (grid < 0) return;
    (void)hipMemsetAsync((char*)d_ws + WS_CTL, 0, CTL_ZERO_BYTES, stream);
    Args a{};
    for (int i = 0; i < 26; ++i) a.in[i] = (const float*)d_in[i];
    a.out = (float*)d_out; a.ws = (unsigned char*)d_ws;
#if MEGA
    a.ph_lo = 0; a.ph_hi = NPHASES;
    hipLaunchKernelGGL(fwd_kernel, dim3(grid), dim3(NTHREADS), LDS_BYTES, stream, a);
#else
    for (int ph = 0; ph < NPHASES; ++ph) {
        if (phase_is_nop(ph)) continue;
        a.ph_lo = ph; a.ph_hi = ph + 1;
        hipLaunchKernelGGL(fwd_kernel, dim3(grid), dim3(NTHREADS), LDS_BYTES, stream, a);
    }
#endif
}
```

```cpp
#include <hip/hip_runtime.h>
#include <cstdio>
#include <cstdint>

#ifndef FASTMASK
#define FASTMASK 0x3ff
#endif
#ifndef MEGA
#define MEGA 1
#endif

#define LAS __attribute__((address_space(3)))
#define GAS __attribute__((address_space(1)))
typedef unsigned short bf16_t;
typedef float f32x4 __attribute__((ext_vector_type(4)));
typedef unsigned u32x4 __attribute__((ext_vector_type(4)));
typedef unsigned u32x2 __attribute__((ext_vector_type(2)));
typedef short bf16x8 __attribute__((ext_vector_type(8)));

constexpr int T = 16384, D = 1024, SEQ = 4096, NBATCH = 4, DEPTH = 4;
constexpr int EIN = 2208, EINP = 2304;
constexpr int NH = 8, DQK = 96, DV = 64;
constexpr int QR = 384, KVR = 256;
constexpr int NEXP = 32, DEXP = 512;
constexpr int PLE = 256;
constexpr float EPS = 1e-6f;
constexpr int NWAVES = 8, NTHREADS = 512;
constexpr int MOE_ROWS = 40960;
constexpr float QSCALE = 0.10206207261596577f * 1.4426950408889634f;

constexpr size_t MiB = 1u << 20;
constexpr size_t WS_CTL = 0, CTL_ZERO_BYTES = 1 * MiB;
constexpr size_t WS_WINE = 1 * MiB;
constexpr size_t WS_WQ = 10 * MiB;
constexpr size_t WS_WKV = 12 * MiB;
constexpr size_t WS_WOE = 13 * MiB;
constexpr size_t WS_WINO = 17 * MiB;
constexpr size_t WS_WOO = 25 * MiB;
constexpr size_t WS_WS = 29 * MiB;
constexpr size_t WS_WR = 30 * MiB;
constexpr size_t WS_WG = 31 * MiB;
constexpr size_t WS_WP = 39 * MiB;
constexpr size_t WS_WGU = 41 * MiB;
constexpr size_t WS_WDN = 297 * MiB;
constexpr size_t WS_H = 425 * MiB;
constexpr size_t WS_HB0 = 489 * MiB;
constexpr size_t WS_HB1 = 521 * MiB;
constexpr size_t WS_SSQ0 = 553 * MiB;
constexpr size_t WS_SSQ1 = 554 * MiB;
constexpr size_t WS_SSQX = 555 * MiB;
constexpr size_t WS_ROPE = 558 * MiB;
constexpr size_t WS_PB = 560 * MiB;
constexpr size_t WS_P3 = 592 * MiB;
constexpr size_t WS_CQ = 640 * MiB;
constexpr size_t WS_CKV = 652 * MiB;
constexpr size_t WS_KPE = 660 * MiB;
constexpr size_t WS_Z = 592 * MiB;
constexpr size_t WS_Q = 661 * MiB;
constexpr size_t WS_KV = 685 * MiB;
constexpr size_t WS_MIX = 717 * MiB;
constexpr size_t WS_LIST = 749 * MiB;
constexpr size_t WS_LW = 751 * MiB;
constexpr size_t WS_TOK = 753 * MiB;
constexpr size_t WS_ACT = 754 * MiB;
constexpr size_t WS_Y = 794 * MiB;
constexpr size_t WS_PP = 874 * MiB;
constexpr size_t WS_PAR = 906 * MiB;
constexpr int PAR_CONV = 0, PAR_VN = 3072, PAR_BS = 5120, PAR_FN = 7168, PAR_N = 8192;
constexpr size_t WS_END = 907 * MiB;

constexpr int CW_CNT = 64;
constexpr int CW_BAR = 4096;

constexpr int LDS_BYTES = 147456;
constexpr int LDS_MISC = LDS_BYTES - 256;

__device__ __forceinline__ float bf2f(unsigned b) { return __uint_as_float(b << 16); }
__device__ __forceinline__ unsigned f2bf(float f) { unsigned u = __float_as_uint(f); return (u + 0x7fffu + ((u >> 16) & 1u)) >> 16; }
typedef float f32x2_t __attribute__((ext_vector_type(2))); typedef __bf16 bf16x2_t __attribute__((ext_vector_type(2)));
__device__ __forceinline__ unsigned pk2(float lo, float hi) { f32x2_t v = {lo, hi}; bf16x2_t b = __builtin_convertvector(v, bf16x2_t); return __builtin_bit_cast(unsigned, b); }
__device__ __forceinline__ void unpack8(const u32x4 w, float* v) {
    v[0] = __uint_as_float(w.x << 16); v[1] = __uint_as_float(w.x & 0xffff0000u);
    v[2] = __uint_as_float(w.y << 16); v[3] = __uint_as_float(w.y & 0xffff0000u);
    v[4] = __uint_as_float(w.z << 16); v[5] = __uint_as_float(w.z & 0xffff0000u);
    v[6] = __uint_as_float(w.w << 16); v[7] = __uint_as_float(w.w & 0xffff0000u);
}
__device__ __forceinline__ u32x4 pack8(const float* v) { u32x4 w; w.x = pk2(v[0], v[1]); w.y = pk2(v[2], v[3]); w.z = pk2(v[4], v[5]); w.w = pk2(v[6], v[7]); return w; }
__device__ __forceinline__ float rbf(float f) { return bf2f(f2bf(f)); }
__device__ __forceinline__ float wave_sum(float v) {
#pragma unroll
    for (int o = 1; o < 64; o <<= 1) v += __shfl_xor(v, o);
    return v;
}
__device__ __forceinline__ float wave_max(float v) {
#pragma unroll
    for (int o = 1; o < 64; o <<= 1) v = fmaxf(v, __shfl_xor(v, o));
    return v;
}
__device__ __forceinline__ float sigmoidf_(float x) { return 1.0f / (1.0f + __expf(-x)); }
__device__ __forceinline__ float gelu_tanh(float x) {
    const float u = 0.7978845608028654f * (x + 0.044715f * x * x * x);
    const float e = __expf(2.0f * u);
    const float th = 1.0f - 2.0f / (e + 1.0f);
    return 0.5f * x * (1.0f + th);
}

#define XB_TMO      128
#define XB_XCNT(j)  (256  + 64 * (j))
#define XB_XSUB(j)  (1280 + 64 * (j))
#define XB_XGEN(j)  (2304 + 64 * (j))
#define XB_TOP      3328
#define XB_TOPGEN   3392
#define XCD_BAR_WORDS 3456
#define XB_SPIN_CAP (1u << 22)
__device__ __forceinline__ unsigned xb_ld(unsigned* p)              { return __hip_atomic_load(p, __ATOMIC_RELAXED, __HIP_MEMORY_SCOPE_AGENT); }
__device__ __forceinline__ unsigned xb_add(unsigned* p, unsigned v) { return __hip_atomic_fetch_add(p, v, __ATOMIC_RELAXED, __HIP_MEMORY_SCOPE_AGENT); }
__device__ __forceinline__ unsigned xb_xcc_id() { return (unsigned)__builtin_amdgcn_s_getreg((3 << 11) | 20) & 0xFu; }
#define XB_SPIN(cond, bar) do { unsigned _sp = 0; while (cond) { __builtin_amdgcn_s_sleep(1); \
    if ((++_sp & 255u) == 0u) { if (xb_ld(&(bar)[XB_TMO])) break; if (_sp > XB_SPIN_CAP) { atomicAdd(&(bar)[XB_TMO], 1u); break; } } } } while (0)
struct XcdBarrier { unsigned* bar; unsigned x; volatile LAS unsigned* st; };
__device__ __forceinline__ XcdBarrier xcd_barrier_post(unsigned* bar, volatile LAS unsigned* st) {
    XcdBarrier b; b.bar = bar; b.x = xb_xcc_id(); b.st = st;
    if (threadIdx.x == 0) (void)xb_add(&bar[XB_XCNT(b.x)], 1u);
    return b;
}
__device__ __forceinline__ void xcd_barrier_complete(unsigned* bar, unsigned x, unsigned& nloc, unsigned& nx) {
    const unsigned G = gridDim.x * gridDim.y * gridDim.z;
    unsigned sum, cnt, mine, sp = 0u;
    for (;;) {
        sum = 0u; cnt = 0u; mine = 0u;
#pragma unroll
        for (unsigned j = 0; j < 16; ++j) { const unsigned c = xb_ld(&bar[XB_XCNT(j)]); sum += c; cnt += (c > 0u) ? 1u : 0u; mine = (j == x) ? c : mine; }
        if (sum == G) break;
        __builtin_amdgcn_s_sleep(1);
        if ((++sp & 255u) == 0u) { if (xb_ld(&bar[XB_TMO])) break; if (sp > XB_SPIN_CAP) { atomicAdd(&bar[XB_TMO], 1u); break; } }
    }
    nloc = mine > 0u ? mine : 1u; nx = cnt > 0u ? cnt : 1u;
}
__device__ __forceinline__ void xcd_barrier(const XcdBarrier& b) {
    asm volatile("s_waitcnt vmcnt(0)" ::: "memory");
    __syncthreads();
    if (threadIdx.x == 0) {
        unsigned* bar = b.bar;
        __builtin_amdgcn_s_waitcnt(0);
        unsigned nloc = b.st[0], nx = b.st[1];
        if (nloc == 0u) { xcd_barrier_complete(bar, b.x, nloc, nx); b.st[0] = nloc; b.st[1] = nx; }
        const unsigned old = xb_add(&bar[XB_XSUB(b.x)], 1u);
        const unsigned gen = old / nloc;
        if (old + 1u == (gen + 1u) * nloc) {
            __builtin_amdgcn_fence(__ATOMIC_RELEASE, "agent");
            asm volatile("s_waitcnt vmcnt(0)" ::: "memory");
            const unsigned og = xb_add(&bar[XB_TOP], 1u);
            const unsigned tg = og / nx;
            if (og + 1u == (tg + 1u) * nx) xb_add(&bar[XB_TOPGEN], 1u);
            else XB_SPIN(xb_ld(&bar[XB_TOPGEN]) == tg, bar);
            __builtin_amdgcn_fence(__ATOMIC_ACQUIRE, "agent");
            xb_add(&bar[XB_XGEN(b.x)], 1u);
            asm volatile("s_waitcnt vmcnt(0)" ::: "memory");
        } else {
            XB_SPIN(xb_ld(&bar[XB_XGEN(b.x)]) == gen, bar);
            __builtin_amdgcn_fence(__ATOMIC_ACQUIRE, "agent");
            asm volatile("s_waitcnt vmcnt(0)" ::: "memory");
        }
    }
    __syncthreads();
}

struct Args { const float* in[26]; float* out; unsigned char* ws; int ph_lo, ph_hi; };
struct Ctx {
    LAS unsigned char* lds;
    const Args* a; unsigned char* ws;
    int tid, lane, wave, bid, nblk;
};
#define WSP(T_, off) ((T_*)(C.ws + (off)))

__device__ __forceinline__ void conv_item(const float* colp, int ldw, const float* gain, bf16_t* WT, int K, int k0, int n0, LAS float* scr, int lane) {
#pragma unroll 8
    for (int i = 0; i < 32; ++i) {
        const int kk = 2 * i + (lane >> 5);
        float v = colp ? colp[(size_t)(k0 + kk) * ldw] : 0.f;
        if (gain) v *= gain[k0 + kk];
        scr[kk * 33 + (lane & 31)] = v;
    }
    asm volatile("s_waitcnt lgkmcnt(0)" ::: "memory");
    const int c = lane & 7;
#pragma unroll
    for (int j = 0; j < 4; ++j) {
        const int n = (lane >> 3) + 8 * j; const LAS float* s = scr + (8 * c) * 33 + n;
        u32x4 o; o.x = pk2(s[0 * 33], s[1 * 33]); o.y = pk2(s[2 * 33], s[3 * 33]); o.z = pk2(s[4 * 33], s[5 * 33]); o.w = pk2(s[6 * 33], s[7 * 33]);
        *(u32x4*)(WT + (size_t)(n0 + n) * K + k0 + 8 * c) = o;
    }
    asm volatile("s_waitcnt lgkmcnt(0)" ::: "memory");
}

__device__ __forceinline__ void phase_prologue(Ctx& C) {
    LAS float* scr = (LAS float*)(C.lds + C.wave * 16384);
    const int gw = C.bid * NWAVES + C.wave, NGW = C.nblk * NWAVES, lane = C.lane;
    constexpr int I0 = 16 * 72, I1 = 6 * 24, I2 = 4 * 32, I3 = 16 * 32, I4 = 16 * 64, I5 = 16 * 32, I6 = 16 * 2, I7 = 16 * 32, I8 = 4 * 32, I9 = 16 * 32, I10 = 8 * 32;
    constexpr int E0 = 2 * I0, E1 = E0 + 2 * I1, E2 = E1 + 2 * I2, E3 = E2 + 2 * I3, E4 = E3 + 2 * I4, E5 = E4 + 2 * I5, E6 = E5 + 4 * I6, E7 = E6 + 4 * I7, E8 = E7 + 4 * I8,
                  E9 = E8 + 128 * I9, E10 = E9 + 128 * I10;
    for (int it = gw; it < E10; it += NGW) {
        const int nl = lane & 31;
        if (it < E0) {
            const int j = it / I0, r = it % I0, kb = r / 72, nb = r % 72, np = nb * 32 + nl;
            int n;
            if (np < 1920) n = np; else if (np < 1952) { const int q = np - 1920; n = 2176 + (q & 1) * 16 + (q >> 1); } else if (np < 2048) n = -1; else n = 1920 + (np - 2048);
            const float* base = C.a->in[5] + (size_t)j * D * EIN;
            conv_item(n >= 0 ? base + n : nullptr, EIN, C.a->in[3] + (2 * j) * D, WSP(bf16_t, WS_WINE) + (size_t)j * EINP * D, D, kb * 64, nb * 32, scr, lane);
        } else if (it < E1) {
            const int r0 = it - E0, j = r0 / I1, r = r0 % I1, kb = r / 24, nb = r % 24, np = nb * 32 + nl;
            const int hd = np / 96, dd = np % 96; int n = np;
            if (dd >= 64) { const int q = dd - 64; n = hd * 96 + 64 + (q & 1) * 16 + (q >> 1); }
            conv_item(C.a->in[8] + (size_t)j * QR * 768 + n, 768, C.a->in[7] + j * QR, WSP(bf16_t, WS_WQ) + (size_t)j * 768 * QR, QR, kb * 64, nb * 32, scr, lane);
        } else if (it < E2) {
            const int r0 = it - E1, j = r0 / I2, r = r0 % I2, kb = r / 32, nb = r % 32, np = nb * 32 + nl;
            conv_item(C.a->in[10] + (size_t)j * KVR * 1024 + np, 1024, C.a->in[9] + j * KVR, WSP(bf16_t, WS_WKV) + (size_t)j * 1024 * KVR, KVR, kb * 64, nb * 32, scr, lane);
        } else if (it < E3) {
            const int r0 = it - E2, j = r0 / I3, r = r0 % I3, kb = r / 32, nb = r % 32, np = nb * 32 + nl;
            conv_item(C.a->in[11] + (size_t)j * D * D + np, D, nullptr, WSP(bf16_t, WS_WOE) + (size_t)j * D * D, D, kb * 64, nb * 32, scr, lane);
        } else if (it < E4) {
            const int r0 = it - E3, j = r0 / I4, r = r0 % I4, kb = r / 64, nb = r % 64, np = nb * 32 + nl;
            conv_item(C.a->in[12] + (size_t)j * D * 2048 + np, 2048, C.a->in[3] + (2 * j + 1) * D, WSP(bf16_t, WS_WINO) + (size_t)j * 2048 * D, D, kb * 64, nb * 32, scr, lane);
        } else if (it < E5) {
            const int r0 = it - E4, j = r0 / I5, r = r0 % I5, kb = r / 32, nb = r % 32, np = nb * 32 + nl;
            conv_item(C.a->in[16] + (size_t)j * D * D + np, D, nullptr, WSP(bf16_t, WS_WOO) + (size_t)j * D * D, D, kb * 64, nb * 32, scr, lane);
        } else if (it < E6) {
            const int r0 = it - E5, l = r0 / I6, r = r0 % I6, kb = r / 2, nb = r % 2, np = nb * 32 + nl;
            const float* cp = nullptr; int ld = 4;
            if (np < 4) { cp = C.a->in[17] + (size_t)l * D * 4 + np; ld = 4; } else if (np < 36) { cp = C.a->in[18] + (size_t)l * D * 32 + (np - 4); ld = 32; }
            conv_item(cp, ld, C.a->in[4] + l * D, WSP(bf16_t, WS_WR) + (size_t)l * 64 * D, D, kb * 64, nb * 32, scr, lane);
        } else if (it < E7) {
            const int r0 = it - E6, l = r0 / I7, r = r0 % I7, kb = r / 32, nb = r % 32, np = nb * 32 + nl;
            conv_item(C.a->in[23] + (size_t)l * D * D + np, D, C.a->in[22] + l * D, WSP(bf16_t, WS_WG) + (size_t)l * D * D, D, kb * 64, nb * 32, scr, lane);
        } else if (it < E8) {
            const int r0 = it - E7, l = r0 / I8, r = r0 % I8, kb = r / 32, nb = r % 32, np = nb * 32 + nl;
            conv_item(C.a->in[24] + (size_t)l * PLE * D + np, D, nullptr, WSP(bf16_t, WS_WP) + (size_t)l * D * PLE, PLE, kb * 64, nb * 32, scr, lane);
        } else if (it < E9) {
            const int r0 = it - E8, m = r0 / I9, r = r0 % I9, kb = r / 32, nb = r % 32, np = nb * 32 + nl;
            const int l = m >> 5, blk = np >> 3, rr = np & 7;
            const float* cp = (rr < 4) ? C.a->in[19] + (size_t)m * D * DEXP + blk * 4 + rr : C.a->in[20] + (size_t)m * D * DEXP + blk * 4 + (rr - 4);
            conv_item(cp, DEXP, C.a->in[4] + l * D, WSP(bf16_t, WS_WGU) + (size_t)m * D * D, D, kb * 64, nb * 32, scr, lane);
        } else {
            const int r0 = it - E9, m = r0 / I10, r = r0 % I10, kb = r / 32, nb = r % 32, np = nb * 32 + nl;
            conv_item(C.a->in[21] + (size_t)m * DEXP * D + np, D, nullptr, WSP(bf16_t, WS_WDN) + (size_t)m * D * DEXP, DEXP, kb * 64, nb * 32, scr, lane);
        }
    }
    {
        float* H = WSP(float, WS_H); bf16_t* HB = WSP(bf16_t, WS_HB0); float* SS = WSP(float, WS_SSQ0);
        for (int m = gw; m < T; m += NGW) {
            const f32x4* xr = (const f32x4*)(C.a->in[0] + (size_t)m * D) + lane; f32x4* hr = (f32x4*)(H + (size_t)m * D) + lane;
            u32x2* ob = (u32x2*)(HB + (size_t)m * D) + lane; float s = 0.f;
#pragma unroll
            for (int j = 0; j < 4; ++j) { const f32x4 v = xr[64 * j]; hr[64 * j] = v; s += (v.x * v.x + v.y * v.y) + (v.z * v.z + v.w * v.w); u32x2 o; o.x = pk2(v.x, v.y); o.y = pk2(v.z, v.w); ob[64 * j] = o; }
            s = wave_sum(s);
            if (lane < 16) SS[m * 16 + lane] = (lane == 0) ? s : 0.f;
        }
    }
    {
        const size_t n8 = (size_t)DEPTH * T * PLE / 8; const size_t gt = (size_t)C.bid * NTHREADS + C.tid, NGT = (size_t)C.nblk * NTHREADS;
        const f32x4* src = (const f32x4*)C.a->in[1]; u32x4* dst = WSP(u32x4, WS_PB);
        for (size_t i = gt; i < n8; i += NGT) { const f32x4 a = src[2 * i], b = src[2 * i + 1]; u32x4 o; o.x = pk2(a.x, a.y); o.y = pk2(a.z, a.w); o.z = pk2(b.x, b.y); o.w = pk2(b.z, b.w); dst[i] = o; }
    }
    {
        const int gt = C.bid * NTHREADS + C.tid, NGT = C.nblk * NTHREADS; const int* pos = (const int*)C.a->in[2]; float* R = WSP(float, WS_ROPE);
        for (int i = gt; i < T * 16; i += NGT) {
            const int t = i >> 4, f = i & 15;
            const int q = f & 3; double inv = (q == 0) ? 1.0 : (q == 1) ? 0.5623413251903491 : (q == 2) ? 0.31622776601683794 : 0.17782794100389228;
            const int dec = f >> 2; inv *= (dec == 0) ? 1.0 : (dec == 1) ? 0.1 : (dec == 2) ? 0.01 : 0.001;
            const double ang = (double)pos[t] * inv;
            const double n = __builtin_rint(ang * 0.15915494309189535);
            const double r = ang - n * 6.283185307179586, r2 = r * r;
            double sn = r, cs = 1.0, ts = r, tc = 1.0;
#pragma unroll
            for (int k = 1; k <= 13; ++k) { tc *= -r2 / (double)((2 * k - 1) * (2 * k)); cs += tc; ts *= -r2 / (double)((2 * k) * (2 * k + 1)); sn += ts; }
            R[2 * i] = (float)cs; R[2 * i + 1] = (float)sn;
        }
    }
    {
        const int gt = C.bid * NTHREADS + C.tid, NGT = C.nblk * NTHREADS; float* PR = WSP(float, WS_PAR);
        for (int i = gt; i < PAR_N; i += NGT) {
            float v;
            if (i < PAR_VN) v = C.a->in[6][i]; else if (i < PAR_BS) v = C.a->in[13][i - PAR_VN]; else if (i < PAR_FN) v = C.a->in[15][i - PAR_BS]; else v = C.a->in[25][i - PAR_FN];
            PR[i] = v;
        }
    }
    {
        const int gt = C.bid * NTHREADS + C.tid, NGT = C.nblk * NTHREADS; const float* src = C.a->in[14]; bf16_t* dst = WSP(bf16_t, WS_WS);
        for (int i = gt; i < 2 * 8 * 128 * 128; i += NGT) { const int s = i & 127, t = (i >> 7) & 127; dst[i] = (bf16_t)((s <= t) ? f2bf(src[i]) : 0u); }
    }
}

template <class RM, class Epi>
__device__ __forceinline__ void gemm_naive(Ctx& C, int N, int K, const RM& rm, const Epi& epi) {
    LAS float* As = (LAS float*)C.lds;
    LAS float* Bs = As + 32 * 132;
    const int tid = C.tid, ty = tid >> 4, tx = tid & 15;
    const int nct = N / 128, nunits = rm.ntiles128() * nct;
    for (int u = C.bid; u < nunits; u += C.nblk) {
        const int mt = u / nct, nt = u % nct, row0 = mt * 128, col0 = nt * 128;
        const bf16_t* Bt = rm.bt(row0);
        float acc[4][8];
#pragma unroll
        for (int i = 0; i < 4; ++i)
#pragma unroll
            for (int j = 0; j < 8; ++j) acc[i][j] = 0.f;
        const int lr = tid >> 2, kc = (tid & 3) * 8;
        const bf16_t* ap = rm.arow(row0 + lr);
        const bf16_t* bp = Bt + (size_t)(col0 + lr) * K;
        for (int k0 = 0; k0 < K; k0 += 32) {
            float av[8], bv[8];
            if (ap) { const u32x4 w = *(const u32x4*)(ap + k0 + kc); unpack8(w, av); } else {
#pragma unroll
                for (int i = 0; i < 8; ++i) av[i] = 0.f; }
            { const u32x4 w = *(const u32x4*)(bp + k0 + kc); unpack8(w, bv); }
            __syncthreads();
#pragma unroll
            for (int i = 0; i < 8; ++i) { As[(kc + i) * 132 + lr] = av[i]; Bs[(kc + i) * 132 + lr] = bv[i]; }
            __syncthreads();
#pragma unroll 4
            for (int k = 0; k < 32; ++k) {
                const f32x4 a = *(const LAS f32x4*)(As + k * 132 + ty * 4);
                const f32x4 b0 = *(const LAS f32x4*)(Bs + k * 132 + tx * 8), b1 = *(const LAS f32x4*)(Bs + k * 132 + tx * 8 + 4);
                const float aa[4] = {a.x, a.y, a.z, a.w}; const float bb[8] = {b0.x, b0.y, b0.z, b0.w, b1.x, b1.y, b1.z, b1.w};
#pragma unroll
                for (int i = 0; i < 4; ++i)
#pragma unroll
                    for (int j = 0; j < 8; ++j) acc[i][j] += aa[i] * bb[j];
            }
        }
#pragma unroll
        for (int i = 0; i < 4; ++i) {
            const int srow = row0 + ty * 4 + i;
            const typename Epi::Row rw = epi.row(srow);
            float ss = epi(srow, col0 + tx * 8, acc[i], rw);
            ss += __shfl_xor(ss, 1); ss += __shfl_xor(ss, 2); ss += __shfl_xor(ss, 4);
            if ((tx & 7) == 0) epi.rowsum(srow, (col0 + tx * 8) >> 6, ss);
        }
    }
    __syncthreads();
}

struct DenseRM {
    const bf16_t* A; const bf16_t* Bt; int K;
    __device__ __forceinline__ int ntiles128() const { return T / 128; }
    __device__ __forceinline__ const bf16_t* arow(int r) const { return A + (size_t)r * K; }
    __device__ __forceinline__ const bf16_t* bt(int) const { return Bt; }
};
struct MoeTab { LAS int* ebase; LAS int* tile2e; LAS int* ecnt; };
__device__ __forceinline__ MoeTab moe_tables(Ctx& C, int layer) {
    MoeTab mt; mt.ebase = (LAS int*)(C.lds + LDS_MISC - 2048); mt.tile2e = mt.ebase + 64; mt.ecnt = mt.tile2e + 192;
    __syncthreads();
    if (C.tid == 0) {
        const unsigned* cnt = WSP(unsigned, WS_CTL) + CW_CNT + layer * 64; int b = 0;
        for (int e = 0; e < NEXP; ++e) { const int c = (int)__hip_atomic_load(cnt + e, __ATOMIC_RELAXED, __HIP_MEMORY_SCOPE_AGENT); mt.ecnt[e] = c; mt.ebase[e] = b; const int nt = (c + 255) >> 8;
            for (int t = 0; t < nt; ++t) mt.tile2e[b + t] = e; b += nt; }
        mt.ebase[NEXP] = b;
    }
    __syncthreads();
    return mt;
}
struct MoeRow { int e, pos, tok; };
__device__ __forceinline__ MoeRow moe_row(const MoeTab& mt, const int* list, int srow) {
    MoeRow r; const int t256 = srow >> 8; r.e = mt.tile2e[t256]; r.pos = (t256 - mt.ebase[r.e]) * 256 + (srow & 255);
    r.tok = (r.pos < mt.ecnt[r.e]) ? list[r.e * T + r.pos] : -1; return r;
}
struct MoeGatherRM {
    MoeTab mt; const int* list; const bf16_t* HB; const bf16_t* W;
    __device__ __forceinline__ int ntiles128() const { return mt.ebase[NEXP] * 2; }
    __device__ __forceinline__ const bf16_t* arow(int r) const { const MoeRow m = moe_row(mt, list, r); return m.tok >= 0 ? HB + (size_t)m.tok * D : nullptr; }
    __device__ __forceinline__ const bf16_t* bt(int r0) const { return W + (size_t)mt.tile2e[r0 >> 8] * D * D; }
};
struct MoeDownRM {
    MoeTab mt; const bf16_t* ACT; const bf16_t* W;
    __device__ __forceinline__ int ntiles128() const { return mt.ebase[NEXP] * 2; }
    __device__ __forceinline__ const bf16_t* arow(int r) const { return ACT + (size_t)r * DEXP; }
    __device__ __forceinline__ const bf16_t* bt(int r0) const { return W + (size_t)mt.tile2e[r0 >> 8] * D * DEXP; }
};

__device__ __forceinline__ float rs_from(const float* ss, int n, float inv_n) { float s = 0.f; for (int i = 0; i < n; ++i) s += ss[i]; return rsqrtf(s * inv_n + EPS); }
struct RowS { float s; };
struct EpiE1 {
    const float* ssq_h; bf16_t* P3; bf16_t* CQ; bf16_t* CKV; bf16_t* KPE; float* ssqx; const float* rope;
    typedef RowS Row;
    __device__ __forceinline__ Row row(int r) const { Row w; w.s = rs_from(ssq_h + r * 16, 16, 1.f / D); return w; }
    __device__ __forceinline__ float operator()(int r, int col, const float* v, const Row& w) const {
        float x[8];
#pragma unroll
        for (int i = 0; i < 8; ++i) x[i] = v[i] * w.s;
        float ss = 0.f;
        if (col < 1536) { *(u32x4*)(P3 + (size_t)r * 1536 + col) = pack8(x); }
        else if (col < 1920) { *(u32x4*)(CQ + (size_t)r * QR + (col - 1536)) = pack8(x);
#pragma unroll
            for (int i = 0; i < 8; ++i) ss += x[i] * x[i]; }
        else if (col < 1952) { const int f0 = (col - 1920) >> 1; float o[8];
#pragma unroll
            for (int i = 0; i < 4; ++i) { const float c = rope[(r * 16 + f0 + i) * 2], s = rope[(r * 16 + f0 + i) * 2 + 1]; o[2 * i] = x[2 * i] * c - x[2 * i + 1] * s; o[2 * i + 1] = x[2 * i + 1] * c + x[2 * i] * s; }
            *(u32x4*)(KPE + (size_t)r * 32 + (col - 1920)) = pack8(o); }
        else if (col < 2048) { }
        else { *(u32x4*)(CKV + (size_t)r * KVR + (col - 2048)) = pack8(x);
#pragma unroll
            for (int i = 0; i < 8; ++i) ss += x[i] * x[i]; }
        return ss;
    }
    __device__ __forceinline__ void rowsum(int r, int slot, float ss) const { ssqx[r * 36 + slot] = ss; }
};
struct EpiQ {
    const float* ssqx; bf16_t* Q; const float* rope;
    typedef RowS Row;
    __device__ __forceinline__ Row row(int r) const { Row w; w.s = rs_from(ssqx + r * 36 + 24, 8, 1.f / QR) * QSCALE; return w; }
    __device__ __forceinline__ float operator()(int r, int col, const float* v, const Row& w) const {
        float x[8];
#pragma unroll
        for (int i = 0; i < 8; ++i) x[i] = v[i] * w.s;
        const int dd = col % 96;
        if (dd >= 64) { const int f0 = (dd - 64) >> 1; float o[8];
#pragma unroll
            for (int i = 0; i < 4; ++i) { const float c = rope[(r * 16 + f0 + i) * 2], s = rope[(r * 16 + f0 + i) * 2 + 1]; o[2 * i] = x[2 * i] * c - x[2 * i + 1] * s; o[2 * i + 1] = x[2 * i + 1] * c + x[2 * i] * s; }
            *(u32x4*)(Q + (size_t)r * 768 + col) = pack8(o);
        } else *(u32x4*)(Q + (size_t)r * 768 + col) = pack8(x);
        return 0.f;
    }
    __device__ __forceinline__ void rowsum(int, int, float) const {}
};
struct EpiKV {
    const float* ssqx; bf16_t* KV;
    typedef RowS Row;
    __device__ __forceinline__ Row row(int r) const { Row w; w.s = rs_from(ssqx + r * 36 + 32, 4, 1.f / KVR); return w; }
    __device__ __forceinline__ float operator()(int r, int col, const float* v, const Row& w) const {
        float x[8];
#pragma unroll
        for (int i = 0; i < 8; ++i) x[i] = v[i] * w.s;
        *(u32x4*)(KV + (size_t)r * 1024 + col) = pack8(x); return 0.f;
    }
    __device__ __forceinline__ void rowsum(int, int, float) const {}
};
struct EpiRes {
    float* H; bf16_t* HB; float* ssq;
    typedef RowS Row;
    __device__ __forceinline__ Row row(int) const { Row w; w.s = 1.f; return w; }
    __device__ __forceinline__ float operator()(int r, int col, const float* v, const Row&) const {
        f32x4* hp = (f32x4*)(H + (size_t)r * D + col); const f32x4 a = hp[0], b = hp[1];
        float x[8] = {a.x + v[0], a.y + v[1], a.z + v[2], a.w + v[3], b.x + v[4], b.y + v[5], b.z + v[6], b.w + v[7]};
        hp[0] = (f32x4){x[0], x[1], x[2], x[3]}; hp[1] = (f32x4){x[4], x[5], x[6], x[7]};
        *(u32x4*)(HB + (size_t)r * D + col) = pack8(x);
        float ss = 0.f;
#pragma unroll
        for (int i = 0; i < 8; ++i) ss += x[i] * x[i];
        return ss;
    }
    __device__ __forceinline__ void rowsum(int r, int slot, float ss) const { ssq[r * 16 + slot] = ss; }
};
struct EpiGelu {
    const float* ssq_h; bf16_t* Z; float* ssqx;
    typedef RowS Row;
    __device__ __forceinline__ Row row(int r) const { Row w; w.s = rs_from(ssq_h + r * 16, 16, 1.f / D); return w; }
    __device__ __forceinline__ float operator()(int r, int col, const float* v, const Row& w) const {
        float x[8]; float ss = 0.f;
#pragma unroll
        for (int i = 0; i < 8; ++i) { x[i] = gelu_tanh(v[i] * w.s); ss += x[i] * x[i]; }
        *(u32x4*)(Z + (size_t)r * 2048 + col) = pack8(x);
        return col >= 1024 ? ss : 0.f;
    }
    __device__ __forceinline__ void rowsum(int r, int slot, float ss) const { ssqx[r * 36 + slot] = ss; }
};
struct RowM { float s; int ok; };
struct EpiGU {
    MoeTab mt; const int* list; const float* rffn; bf16_t* ACT;
    typedef RowM Row;
    __device__ __forceinline__ Row row(int r) const { const MoeRow m = moe_row(mt, list, r); Row w; w.ok = m.tok >= 0; w.s = w.ok ? rffn[m.tok] : 0.f; return w; }
    __device__ __forceinline__ float operator()(int r, int col, const float* v, const Row& w) const {
        float a[4];
#pragma unroll
        for (int i = 0; i < 4; ++i) { const float g = v[i] * w.s, u = v[4 + i] * w.s; a[i] = g * sigmoidf_(g) * u; }
        u32x2 o; o.x = pk2(a[0], a[1]); o.y = pk2(a[2], a[3]);
        *(u32x2*)(ACT + (size_t)r * DEXP + (col >> 1)) = o;
        return 0.f;
    }
    __device__ __forceinline__ void rowsum(int, int, float) const {}
};
struct EpiDown {
    MoeTab mt; const int* list; const float* lw; bf16_t* Y;
    typedef RowM Row;
    __device__ __forceinline__ Row row(int r) const { const MoeRow m = moe_row(mt, list, r); Row w; w.ok = m.tok >= 0; w.s = w.ok ? lw[m.e * T + m.pos] : 0.f; return w; }
    __device__ __forceinline__ float operator()(int r, int col, const float* v, const Row& w) const {
        if (w.ok) { float x[8];
#pragma unroll
            for (int i = 0; i < 8; ++i) x[i] = v[i] * w.s;
            *(u32x4*)(Y + (size_t)r * D + col) = pack8(x); }
        return 0.f;
    }
    __device__ __forceinline__ void rowsum(int, int, float) const {}
};
struct EpiPP {
    bf16_t* PP;
    typedef RowS Row;
    __device__ __forceinline__ Row row(int) const { Row w; w.s = 1.f; return w; }
    __device__ __forceinline__ float operator()(int r, int col, const float* v, const Row&) const { *(u32x4*)(PP + (size_t)r * D + col) = pack8(v); return 0.f; }
    __device__ __forceinline__ void rowsum(int, int, float) const {}
};
struct EpiPLE {
    const float* ssq_in; const bf16_t* PP; float* H; bf16_t* HB; float* ssq;
    typedef RowS Row;
    __device__ __forceinline__ Row row(int r) const { Row w; w.s = rs_from(ssq_in + r * 16, 16, 1.f / D); return w; }
    __device__ __forceinline__ float operator()(int r, int col, const float* v, const Row& w) const {
        float pp[8]; unpack8(*(const u32x4*)(PP + (size_t)r * D + col), pp);
        f32x4* hp = (f32x4*)(H + (size_t)r * D + col); const f32x4 a = hp[0], b = hp[1];
        const float h0[8] = {a.x, a.y, a.z, a.w, b.x, b.y, b.z, b.w};
        float x[8]; float ss = 0.f;
#pragma unroll
        for (int i = 0; i < 8; ++i) { x[i] = h0[i] + sigmoidf_(v[i] * w.s) * pp[i]; ss += x[i] * x[i]; }
        hp[0] = (f32x4){x[0], x[1], x[2], x[3]}; hp[1] = (f32x4){x[4], x[5], x[6], x[7]};
        *(u32x4*)(HB + (size_t)r * D + col) = pack8(x);
        return ss;
    }
    __device__ __forceinline__ void rowsum(int r, int slot, float ss) const { ssq[r * 16 + slot] = ss; }
};


namespace pg8 {
constexpr int BM = 256, BK = 64, HALF = 128, HTB = HALF * BK * 2, STAGE_BYTES = 8 * HTB, NXCD = 8, WGM = 8;
__host__ __device__ __forceinline__ int lds_byte(int r, int c) { const int st = (r >> 4) * 2 + (c >> 5), rr = r & 15, cc = c & 31, ob = rr * 64 + cc * 2; return st * 1024 + (ob ^ (((ob >> 9) & 1) << 5)); }
__host__ __device__ __forceinline__ void stage_rc(int b, int& R, int& C) { const int st = b / 1024, sb = b % 1024, swz = sb ^ (((sb >> 9) & 1) << 5); R = (st >> 1) * 16 + swz / 64; C = (st & 1) * 32 + (swz % 64) / 2; }
__host__ __device__ __forceinline__ int perm32(int rho) { const int n = rho >> 4, i = rho & 15; return 8 * (i >> 2) + 4 * n + (i & 3); }
struct Unit { int pm, pn; };
struct StaticOrder {
    int nM, nN, nwg, G, c;
    __device__ void init(int M, int N, int G_, int c_) { nM = M / BM; nN = N / BM; nwg = nM * nN; G = G_; c = c_; }
    __device__ bool next(int i, Unit& u) const {
        const long L = (long)i * G + c; if (L >= nwg) return false;
        int wgid = (int)L; { const int q = nwg / NXCD, r = nwg % NXCD, xcd = wgid % NXCD, off = wgid / NXCD; wgid = (xcd < r ? xcd * (q + 1) : r * (q + 1) + (xcd - r) * q) + off; }
        const int nig = WGM * nN, gid = wgid / nig, fm = gid * WGM, gsz = (nM - fm) < WGM ? (nM - fm) : WGM;
        u.pm = fm + ((wgid % nig) % gsz); u.pn = (wgid % nig) / gsz; return true;
    }
};
struct MoeOrder {
    int ntile, G, c;
    __device__ bool next(int i, Unit& u) const { const int L = i * G + c; if (L >= ntile * 4) return false; u.pm = L >> 2; u.pn = L & 3; return true; }
};
template <class Prob, class Epi, class Sched>
__device__ __forceinline__ void gemm_phase(LAS unsigned char* lds, int tid, const Prob& P, const Sched& S, const Epi& E) {
    constexpr bool GATHER = Prob::GATHER;
    const int wid = __builtin_amdgcn_readfirstlane(tid >> 6), lane = tid & 63, wr = wid >> 2, wc = wid & 3, fr = lane & 15, fq = lane >> 4;
    const int K = P.K, nt = K / BK;
    unsigned voffA[2], voffB[2]; int RA[2], CA2[2];
#pragma unroll
    for (int i = 0; i < 2; ++i) { int R, C; stage_rc(tid * 16 + i * 8192, R, C); const int Rb = (R & ~31) + perm32(R & 31);
        voffA[i] = (unsigned)(R * K + C) * 2u; voffB[i] = (unsigned)(Rb * K + C) * 2u; RA[i] = R; CA2[i] = C * 2; }
    const size_t kstep = (size_t)(BK * 2);
    const size_t hstep = (size_t)HALF * K * 2;
    const unsigned ldsw = (unsigned)wid * 1024u;
    const int aoff = lds_byte(wr * 64 + fr, fq * 8), boff = lds_byte(wc * 32 + fr, fq * 8);
#define PG8_SA(b, h) (((b) * 2 + (h)) * HTB)
#define PG8_SB(b, h) ((4 + (b) * 2 + (h)) * HTB)
#define PG8_STAGE2(bufoff, gbase, v0, v1) do { \
        __builtin_amdgcn_global_load_lds((const unsigned*)((const char*)(gbase) + (v0)), (LAS unsigned*)(lds + (bufoff) + ldsw), 16, 0, 0); \
        __builtin_amdgcn_global_load_lds((const unsigned*)((const char*)(gbase) + (v1)), (LAS unsigned*)(lds + (bufoff) + ldsw + 8192), 16, 0, 0); } while (0)
#define PG8_STAGE_B(bufoff, gbase) PG8_STAGE2(bufoff, gbase, voffB[0], voffB[1])
#define PG8_STAGE_A(bufoff, gbase, h, nx) do { if constexpr (GATHER) { PG8_STAGE2(bufoff, gbase, (nx) ? nvA[h][0] : cvA[h][0], (nx) ? nvA[h][1] : cvA[h][1]); } \
        else { PG8_STAGE2(bufoff, (gbase) + (h) * hstep, voffA[0], voffA[1]); } } while (0)
#define PG8_LDA(dst, b, h) do { _Pragma("unroll") for (int m = 0; m < 4; ++m) _Pragma("unroll") for (int k = 0; k < 2; ++k) dst[m][k] = *(const LAS bf16x8*)(lds + PG8_SA(b, h) + aoff + m * 2048 + k * 1024); } while (0)
#define PG8_LDB(dst, b, h) do { _Pragma("unroll") for (int n = 0; n < 2; ++n) _Pragma("unroll") for (int k = 0; k < 2; ++k) dst[n][k] = *(const LAS bf16x8*)(lds + PG8_SB(b, h) + boff + n * 2048 + k * 1024); } while (0)
#define PG8_MMA(ai, bj, At, Bt) do { __builtin_amdgcn_s_setprio(1); _Pragma("unroll") for (int m = 0; m < 4; ++m) _Pragma("unroll") for (int n = 0; n < 2; ++n) _Pragma("unroll") for (int k = 0; k < 2; ++k) \
        acc[ai][bj][m][n] = __builtin_amdgcn_mfma_f32_16x16x32_bf16(Bt[n][k], At[m][k], acc[ai][bj][m][n], 0, 0, 0); __builtin_amdgcn_s_setprio(0); } while (0)
#define PG8_WAIT_V(n) asm volatile("s_waitcnt vmcnt(" #n ")" ::: "memory")
#define PG8_WAIT_L(n) asm volatile("s_waitcnt lgkmcnt(" #n ")" ::: "memory")
#define PG8_BAR __builtin_amdgcn_s_barrier()
#define PG8_SCHED __builtin_amdgcn_sched_barrier(0)
    Unit cur, nxt; int ui = 0;
    if (!S.next(0, cur)) return;
    f32x4 acc[2][2][4][2];
#pragma unroll
    for (int a = 0; a < 2; ++a)
#pragma unroll
        for (int b = 0; b < 2; ++b)
#pragma unroll
            for (int m = 0; m < 4; ++m)
#pragma unroll
                for (int n = 0; n < 2; ++n) acc[a][b][m][n] = (f32x4){0.f, 0.f, 0.f, 0.f};
    bf16x8 At[4][2], B0[2][2], B1[2][2];
    unsigned cvA[2][2], nvA[2][2];
    if constexpr (GATHER) {
#pragma unroll
        for (int h = 0; h < 2; ++h)
#pragma unroll
            for (int i = 0; i < 2; ++i) { cvA[h][i] = P.arow_off(cur, h * HALF + RA[i]) + (unsigned)CA2[i]; nvA[h][i] = cvA[h][i]; }
    } else { cvA[0][0] = cvA[0][1] = cvA[1][0] = cvA[1][1] = 0u; nvA[0][0] = nvA[0][1] = nvA[1][0] = nvA[1][1] = 0u; }
    const char* cA = P.abase(cur); const char* cB = P.bbase(cur);
    PG8_STAGE_B(PG8_SB(0, 0), cB); PG8_STAGE_B(PG8_SB(0, 1), cB + hstep); PG8_STAGE_A(PG8_SA(0, 0), cA, 0, false); PG8_STAGE_A(PG8_SA(0, 1), cA, 1, false);
    if (wr == 1) PG8_BAR;
    PG8_WAIT_V(2); PG8_BAR;
    PG8_STAGE_B(PG8_SB(1, 0), cB + kstep); PG8_STAGE_A(PG8_SA(1, 0), cA + kstep, 0, false); PG8_STAGE_B(PG8_SB(1, 1), cB + hstep + kstep);
    PG8_WAIT_V(6); PG8_BAR;
    for (;;) {
        const bool has_next = S.next(ui + 1, nxt);
        const char* nA = has_next ? P.abase(nxt) : cA; const char* nB = has_next ? P.bbase(nxt) : cB;
        if constexpr (GATHER) {
            if (has_next) {
#pragma unroll
                for (int h = 0; h < 2; ++h)
#pragma unroll
                    for (int i = 0; i < 2; ++i) nvA[h][i] = P.arow_off(nxt, h * HALF + RA[i]) + (unsigned)CA2[i];
            }
        }
        for (int t = 0; t < nt; t += 2) {
            const bool last = (t == nt - 2);
            const char* a1 = cA + (size_t)(t + 1) * kstep;
            const char* a2 = last ? nA : cA + (size_t)(t + 2) * kstep; const char* b2 = last ? nB : cB + (size_t)(t + 2) * kstep;
            const char* a3 = a2 + kstep; const char* b3 = b2 + kstep;
            PG8_LDB(B0, 0, 0); PG8_LDB(B1, 0, 1); PG8_SCHED; PG8_LDA(At, 0, 0); PG8_STAGE_A(PG8_SA(1, 1), a1, 1, false);
            PG8_WAIT_V(8); PG8_WAIT_L(0); PG8_BAR; PG8_MMA(0, 0, At, B0); PG8_MMA(0, 1, At, B1); PG8_BAR; PG8_SCHED;
            PG8_LDA(At, 0, 1); PG8_STAGE_B(PG8_SB(0, 0), b2); PG8_STAGE_B(PG8_SB(0, 1), b2 + hstep); PG8_STAGE_A(PG8_SA(0, 0), a2, 0, last);
            PG8_WAIT_V(8); PG8_WAIT_L(0); PG8_BAR; PG8_MMA(1, 0, At, B0); PG8_MMA(1, 1, At, B1); PG8_BAR; PG8_SCHED;
            PG8_LDB(B0, 1, 0); PG8_LDB(B1, 1, 1); PG8_SCHED; PG8_LDA(At, 1, 0); PG8_STAGE_A(PG8_SA(0, 1), a2, 1, last);
            PG8_WAIT_V(8); PG8_WAIT_L(0); PG8_BAR; PG8_MMA(0, 0, At, B0); PG8_MMA(0, 1, At, B1); PG8_BAR; PG8_SCHED;
            PG8_LDA(At, 1, 1); PG8_STAGE_B(PG8_SB(1, 0), b3); PG8_STAGE_B(PG8_SB(1, 1), b3 + hstep); PG8_STAGE_A(PG8_SA(1, 0), a3, 0, last);
            PG8_WAIT_V(8); PG8_WAIT_L(0); PG8_BAR; PG8_MMA(1, 0, At, B0); PG8_MMA(1, 1, At, B1); PG8_BAR; PG8_SCHED;
        }
        if (wr == 0) PG8_BAR;
        { int fr_e = fr, fq_e = fq; asm volatile("" : "+v"(fr_e), "+v"(fq_e));
          E(acc, cur, wr, wc, fr_e, fq_e); }
        if (!has_next) break;
#pragma unroll
        for (int a = 0; a < 2; ++a)
#pragma unroll
            for (int b = 0; b < 2; ++b)
#pragma unroll
                for (int m = 0; m < 4; ++m)
#pragma unroll
                    for (int n = 0; n < 2; ++n) acc[a][b][m][n] = (f32x4){0.f, 0.f, 0.f, 0.f};
        cur = nxt; cA = nA; cB = nB; ++ui;
        if constexpr (GATHER) {
#pragma unroll
            for (int h = 0; h < 2; ++h)
#pragma unroll
                for (int i = 0; i < 2; ++i) cvA[h][i] = nvA[h][i];
        }
        if (wr == 1) PG8_BAR;
    }
    PG8_WAIT_V(0);
    PG8_BAR;
#undef PG8_SA
#undef PG8_SB
#undef PG8_STAGE2
#undef PG8_STAGE_A
#undef PG8_STAGE_B
#undef PG8_LDA
#undef PG8_LDB
#undef PG8_MMA
#undef PG8_WAIT_V
#undef PG8_WAIT_L
#undef PG8_BAR
#undef PG8_SCHED
}
template <class E> struct EpiAdapt {
    E e;
    __device__ __forceinline__ void operator()(const f32x4 (&acc)[2][2][4][2], const Unit& u, int wr, int wc, int fr, int fq) const {
#pragma unroll
        for (int ai = 0; ai < 2; ++ai)
#pragma unroll
            for (int m = 0; m < 4; ++m) {
                const int row = u.pm * BM + ai * HALF + wr * 64 + m * 16 + fr;
                const typename E::Row rw = e.row(row);
                float ss = 0.f;
#pragma unroll
                for (int bj = 0; bj < 2; ++bj) {
                    const int col = u.pn * BM + bj * HALF + wc * 32 + fq * 8;
                    const f32x4 a0 = acc[ai][bj][m][0], a1 = acc[ai][bj][m][1];
                    const float v[8] = {a0[0], a0[1], a0[2], a0[3], a1[0], a1[1], a1[2], a1[3]};
                    ss += e(row, col, v, rw);
                }
                ss += __shfl_xor(ss, 16); ss += __shfl_xor(ss, 32);
                if (fq == 0) e.rowsum(row, u.pn * 4 + wc, ss);
            }
    }
};
struct DenseProb {
    static constexpr bool GATHER = false;
    const bf16_t* A; const bf16_t* Bt; int K;
    __device__ __forceinline__ const char* abase(const Unit& u) const { return (const char*)A + (size_t)u.pm * BM * K * 2; }
    __device__ __forceinline__ unsigned arow_off(const Unit&, int) const { return 0u; }
    __device__ __forceinline__ const char* bbase(const Unit& u) const { return (const char*)Bt + (size_t)u.pn * BM * K * 2; }
};
}
struct MoeGatherProb {
    static constexpr bool GATHER = true;
    MoeTab mt; const int* list; const bf16_t* HB; const bf16_t* W; int K;
    __device__ __forceinline__ const char* abase(const pg8::Unit&) const { return (const char*)HB; }
    __device__ __forceinline__ unsigned arow_off(const pg8::Unit& u, int r) const { const MoeRow m = moe_row(mt, list, u.pm * 256 + r); return (unsigned)(m.tok >= 0 ? m.tok : 0) * (unsigned)(D * 2); }
    __device__ __forceinline__ const char* bbase(const pg8::Unit& u) const { return (const char*)W + ((size_t)mt.tile2e[u.pm] * D + (size_t)u.pn * 256) * D * 2; }
};
struct MoeDownProb {
    static constexpr bool GATHER = false;
    MoeTab mt; const bf16_t* ACT; const bf16_t* W; int K;
    __device__ __forceinline__ const char* abase(const pg8::Unit& u) const { return (const char*)ACT + (size_t)u.pm * 256 * DEXP * 2; }
    __device__ __forceinline__ unsigned arow_off(const pg8::Unit&, int) const { return 0u; }
    __device__ __forceinline__ const char* bbase(const pg8::Unit& u) const { return (const char*)W + ((size_t)mt.tile2e[u.pm] * D + (size_t)u.pn * 256) * DEXP * 2; }
};
template <class E> __device__ __forceinline__ void gemm_dense(Ctx& C, const bf16_t* A, const bf16_t* Bt, int N, int K, const E& e) {
    pg8::DenseProb P{A, Bt, K}; pg8::StaticOrder S; S.init(T, N, C.nblk, C.bid); pg8::EpiAdapt<E> ea{e};
    pg8::gemm_phase(C.lds, C.tid, P, S, ea);
}

__device__ __forceinline__ void phase_conv(Ctx& C, int j) {
    const bf16_t* P3 = WSP(bf16_t, WS_P3); bf16_t* MIX = WSP(bf16_t, WS_MIX); const float* cw = WSP(float, WS_PAR) + PAR_CONV + (size_t)j * 3 * 512;
    const int gt = C.bid * NTHREADS + C.tid, NGT = C.nblk * NTHREADS;
    for (int i = gt; i < T * 64; i += NGT) {
        const int t = i >> 6, c = (i & 63) * 8, s = t & (SEQ - 1);
        float acc[8];
#pragma unroll
        for (int q = 0; q < 8; ++q) acc[q] = 0.f;
#pragma unroll
        for (int k = 0; k < 3; ++k) {
            const int dt = 2 - k;
            if (s - dt >= 0) {
                float xc[8], gc[8]; unpack8(*(const u32x4*)(P3 + (size_t)(t - dt) * 1536 + c), xc); unpack8(*(const u32x4*)(P3 + (size_t)(t - dt) * 1536 + 1024 + c), gc);
#pragma unroll
                for (int q = 0; q < 8; ++q) acc[q] += cw[k * 512 + c + q] * (gc[q] * xc[q]);
            }
        }
        float gb[8]; unpack8(*(const u32x4*)(P3 + (size_t)t * 1536 + 512 + c), gb);
#pragma unroll
        for (int q = 0; q < 8; ++q) acc[q] *= gb[q];
        *(u32x4*)(MIX + (size_t)t * D + c) = pack8(acc);
    }
}

__device__ __forceinline__ void phase_attn_naive(Ctx& C) {
    const bf16_t* Q = WSP(bf16_t, WS_Q); const bf16_t* KV = WSP(bf16_t, WS_KV); const bf16_t* KPE = WSP(bf16_t, WS_KPE); bf16_t* MIX = WSP(bf16_t, WS_MIX);
    LAS float* Ks = (LAS float*)C.lds;
    LAS float* Vs = Ks + 64 * 97;
    LAS float* Qs = Vs + 64 * 64;
    LAS float* Ps = Qs + 64 * 96;
    const int tid = C.tid, lane = C.lane, wave = C.wave;
    const int nunits = NBATCH * NH * (SEQ / 64);
    for (int u = C.bid; u < nunits; u += C.nblk) {
        const int qb = (SEQ / 64 - 1) - (u / (NBATCH * NH)), bh = u % (NBATCH * NH), b = bh / NH, h = bh % NH;
        const int t0 = b * SEQ + qb * 64;
        __syncthreads();
        for (int i = tid; i < 64 * 12; i += NTHREADS) { const int r = i / 12, c8 = (i % 12) * 8; float v[8]; unpack8(*(const u32x4*)(Q + (size_t)(t0 + r) * 768 + h * 96 + c8), v);
#pragma unroll
            for (int q = 0; q < 8; ++q) Qs[r * 96 + c8 + q] = v[q]; }
        float m[8], l[8], o[8];
#pragma unroll
        for (int i = 0; i < 8; ++i) { m[i] = -1e30f; l[i] = 0.f; o[i] = 0.f; }
        for (int kt = 0; kt <= qb; ++kt) {
            const int k0 = b * SEQ + kt * 64;
            __syncthreads();
            for (int i = tid; i < 64 * 20; i += NTHREADS) { const int r = i / 20, c = i % 20; float v[8];
                if (c < 8) { unpack8(*(const u32x4*)(KV + (size_t)(k0 + r) * 1024 + h * 128 + c * 8), v);
#pragma unroll
                    for (int q = 0; q < 8; ++q) Ks[r * 97 + c * 8 + q] = v[q]; }
                else if (c < 12) { unpack8(*(const u32x4*)(KPE + (size_t)(k0 + r) * 32 + (c - 8) * 8), v);
#pragma unroll
                    for (int q = 0; q < 8; ++q) Ks[r * 97 + c * 8 + q] = v[q]; }
                else { unpack8(*(const u32x4*)(KV + (size_t)(k0 + r) * 1024 + h * 128 + 64 + (c - 12) * 8), v);
#pragma unroll
                    for (int q = 0; q < 8; ++q) Vs[r * 64 + (c - 12) * 8 + q] = v[q]; } }
            __syncthreads();
#pragma unroll
            for (int qi = 0; qi < 8; ++qi) {
                const int qr = wave * 8 + qi;
                float s = 0.f;
                for (int d = 0; d < 96; ++d) s += Qs[qr * 96 + d] * Ks[lane * 97 + d];
                if (kt == qb && lane > qr) s = -1e30f;
                const float mn = fmaxf(m[qi], wave_max(s));
                const float p = exp2f(s - mn), al = exp2f(m[qi] - mn);
                const float pb = rbf(p);
                l[qi] = l[qi] * al + wave_sum(p); m[qi] = mn;
                Ps[wave * 64 + lane] = pb;
                asm volatile("s_waitcnt lgkmcnt(0)" ::: "memory");
                float acc = 0.f;
                for (int k = 0; k < 64; ++k) acc += Ps[wave * 64 + k] * Vs[k * 64 + lane];
                o[qi] = o[qi] * al + acc;
                asm volatile("s_waitcnt lgkmcnt(0)" ::: "memory");
            }
        }
#pragma unroll
        for (int qi = 0; qi < 8; ++qi) MIX[(size_t)(t0 + wave * 8 + qi) * D + 512 + h * 64 + lane] = (bf16_t)f2bf(o[qi] / l[qi]);
    }
    __syncthreads();
}


typedef float f32x16 __attribute__((ext_vector_type(16)));
typedef short s16x4 __attribute__((ext_vector_type(4)));
typedef short v4i16_t __attribute__((ext_vector_type(4)));
__device__ __forceinline__ int crow(int r, int hi) { return (r & 3) + 8 * (r >> 2) + 4 * hi; }
__device__ __forceinline__ s16x4 vtr(const LAS unsigned char* p) { return __builtin_bit_cast(s16x4, __builtin_amdgcn_ds_read_tr16_b64_v4i16((LAS v4i16_t*)p)); }
#ifndef ATT_THR
#define ATT_THR 5.0f
#endif
__device__ __forceinline__ void phase_attn(Ctx& C) {
    const bf16_t* Q = WSP(bf16_t, WS_Q); const bf16_t* KV = WSP(bf16_t, WS_KV); const bf16_t* KPE = WSP(bf16_t, WS_KPE); bf16_t* MIX = WSP(bf16_t, WS_MIX);
    constexpr int KROW = 208, KBUF = 64 * KROW, VBUF = 8192, OFF_K = 0, OFF_V = 2 * KBUF, OFF_WS = OFF_V + 2 * VBUF, OFF_OST = OFF_WS + 8 * 128;
    LAS unsigned char* lds = C.lds;
    const int tid = C.tid, lane = C.lane, wave = C.wave, r32 = lane & 31, hi = lane >> 5;
    LAS float* wsf = (LAS float*)(lds + OFF_WS + wave * 128);
    LAS unsigned char* ost = lds + OFF_OST + wave * 4096;
    const int krow = tid >> 3, kch = tid & 7, prow = tid >> 2, pch = tid & 3;
    const int kdst = krow * KROW + kch * 16, vdst = (kch >> 2) * 4096 + krow * 64 + (kch & 3) * 16, pdst = prow * KROW + 128 + pch * 16;
    const int kfrag = r32 * KROW + hi * 16;
    const int vfrag = ((lane >> 4) & 1) * 32 + (lane & 3) * 8 + (4 * hi + ((lane & 15) >> 2)) * 64;
    for (int pr = C.bid; pr < 256; pr += C.nblk) {
        for (int half = 0; half < 2; ++half) {
            const int bh = pr >> 3, qq = pr & 7, qb = half == 0 ? 15 - qq : qq, b = bh >> 3, h = bh & 7;
            const int tb = b * SEQ, t0 = tb + qb * 256, NT = 4 * qb + 4;
            bf16x8 qf[6];
            { const bf16_t* qp = Q + (size_t)(t0 + wave * 32 + r32) * 768 + h * 96 + hi * 8;
#pragma unroll
              for (int s = 0; s < 6; ++s) qf[s] = *(const bf16x8*)(qp + 16 * s); }
            f32x16 o0, o1;
#pragma unroll
            for (int r = 0; r < 16; ++r) { o0[r] = 0.f; o1[r] = 0.f; }
            float mref = -1e30f, lsum = 0.f;
            const bf16_t* ksrc = KV + (size_t)(tb + krow) * 1024 + h * 128 + kch * 8;
            const bf16_t* vsrc = ksrc + 64;
            const bf16_t* psrc = KPE + (size_t)(tb + prow) * 32 + pch * 8;
            u32x4 kreg, vreg, preg;
            kreg = *(const u32x4*)ksrc; vreg = *(const u32x4*)vsrc; preg = (tid < 256) ? *(const u32x4*)psrc : (u32x4){0u, 0u, 0u, 0u};
            __syncthreads();
            *(LAS u32x4*)(lds + OFF_K + kdst) = kreg; *(LAS u32x4*)(lds + OFF_V + vdst) = vreg; if (tid < 256) *(LAS u32x4*)(lds + OFF_K + pdst) = preg;
            __syncthreads();
            const int qmin = qb * 256 + wave * 32;
            for (int t = 0; t < NT; ++t) {
                const int cur = t & 1;
                if (t + 1 < NT) { const size_t adv = (size_t)(t + 1) * 64; kreg = *(const u32x4*)(ksrc + adv * 1024); vreg = *(const u32x4*)(vsrc + adv * 1024); if (tid < 256) preg = *(const u32x4*)(psrc + adv * 32); }
                const int kmin = 64 * t;
                if (kmin <= qmin + 31) {
                    f32x16 p0, p1;
#pragma unroll
                    for (int r = 0; r < 16; ++r) { p0[r] = 0.f; p1[r] = 0.f; }
                    const LAS unsigned char* kb = lds + OFF_K + cur * KBUF + kfrag;
#pragma unroll
                    for (int s = 0; s < 6; ++s) {
                        const bf16x8 k0 = *(const LAS bf16x8*)(kb + s * 32), k1 = *(const LAS bf16x8*)(kb + 32 * KROW + s * 32);
                        p0 = __builtin_amdgcn_mfma_f32_32x32x16_bf16(k0, qf[s], p0, 0, 0, 0);
                        p1 = __builtin_amdgcn_mfma_f32_32x32x16_bf16(k1, qf[s], p1, 0, 0, 0);
                    }
                    if (kmin + 63 > qmin) {
                        const int qd = qmin + r32 - kmin;
#pragma unroll
                        for (int r = 0; r < 16; ++r) { const int kv = crow(r, hi); if (kv > qd) p0[r] = -1e30f; if (kv + 32 > qd) p1[r] = -1e30f; }
                    }
                    float rm = fmaxf(p0[0], p1[0]);
#pragma unroll
                    for (int r = 1; r < 16; ++r) rm = fmaxf(rm, fmaxf(p0[r], p1[r]));
                    rm = fmaxf(rm, __shfl_xor(rm, 32));
                    if (__any(rm > mref + ATT_THR)) {
                        const float mnew = fmaxf(mref, rm), f = __builtin_amdgcn_exp2f(mref - mnew);
                        lsum *= f; mref = mnew;
                        if (hi == 0) wsf[r32] = f;
                        asm volatile("s_waitcnt lgkmcnt(0)" ::: "memory");
#pragma unroll
                        for (int r = 0; r < 16; ++r) { const float fr = wsf[crow(r, hi)]; o0[r] *= fr; o1[r] *= fr; }
                        asm volatile("s_waitcnt lgkmcnt(0)" ::: "memory");
                    }
#pragma unroll
                    for (int r = 0; r < 16; ++r) { p0[r] = __builtin_amdgcn_exp2f(p0[r] - mref); p1[r] = __builtin_amdgcn_exp2f(p1[r] - mref); lsum += p0[r] + p1[r]; }
                    u32x4 pw[4];
#pragma unroll
                    for (int i = 0; i < 4; ++i) { pw[0][i] = pk2(p0[2 * i], p0[2 * i + 1]); pw[1][i] = pk2(p0[8 + 2 * i], p0[9 + 2 * i]); pw[2][i] = pk2(p1[2 * i], p1[2 * i + 1]); pw[3][i] = pk2(p1[8 + 2 * i], p1[9 + 2 * i]); }
                    const LAS unsigned char* vb = lds + OFF_V + cur * VBUF + vfrag;
#pragma unroll
                    for (int ks = 0; ks < 4; ++ks) {
                        const s16x4 a0 = vtr(vb + ks * 1024), a1 = vtr(vb + ks * 1024 + 512), b0 = vtr(vb + 4096 + ks * 1024), b1 = vtr(vb + 4096 + ks * 1024 + 512);
                        const bf16x8 v0 = (bf16x8){a0[0], a0[1], a0[2], a0[3], a1[0], a1[1], a1[2], a1[3]}, v1 = (bf16x8){b0[0], b0[1], b0[2], b0[3], b1[0], b1[1], b1[2], b1[3]};
                        const bf16x8 pa = __builtin_bit_cast(bf16x8, pw[ks]);
                        o0 = __builtin_amdgcn_mfma_f32_32x32x16_bf16(pa, v0, o0, 0, 0, 0);
                        o1 = __builtin_amdgcn_mfma_f32_32x32x16_bf16(pa, v1, o1, 0, 0, 0);
                    }
                }
                if (t + 1 < NT) { const int nb = cur ^ 1; *(LAS u32x4*)(lds + OFF_K + nb * KBUF + kdst) = kreg; *(LAS u32x4*)(lds + OFF_V + nb * VBUF + vdst) = vreg; if (tid < 256) *(LAS u32x4*)(lds + OFF_K + nb * KBUF + pdst) = preg; }
                __syncthreads();
            }
            const float ltot = lsum + __shfl_xor(lsum, 32);
            if (hi == 0) wsf[r32] = 1.0f / ltot;
            asm volatile("s_waitcnt lgkmcnt(0)" ::: "memory");
#pragma unroll
            for (int r = 0; r < 16; ++r) { const int q = crow(r, hi); const float fr = wsf[q];
                *(LAS bf16_t*)(ost + q * 128 + r32 * 2) = (bf16_t)f2bf(o0[r] * fr); *(LAS bf16_t*)(ost + q * 128 + 64 + r32 * 2) = (bf16_t)f2bf(o1[r] * fr); }
            asm volatile("s_waitcnt lgkmcnt(0)" ::: "memory");
#pragma unroll
            for (int i = 0; i < 4; ++i) { const int idx = i * 64 + lane, q = idx >> 3, c = idx & 7;
                const u32x4 w = *(const LAS u32x4*)(ost + q * 128 + c * 16);
                *(u32x4*)(MIX + (size_t)(t0 + wave * 32 + q) * D + 512 + h * 64 + c * 8) = w; }
        }
    }
    __syncthreads();
}

__device__ __forceinline__ void phase_sg_naive(Ctx& C, int j) {
    const bf16_t* Z = WSP(bf16_t, WS_Z); const float* ssqx = WSP(float, WS_SSQX); const bf16_t* WS = WSP(bf16_t, WS_WS) + (size_t)j * 8 * 128 * 128; bf16_t* MIX = WSP(bf16_t, WS_MIX);
    const float* vg = WSP(float, WS_PAR) + PAR_VN + j * D; const float* bs = WSP(float, WS_PAR) + PAR_BS + (size_t)j * 8 * 128;
    LAS float* Wt = (LAS float*)C.lds;
    LAS float* Vn = Wt + 128 * 129;
    const int tid = C.tid;
    for (int u = C.bid; u < NBATCH * 32 * 8; u += C.nblk) {
        const int g = u & 7, bc = u >> 3, t0 = bc * 128;
        __syncthreads();
        for (int i = tid; i < 128 * 16; i += NTHREADS) { const int r = i >> 4, c8 = (i & 15) * 8; float v[8];
            unpack8(*(const u32x4*)(WS + (size_t)g * 16384 + r * 128 + c8), v);
#pragma unroll
            for (int q = 0; q < 8; ++q) Wt[r * 129 + c8 + q] = v[q];
            unpack8(*(const u32x4*)(Z + (size_t)(t0 + r) * 2048 + 1024 + g * 128 + c8), v);
            const float rv = rs_from(ssqx + (t0 + r) * 36 + 16, 16, 1.f / 1024);
#pragma unroll
            for (int q = 0; q < 8; ++q) Vn[r * 128 + c8 + q] = rbf(v[q] * rv * vg[g * 128 + c8 + q]); }
        __syncthreads();
        const int t = tid >> 2, d0 = (tid & 3) * 32;
        float acc[32];
#pragma unroll
        for (int i = 0; i < 32; ++i) acc[i] = 0.f;
        for (int s = 0; s <= t; ++s) { const float w = Wt[t * 129 + s];
#pragma unroll
            for (int i = 0; i < 32; ++i) acc[i] += w * Vn[s * 128 + d0 + i]; }
        const float bias = bs[g * 128 + t];
#pragma unroll
        for (int i8 = 0; i8 < 4; ++i8) { float uu[8], o[8]; unpack8(*(const u32x4*)(Z + (size_t)(t0 + t) * 2048 + g * 128 + d0 + i8 * 8), uu);
#pragma unroll
            for (int q = 0; q < 8; ++q) o[q] = uu[q] * (acc[i8 * 8 + q] + bias);
            *(u32x4*)(MIX + (size_t)(t0 + t) * D + g * 128 + d0 + i8 * 8) = pack8(o); }
    }
    __syncthreads();
}

__device__ __forceinline__ void phase_router(Ctx& C, int layer) {
    const bf16_t* HB = WSP(bf16_t, WS_HB0); const float* ssq = WSP(float, WS_SSQ0); const bf16_t* WR = WSP(bf16_t, WS_WR) + (size_t)layer * 64 * D;
    int* tok_e = WSP(int, WS_TOK); int* tok_pos = tok_e + 2 * T; float* rffn = (float*)(tok_pos + 2 * T);
    int* list = WSP(int, WS_LIST); float* lw = WSP(float, WS_LW); unsigned* cnt = WSP(unsigned, WS_CTL) + CW_CNT + layer * 64;
    LAS u32x4* Wl = (LAS u32x4*)C.lds;
    const int lane = C.lane;
    __syncthreads();
    for (int i = C.tid; i < 36 * 128; i += NTHREADS) Wl[i] = *(const u32x4*)(WR + (size_t)i * 8);
    __syncthreads();
    const int gw = C.bid * NWAVES + C.wave, NGW = C.nblk * NWAVES;
    for (int m = gw; m < T; m += NGW) {
        const float r = rs_from(ssq + m * 16, 16, 1.f / D);
        float x0[8], x1[8];
        unpack8(*(const u32x4*)(HB + (size_t)m * D + lane * 8), x0); unpack8(*(const u32x4*)(HB + (size_t)m * D + 512 + lane * 8), x1);
        LAS float* lgs = (LAS float*)(C.lds + 36 * 128 * 16) + C.wave * 64;
#pragma unroll 2
        for (int n = 0; n < 36; ++n) {
            float w0[8], w1[8]; unpack8(Wl[n * 128 + lane], w0); unpack8(Wl[n * 128 + 64 + lane], w1);
            float s = 0.f;
#pragma unroll
            for (int i = 0; i < 8; ++i) s += x0[i] * w0[i] + x1[i] * w1[i];
            s = wave_sum(s) * r;
            if (lane == 0) lgs[n] = s;
        }
        asm volatile("s_waitcnt lgkmcnt(0)" ::: "memory");
        const float g0 = lgs[0], g1 = lgs[1], g2 = lgs[2], g3 = lgs[3];
        int g = 0; float gm = g0;
        if (g1 > gm) { gm = g1; g = 1; }
        if (g2 > gm) { gm = g2; g = 2; }
        if (g3 > gm) { gm = g3; g = 3; }
        const float gs = __expf(g0 - gm) + __expf(g1 - gm) + __expf(g2 - gm) + __expf(g3 - gm);
        const float gw_ = 1.0f / gs;
        float el[8];
#pragma unroll
        for (int q = 0; q < 8; ++q) el[q] = lgs[4 + g * 8 + q];
        asm volatile("s_waitcnt lgkmcnt(0)" ::: "memory");
        int i1 = 0; float m1 = el[0];
#pragma unroll
        for (int q = 1; q < 8; ++q) if (el[q] > m1) { m1 = el[q]; i1 = q; }
        int i2 = -1; float m2 = -3.0e38f;
#pragma unroll
        for (int q = 0; q < 8; ++q) if (q != i1 && el[q] > m2) { m2 = el[q]; i2 = q; }
        const float e2 = __expf(m2 - m1), p1 = 1.0f / (1.0f + e2), p2 = e2 / (1.0f + e2);
        if (lane == 0) {
            rffn[m] = r;
            const int ea = g * 8 + i1, eb = g * 8 + i2;
            const int pa = (int)atomicAdd(cnt + ea, 1u), pb = (int)atomicAdd(cnt + eb, 1u);
            list[ea * T + pa] = m; lw[ea * T + pa] = gw_ * p1; list[eb * T + pb] = m; lw[eb * T + pb] = gw_ * p2;
            tok_e[2 * m] = ea; tok_e[2 * m + 1] = eb; tok_pos[2 * m] = pa; tok_pos[2 * m + 1] = pb;
        }
    }
    __syncthreads();
}

__device__ __forceinline__ void phase_combine(Ctx& C, int layer) {
    const MoeTab mt = moe_tables(C, layer);
    float* H = WSP(float, WS_H); bf16_t* HB = WSP(bf16_t, WS_HB1); float* SS = WSP(float, WS_SSQ1); const bf16_t* Y = WSP(bf16_t, WS_Y);
    const int* tok_e = WSP(int, WS_TOK); const int* tok_pos = tok_e + 2 * T;
    const int gw = C.bid * NWAVES + C.wave, NGW = C.nblk * NWAVES, lane = C.lane;
    for (int m = gw; m < T; m += NGW) {
        const int ea = tok_e[2 * m], eb = tok_e[2 * m + 1];
        const size_t sa = (size_t)mt.ebase[ea] * 256 + tok_pos[2 * m], sb = (size_t)mt.ebase[eb] * 256 + tok_pos[2 * m + 1];
        f32x4* hr = (f32x4*)(H + (size_t)m * D) + lane; const u32x2* ya = (const u32x2*)(Y + sa * D) + lane; const u32x2* yb = (const u32x2*)(Y + sb * D) + lane;
        u32x2* ob = (u32x2*)(HB + (size_t)m * D) + lane; float s = 0.f;
#pragma unroll
        for (int j = 0; j < 4; ++j) {
            f32x4 v = hr[64 * j]; const u32x2 a = ya[64 * j], b = yb[64 * j];
            v.x += bf2f(a.x & 0xffffu) + bf2f(b.x & 0xffffu); v.y += bf2f(a.x >> 16) + bf2f(b.x >> 16); v.z += bf2f(a.y & 0xffffu) + bf2f(b.y & 0xffffu); v.w += bf2f(a.y >> 16) + bf2f(b.y >> 16);
            hr[64 * j] = v; s += (v.x * v.x + v.y * v.y) + (v.z * v.z + v.w * v.w); u32x2 o; o.x = pk2(v.x, v.y); o.y = pk2(v.z, v.w); ob[64 * j] = o;
        }
        s = wave_sum(s);
        if (lane < 16) SS[m * 16 + lane] = (lane == 0) ? s : 0.f;
    }
    __syncthreads();
}

__device__ __forceinline__ void phase_final(Ctx& C, float* outp) {
    const float* H = WSP(float, WS_H); const float* SS = WSP(float, WS_SSQ0); const float* g = WSP(float, WS_PAR) + PAR_FN;
    const int gw = C.bid * NWAVES + C.wave, NGW = C.nblk * NWAVES, lane = C.lane;
    for (int m = gw; m < T; m += NGW) {
        const float r = rs_from(SS + m * 16, 16, 1.f / D);
        const f32x4* hr = (const f32x4*)(H + (size_t)m * D) + lane; f32x4* o = (f32x4*)(outp + (size_t)m * D) + lane; const f32x4* gg = (const f32x4*)g + lane;
#pragma unroll
        for (int j = 0; j < 4; ++j) { const f32x4 v = hr[64 * j], w = gg[64 * j]; o[64 * j] = (f32x4){v.x * r * w.x, v.y * r * w.y, v.z * r * w.z, v.w * r * w.w}; }
    }
}

constexpr int NPHASES = 42;
template <int ph> __device__ __forceinline__ void run_phase(Ctx& C) {
    constexpr int layer = (ph - 1) / 10, sub = (ph - 1) % 10, j = layer >> 1; constexpr bool even = (layer & 1) == 0;
    float* H = WSP(float, WS_H); bf16_t* HB0 = WSP(bf16_t, WS_HB0); bf16_t* HB1 = WSP(bf16_t, WS_HB1); float* SSQ0 = WSP(float, WS_SSQ0); float* SSQ1 = WSP(float, WS_SSQ1); float* SSQX = WSP(float, WS_SSQX);
    const float* ROPE = WSP(float, WS_ROPE); bf16_t* MIX = WSP(bf16_t, WS_MIX);
    switch (sub) {
    case 0:
        if (even) { const bf16_t* W = WSP(bf16_t, WS_WINE) + (size_t)j * EINP * D; EpiE1 e{SSQ0, WSP(bf16_t, WS_P3), WSP(bf16_t, WS_CQ), WSP(bf16_t, WS_CKV), WSP(bf16_t, WS_KPE), SSQX, ROPE};
            if (FASTMASK & 1) gemm_dense(C, HB0, W, EINP, D, e); else { DenseRM rm{HB0, W, D}; gemm_naive(C, EINP, D, rm, e); } }
        else { const bf16_t* W = WSP(bf16_t, WS_WINO) + (size_t)j * 2048 * D; EpiGelu e{SSQ0, WSP(bf16_t, WS_Z), SSQX};
            if (FASTMASK & 2) gemm_dense(C, HB0, W, 2048, D, e); else { DenseRM rm{HB0, W, D}; gemm_naive(C, 2048, D, rm, e); } }
        break;
    case 1:
        if (even) {
            { const bf16_t* W = WSP(bf16_t, WS_WQ) + (size_t)j * 768 * QR; EpiQ e{SSQX, WSP(bf16_t, WS_Q), ROPE};
              if (FASTMASK & 4) gemm_dense(C, WSP(bf16_t, WS_CQ), W, 768, QR, e); else { DenseRM rm{WSP(bf16_t, WS_CQ), W, QR}; gemm_naive(C, 768, QR, rm, e); } }
            { const bf16_t* W = WSP(bf16_t, WS_WKV) + (size_t)j * 1024 * KVR; EpiKV e{SSQX, WSP(bf16_t, WS_KV)};
              if (FASTMASK & 8) gemm_dense(C, WSP(bf16_t, WS_CKV), W, 1024, KVR, e); else { DenseRM rm{WSP(bf16_t, WS_CKV), W, KVR}; gemm_naive(C, 1024, KVR, rm, e); } }
            phase_conv(C, j);
        } else phase_sg_naive(C, j);
        break;
    case 2:
        if (even) { if (FASTMASK & 512) phase_attn(C); else phase_attn_naive(C); }
        break;
    case 3: {
        const bf16_t* W = (even ? WSP(bf16_t, WS_WOE) : WSP(bf16_t, WS_WOO)) + (size_t)j * D * D; EpiRes e{H, HB0, SSQ0};
        if (FASTMASK & 16) gemm_dense(C, MIX, W, D, D, e); else { DenseRM rm{MIX, W, D}; gemm_naive(C, D, D, rm, e); }
        break; }
    case 4: phase_router(C, layer); break;
    case 5: { const MoeTab mt = moe_tables(C, layer); const int* tok_e = WSP(int, WS_TOK); const bf16_t* W = WSP(bf16_t, WS_WGU) + (size_t)layer * NEXP * D * D;
        EpiGU e{mt, WSP(int, WS_LIST), (const float*)(tok_e + 4 * T), WSP(bf16_t, WS_ACT)};
        if (FASTMASK & 32) { MoeGatherProb P{mt, WSP(int, WS_LIST), HB0, W, D}; pg8::MoeOrder S{mt.ebase[NEXP], C.nblk, C.bid}; pg8::EpiAdapt<EpiGU> ea{e}; pg8::gemm_phase(C.lds, C.tid, P, S, ea); }
        else { MoeGatherRM rm{mt, WSP(int, WS_LIST), HB0, W}; gemm_naive(C, D, D, rm, e); }
        break; }
    case 6: { const MoeTab mt = moe_tables(C, layer); const bf16_t* W = WSP(bf16_t, WS_WDN) + (size_t)layer * NEXP * D * DEXP;
        EpiDown e{mt, WSP(int, WS_LIST), WSP(float, WS_LW), WSP(bf16_t, WS_Y)};
        if (FASTMASK & 64) { MoeDownProb P{mt, WSP(bf16_t, WS_ACT), W, DEXP}; pg8::MoeOrder S{mt.ebase[NEXP], C.nblk, C.bid}; pg8::EpiAdapt<EpiDown> ea{e}; pg8::gemm_phase(C.lds, C.tid, P, S, ea); }
        else { MoeDownRM rm{mt, WSP(bf16_t, WS_ACT), W}; gemm_naive(C, D, DEXP, rm, e); }
        break; }
    case 7: phase_combine(C, layer); break;
    case 8: { const bf16_t* A = WSP(bf16_t, WS_PB) + (size_t)layer * T * PLE; const bf16_t* W = WSP(bf16_t, WS_WP) + (size_t)layer * D * PLE; EpiPP e{WSP(bf16_t, WS_PP)};
        if (FASTMASK & 128) gemm_dense(C, A, W, D, PLE, e); else { DenseRM rm{A, W, PLE}; gemm_naive(C, D, PLE, rm, e); }
        break; }
    case 9: { const bf16_t* W = WSP(bf16_t, WS_WG) + (size_t)layer * D * D; EpiPLE e{SSQ1, WSP(bf16_t, WS_PP), H, HB0, SSQ0};
        if (FASTMASK & 256) gemm_dense(C, HB1, W, D, D, e); else { DenseRM rm{HB1, W, D}; gemm_naive(C, D, D, rm, e); }
        break; }
    }
}
__host__ __device__ constexpr bool phase_is_nop(int ph) { return (ph != 0 && ph != NPHASES - 1) && ((((ph - 1) / 10) & 1) != 0) && (((ph - 1) % 10) == 2); }

__device__ __forceinline__ void phase_enter(Ctx& C, unsigned char* ws) {
    int t = threadIdx.x; asm volatile("" : "+v"(t)); C.tid = t; C.lane = t & 63; C.wave = __builtin_amdgcn_readfirstlane(t >> 6);
    unsigned char* w = ws; asm volatile("" : "+s"(w)); C.ws = w;
    int b = blockIdx.x; asm volatile("" : "+s"(b)); C.bid = b;
}
template <int PH> __device__ __forceinline__ void run_all(Ctx& C, unsigned char* ws, const XcdBarrier& bar) {
    if constexpr (PH < NPHASES - 1) {
        if constexpr (!phase_is_nop(PH)) { phase_enter(C, ws); run_phase<PH>(C); xcd_barrier(bar); }
        run_all<PH + 1>(C, ws, bar);
    }
}
template <int PH> __device__ __forceinline__ void run_one(Ctx& C, unsigned char* ws, int ph) {
    if constexpr (PH < NPHASES - 1) {
        if (ph == PH) { if constexpr (!phase_is_nop(PH)) { phase_enter(C, ws); run_phase<PH>(C); } }
        else run_one<PH + 1>(C, ws, ph);
    }
}
__global__ void __launch_bounds__(NTHREADS, 2) fwd_kernel(Args args) {
    extern __shared__ __attribute__((aligned(16))) unsigned char lds_raw[];
    Ctx C;
    C.lds = (LAS unsigned char*)lds_raw;
    C.a = &args; C.ws = args.ws;
    C.tid = threadIdx.x; C.lane = C.tid & 63; C.wave = __builtin_amdgcn_readfirstlane(C.tid >> 6);
    C.bid = blockIdx.x; C.nblk = gridDim.x;
    volatile LAS unsigned* misc = (volatile LAS unsigned*)(C.lds + LDS_MISC);
    if (C.tid < 64) misc[C.tid] = 0u;
    __syncthreads();
#if MEGA
    XcdBarrier bar = xcd_barrier_post(WSP(unsigned, WS_CTL) + CW_BAR, misc + 8);
#endif
#if MEGA
    int lo = 0; constexpr int hi = NPHASES;
#else
    int lo = args.ph_lo; const int hi = args.ph_hi;
#endif
#if MEGA
#define SEAM(p) do { if ((p) + 1 < hi) xcd_barrier(bar); } while (0)
#else
#define SEAM(p) do { } while (0)
#endif
    if (lo == 0) { phase_prologue(C); SEAM(0); lo = 1; }
#if MEGA
    run_all<1>(C, args.ws, bar);
#else
    run_one<1>(C, args.ws, lo);
#endif
    if (hi == NPHASES && lo <= NPHASES - 1) {
        int t = threadIdx.x; asm volatile("" : "+v"(t)); C.tid = t; C.lane = t & 63; C.wave = __builtin_amdgcn_readfirstlane(t >> 6);
        unsigned char* w = args.ws; asm volatile("" : "+s"(w)); C.ws = w;
        phase_final(C, args.out);
    }
#undef SEAM
}

extern "C" void kernel_launch(void* const* d_in, const int* in_sizes, int n_in, void* d_out, int out_size, void* d_ws, size_t ws_size, hipStream_t stream) {
    static int grid = 0;
    if (grid == 0) {
        if (n_in != 26 || out_size != T * D || ws_size < WS_END) { fprintf(stderr, "kernel_launch: unexpected shapes (n_in %d out %d ws %zu)\n", n_in, out_size, ws_size); grid = -1; return; }
        int dev = 0, cus = 0;
        if (hipGetDevice(&dev) != hipSuccess || hipDeviceGetAttribute(&cus, hipDeviceAttributeMultiprocessorCount, dev) != hipSuccess) { grid = -1; return; }
        if (hipFuncSetAttribute((const void*)fwd_kernel, hipFuncAttributeMaxDynamicSharedMemorySize, LDS_BYTES) != hipSuccess) { fprintf(stderr, "kernel_launch: hipFuncSetAttribute failed\n"); grid = -1; return; }
        grid = cus;
    }
    if (grid < 0) return;
    (void)hipMemsetAsync((char*)d_ws + WS_CTL, 0, CTL_ZERO_BYTES, stream);
    Args a{};
    for (int i = 0; i < 26; ++i) a.in[i] = (const float*)d_in[i];
    a.out = (float*)d_out; a.ws = (unsigned char*)d_ws;
#if MEGA
    a.ph_lo = 0; a.ph_hi = NPHASES;
    hipLaunchKernelGGL(fwd_kernel, dim3(grid), dim3(NTHREADS), LDS_BYTES, stream, a);
#else
    for (int ph = 0; ph < NPHASES; ++ph) {
        if (phase_is_nop(ph)) continue;
        a.ph_lo = ph; a.ph_hi = ph + 1;
        hipLaunchKernelGGL(fwd_kernel, dim3(grid), dim3(NTHREADS), LDS_BYTES, stream, a);
    }
#endif
}
```

```cpp
#include <hip/hip_runtime.h>
#include <cstdio>
#include <cstdint>

#ifndef FASTMASK
#define FASTMASK 0x7ff
#endif
#ifndef DUPMASK
#define DUPMASK 0ull
#endif
#ifndef MEGA
#define MEGA 1
#endif

#define LAS __attribute__((address_space(3)))
#define GAS __attribute__((address_space(1)))
typedef unsigned short bf16_t;
typedef float f32x4 __attribute__((ext_vector_type(4)));
typedef unsigned u32x4 __attribute__((ext_vector_type(4)));
typedef unsigned u32x2 __attribute__((ext_vector_type(2)));
typedef short bf16x8 __attribute__((ext_vector_type(8)));

constexpr int T = 16384, D = 1024, SEQ = 4096, NBATCH = 4, DEPTH = 4;
constexpr int EIN = 2208, EINP = 2304;
constexpr int NH = 8, DQK = 96, DV = 64;
constexpr int QR = 384, KVR = 256;
constexpr int NEXP = 32, DEXP = 512;
constexpr int PLE = 256;
constexpr float EPS = 1e-6f;
constexpr int NWAVES = 8, NTHREADS = 512;
constexpr int MOE_ROWS = 40960;
constexpr float QSCALE = 0.10206207261596577f * 1.4426950408889634f;

constexpr size_t MiB = 1u << 20;
constexpr size_t WS_CTL = 0, CTL_ZERO_BYTES = 1 * MiB;
constexpr size_t WS_WINE = 1 * MiB;
constexpr size_t WS_WQ = 10 * MiB;
constexpr size_t WS_WKV = 12 * MiB;
constexpr size_t WS_WOE = 13 * MiB;
constexpr size_t WS_WINO = 17 * MiB;
constexpr size_t WS_WOO = 25 * MiB;
constexpr size_t WS_WS = 29 * MiB;
constexpr size_t WS_WR = 30 * MiB;
constexpr size_t WS_WG = 31 * MiB;
constexpr size_t WS_WP = 39 * MiB;
constexpr size_t WS_WGU = 41 * MiB;
constexpr size_t WS_WDN = 297 * MiB;
constexpr size_t WS_H = 425 * MiB;
constexpr size_t WS_HB0 = 489 * MiB;
constexpr size_t WS_HB1 = 521 * MiB;
constexpr size_t WS_SSQ0 = 553 * MiB;
constexpr size_t WS_SSQ1 = 554 * MiB;
constexpr size_t WS_SSQX = 555 * MiB;
constexpr size_t WS_ROPE = 558 * MiB;
constexpr size_t WS_PB = 560 * MiB;
constexpr size_t WS_P3 = 592 * MiB;
constexpr size_t WS_CQ = 640 * MiB;
constexpr size_t WS_CKV = 652 * MiB;
constexpr size_t WS_KPE = 660 * MiB;
constexpr size_t WS_Z = 592 * MiB;
constexpr size_t WS_Q = 661 * MiB;
constexpr size_t WS_KV = 685 * MiB;
constexpr size_t WS_MIX = 717 * MiB;
constexpr size_t WS_LIST = 749 * MiB;
constexpr size_t WS_LW = 751 * MiB;
constexpr size_t WS_TOK = 753 * MiB;
constexpr size_t WS_ACT = 754 * MiB;
constexpr size_t WS_Y = 794 * MiB;
constexpr size_t WS_PP = 874 * MiB;
constexpr size_t WS_PAR = 906 * MiB;
constexpr int PAR_CONV = 0, PAR_VN = 3072, PAR_BS = 5120, PAR_FN = 7168, PAR_N = 8192;
constexpr size_t WS_END = 907 * MiB;

constexpr int CW_CNT = 64;
constexpr int CW_BAR = 4096;

constexpr int LDS_BYTES = 147456;
constexpr int LDS_MISC = LDS_BYTES - 256;

__device__ __forceinline__ float bf2f(unsigned b) { return __uint_as_float(b << 16); }
__device__ __forceinline__ unsigned f2bf(float f) { unsigned u = __float_as_uint(f); return (u + 0x7fffu + ((u >> 16) & 1u)) >> 16; }
typedef float f32x2_t __attribute__((ext_vector_type(2))); typedef __bf16 bf16x2_t __attribute__((ext_vector_type(2)));
__device__ __forceinline__ unsigned pk2(float lo, float hi) { f32x2_t v = {lo, hi}; bf16x2_t b = __builtin_convertvector(v, bf16x2_t); return __builtin_bit_cast(unsigned, b); }
__device__ __forceinline__ void unpack8(const u32x4 w, float* v) {
    v[0] = __uint_as_float(w.x << 16); v[1] = __uint_as_float(w.x & 0xffff0000u);
    v[2] = __uint_as_float(w.y << 16); v[3] = __uint_as_float(w.y & 0xffff0000u);
    v[4] = __uint_as_float(w.z << 16); v[5] = __uint_as_float(w.z & 0xffff0000u);
    v[6] = __uint_as_float(w.w << 16); v[7] = __uint_as_float(w.w & 0xffff0000u);
}
__device__ __forceinline__ u32x4 pack8(const float* v) { u32x4 w; w.x = pk2(v[0], v[1]); w.y = pk2(v[2], v[3]); w.z = pk2(v[4], v[5]); w.w = pk2(v[6], v[7]); return w; }
__device__ __forceinline__ float rbf(float f) { return bf2f(f2bf(f)); }
__device__ __forceinline__ float wave_sum(float v) {
#pragma unroll
    for (int o = 1; o < 64; o <<= 1) v += __shfl_xor(v, o);
    return v;
}
__device__ __forceinline__ float wave_max(float v) {
#pragma unroll
    for (int o = 1; o < 64; o <<= 1) v = fmaxf(v, __shfl_xor(v, o));
    return v;
}
__device__ __forceinline__ float sigmoidf_(float x) { return 1.0f / (1.0f + __expf(-x)); }
__device__ __forceinline__ float gelu_tanh(float x) {
    const float u = 0.7978845608028654f * (x + 0.044715f * x * x * x);
    const float e = __expf(2.0f * u);
    const float th = 1.0f - 2.0f / (e + 1.0f);
    return 0.5f * x * (1.0f + th);
}

#define XB_TMO      128
#define XB_XCNT(j)  (256  + 64 * (j))
#define XB_XSUB(j)  (1280 + 64 * (j))
#define XB_XGEN(j)  (2304 + 64 * (j))
#define XB_TOP      3328
#define XB_TOPGEN   3392
#define XCD_BAR_WORDS 3456
#define XB_SPIN_CAP (1u << 22)
__device__ __forceinline__ unsigned xb_ld(unsigned* p)              { return __hip_atomic_load(p, __ATOMIC_RELAXED, __HIP_MEMORY_SCOPE_AGENT); }
__device__ __forceinline__ unsigned xb_add(unsigned* p, unsigned v) { return __hip_atomic_fetch_add(p, v, __ATOMIC_RELAXED, __HIP_MEMORY_SCOPE_AGENT); }
__device__ __forceinline__ unsigned xb_xcc_id() { return (unsigned)__builtin_amdgcn_s_getreg((3 << 11) | 20) & 0xFu; }
#define XB_SPIN(cond, bar) do { unsigned _sp = 0; while (cond) { __builtin_amdgcn_s_sleep(1); \
    if ((++_sp & 255u) == 0u) { if (xb_ld(&(bar)[XB_TMO])) break; if (_sp > XB_SPIN_CAP) { atomicAdd(&(bar)[XB_TMO], 1u); break; } } } } while (0)
struct XcdBarrier { unsigned* bar; unsigned x; volatile LAS unsigned* st; };
__device__ __forceinline__ XcdBarrier xcd_barrier_post(unsigned* bar, volatile LAS unsigned* st) {
    XcdBarrier b; b.bar = bar; b.x = xb_xcc_id(); b.st = st;
    if (threadIdx.x == 0) (void)xb_add(&bar[XB_XCNT(b.x)], 1u);
    return b;
}
__device__ __forceinline__ void xcd_barrier_complete(unsigned* bar, unsigned x, unsigned& nloc, unsigned& nx) {
    const unsigned G = gridDim.x * gridDim.y * gridDim.z;
    unsigned sum, cnt, mine, sp = 0u;
    for (;;) {
        sum = 0u; cnt = 0u; mine = 0u;
#pragma unroll
        for (unsigned j = 0; j < 16; ++j) { const unsigned c = xb_ld(&bar[XB_XCNT(j)]); sum += c; cnt += (c > 0u) ? 1u : 0u; mine = (j == x) ? c : mine; }
        if (sum == G) break;
        __builtin_amdgcn_s_sleep(1);
        if ((++sp & 255u) == 0u) { if (xb_ld(&bar[XB_TMO])) break; if (sp > XB_SPIN_CAP) { atomicAdd(&bar[XB_TMO], 1u); break; } }
    }
    nloc = mine > 0u ? mine : 1u; nx = cnt > 0u ? cnt : 1u;
}
__device__ __forceinline__ void xcd_barrier(const XcdBarrier& b) {
    asm volatile("s_waitcnt vmcnt(0)" ::: "memory");
    __syncthreads();
    if (threadIdx.x == 0) {
        unsigned* bar = b.bar;
        __builtin_amdgcn_s_waitcnt(0);
        unsigned nloc = b.st[0], nx = b.st[1];
        if (nloc == 0u) { xcd_barrier_complete(bar, b.x, nloc, nx); b.st[0] = nloc; b.st[1] = nx; }
        const unsigned old = xb_add(&bar[XB_XSUB(b.x)], 1u);
        const unsigned gen = old / nloc;
        if (old + 1u == (gen + 1u) * nloc) {
            __builtin_amdgcn_fence(__ATOMIC_RELEASE, "agent");
            asm volatile("s_waitcnt vmcnt(0)" ::: "memory");
            const unsigned og = xb_add(&bar[XB_TOP], 1u);
            const unsigned tg = og / nx;
            if (og + 1u == (tg + 1u) * nx) xb_add(&bar[XB_TOPGEN], 1u);
            else XB_SPIN(xb_ld(&bar[XB_TOPGEN]) == tg, bar);
            __builtin_amdgcn_fence(__ATOMIC_ACQUIRE, "agent");
            xb_add(&bar[XB_XGEN(b.x)], 1u);
            asm volatile("s_waitcnt vmcnt(0)" ::: "memory");
        } else {
            XB_SPIN(xb_ld(&bar[XB_XGEN(b.x)]) == gen, bar);
            __builtin_amdgcn_fence(__ATOMIC_ACQUIRE, "agent");
            asm volatile("s_waitcnt vmcnt(0)" ::: "memory");
        }
    }
    __syncthreads();
}

struct Args { const float* in[26]; float* out; unsigned char* ws; int ph_lo, ph_hi; };
struct Ctx {
    LAS unsigned char* lds;
    const Args* a; unsigned char* ws;
    int tid, lane, wave, bid, nblk;
};
#define WSP(T_, off) ((T_*)(C.ws + (off)))

__device__ __forceinline__ void conv_item(const float* colp, int ldw, const float* gain, bf16_t* WT, int K, int k0, int n0, LAS float* scr, int lane) {
#pragma unroll 8
    for (int i = 0; i < 32; ++i) {
        const int kk = 2 * i + (lane >> 5);
        float v = colp ? colp[(size_t)(k0 + kk) * ldw] : 0.f;
        if (gain) v *= gain[k0 + kk];
        scr[kk * 33 + (lane & 31)] = v;
    }
    asm volatile("s_waitcnt lgkmcnt(0)" ::: "memory");
    const int c = lane & 7;
#pragma unroll
    for (int j = 0; j < 4; ++j) {
        const int n = (lane >> 3) + 8 * j; const LAS float* s = scr + (8 * c) * 33 + n;
        u32x4 o; o.x = pk2(s[0 * 33], s[1 * 33]); o.y = pk2(s[2 * 33], s[3 * 33]); o.z = pk2(s[4 * 33], s[5 * 33]); o.w = pk2(s[6 * 33], s[7 * 33]);
        *(u32x4*)(WT + (size_t)(n0 + n) * K + k0 + 8 * c) = o;
    }
    asm volatile("s_waitcnt lgkmcnt(0)" ::: "memory");
}


__device__ __forceinline__ void conv_item64(const float* colp  , int ldw, const float* gain, bf16_t* WT, int K, int k0, int n0, LAS float* scr, int lane) {
    f32x4 v[16];
#pragma unroll
    for (int i = 0; i < 16; ++i) v[i] = *(const f32x4*)(colp + (size_t)(k0 + 4 * i + (lane >> 4)) * ldw);
#pragma unroll
    for (int i = 0; i < 16; ++i) {
        const int kk = 4 * i + (lane >> 4); const float g = gain ? gain[k0 + kk] : 1.f; LAS float* s = scr + kk * 65 + (lane & 15) * 4;
        s[0] = v[i].x * g; s[1] = v[i].y * g; s[2] = v[i].z * g; s[3] = v[i].w * g;
    }
    asm volatile("s_waitcnt lgkmcnt(0)" ::: "memory");
    const int c = lane & 7;
#pragma unroll
    for (int j = 0; j < 8; ++j) {
        const int n = (lane >> 3) + 8 * j; const LAS float* s = scr + (8 * c) * 65 + n;
        u32x4 o; o.x = pk2(s[0 * 65], s[1 * 65]); o.y = pk2(s[2 * 65], s[3 * 65]); o.z = pk2(s[4 * 65], s[5 * 65]); o.w = pk2(s[6 * 65], s[7 * 65]);
        *(u32x4*)(WT + (size_t)(n0 + n) * K + k0 + 8 * c) = o;
    }
    asm volatile("s_waitcnt lgkmcnt(0)" ::: "memory");
}

__device__ __forceinline__ void phase_prologue(Ctx& C) {
    LAS float* scr = (LAS float*)(C.lds + C.wave * 16896);
    const int gw = C.bid * NWAVES + C.wave, NGW = C.nblk * NWAVES, lane = C.lane;
    {
        constexpr int I0 = 16 * 72, I1 = 6 * 24, I6 = 16 * 2;
        constexpr int E0 = 2 * I0, E1 = E0 + 2 * I1, E6 = E1 + 4 * I6;
        for (int it = gw; it < E6; it += NGW) {
            const int nl = lane & 31;
            if (it < E0) {
                const int j = it / I0, r = it % I0, kb = r / 72, nb = r % 72, np = nb * 32 + nl;
                int n;
                if (np < 1920) n = np; else if (np < 1952) { const int q = np - 1920; n = 2176 + (q & 1) * 16 + (q >> 1); } else if (np < 2048) n = -1; else n = 1920 + (np - 2048);
                const float* base = C.a->in[5] + (size_t)j * D * EIN;
                conv_item(n >= 0 ? base + n : nullptr, EIN, C.a->in[3] + (2 * j) * D, WSP(bf16_t, WS_WINE) + (size_t)j * EINP * D, D, kb * 64, nb * 32, scr, lane);
            } else if (it < E1) {
                const int r0 = it - E0, j = r0 / I1, r = r0 % I1, kb = r / 24, nb = r % 24, np = nb * 32 + nl;
                const int hd = np / 96, dd = np % 96; int n = np;
                if (dd >= 64) { const int q = dd - 64; n = hd * 96 + 64 + (q & 1) * 16 + (q >> 1); }
                conv_item(C.a->in[8] + (size_t)j * QR * 768 + n, 768, C.a->in[7] + j * QR, WSP(bf16_t, WS_WQ) + (size_t)j * 768 * QR, QR, kb * 64, nb * 32, scr, lane);
            } else {
                const int r0 = it - E1, l = r0 / I6, r = r0 % I6, kb = r / 2, nb = r % 2, np = nb * 32 + nl;
                const float* cp = nullptr; int ld = 4;
                if (np < 4) { cp = C.a->in[17] + (size_t)l * D * 4 + np; ld = 4; } else if (np < 36) { cp = C.a->in[18] + (size_t)l * D * 32 + (np - 4); ld = 32; }
                conv_item(cp, ld, C.a->in[4] + l * D, WSP(bf16_t, WS_WR) + (size_t)l * 64 * D, D, kb * 64, nb * 32, scr, lane);
            }
        }
        constexpr int J2 = 4 * 16, J3 = 16 * 16, J4 = 16 * 32, J5 = 16 * 16, J7 = 16 * 16, J8 = 4 * 16, J9 = 16 * 16, J10 = 8 * 16;
        constexpr int F2 = 2 * J2, F3 = F2 + 2 * J3, F4 = F3 + 2 * J4, F5 = F4 + 2 * J5, F7 = F5 + 4 * J7, F8 = F7 + 4 * J8, F9 = F8 + 128 * J9, F10 = F9 + 128 * J10;
        const int n4 = (lane & 15) * 4;
        for (int it = gw; it < F10; it += NGW) {
            if (it >= F8) {
                if (it < F9) {
                    const int r0 = it - F8, m = r0 / J9, r = r0 % J9, kb = r / 16, nb = r % 16, np = nb * 64 + n4;
                    const int l = m >> 5, b4 = np >> 2;
                    const float* cp = ((b4 & 1) ? C.a->in[20] : C.a->in[19]) + (size_t)m * D * DEXP + (b4 >> 1) * 4;
                    conv_item64(cp, DEXP, C.a->in[4] + l * D, WSP(bf16_t, WS_WGU) + (size_t)m * D * D, D, kb * 64, nb * 64, scr, lane);
                } else {
                    const int r0 = it - F9, m = r0 / J10, r = r0 % J10, kb = r / 16, nb = r % 16, np = nb * 64 + n4;
                    conv_item64(C.a->in[21] + (size_t)m * DEXP * D + np, D, nullptr, WSP(bf16_t, WS_WDN) + (size_t)m * D * DEXP, DEXP, kb * 64, nb * 64, scr, lane);
                }
            } else if (it < F2) {
                const int j = it / J2, r = it % J2, kb = r / 16, nb = r % 16, np = nb * 64 + n4;
                conv_item64(C.a->in[10] + (size_t)j * KVR * 1024 + np, 1024, C.a->in[9] + j * KVR, WSP(bf16_t, WS_WKV) + (size_t)j * 1024 * KVR, KVR, kb * 64, nb * 64, scr, lane);
            } else if (it < F3) {
                const int r0 = it - F2, j = r0 / J3, r = r0 % J3, kb = r / 16, nb = r % 16, np = nb * 64 + n4;
                conv_item64(C.a->in[11] + (size_t)j * D * D + np, D, nullptr, WSP(bf16_t, WS_WOE) + (size_t)j * D * D, D, kb * 64, nb * 64, scr, lane);
            } else if (it < F4) {
                const int r0 = it - F3, j = r0 / J4, r = r0 % J4, kb = r / 32, nb = r % 32, np = nb * 64 + n4;
                conv_item64(C.a->in[12] + (size_t)j * D * 2048 + np, 2048, C.a->in[3] + (2 * j + 1) * D, WSP(bf16_t, WS_WINO) + (size_t)j * 2048 * D, D, kb * 64, nb * 64, scr, lane);
            } else if (it < F5) {
                const int r0 = it - F4, j = r0 / J5, r = r0 % J5, kb = r / 16, nb = r % 16, np = nb * 64 + n4;
                conv_item64(C.a->in[16] + (size_t)j * D * D + np, D, nullptr, WSP(bf16_t, WS_WOO) + (size_t)j * D * D, D, kb * 64, nb * 64, scr, lane);
            } else if (it < F7) {
                const int r0 = it - F5, l = r0 / J7, r = r0 % J7, kb = r / 16, nb = r % 16, np = nb * 64 + n4;
                conv_item64(C.a->in[23] + (size_t)l * D * D + np, D, C.a->in[22] + l * D, WSP(bf16_t, WS_WG) + (size_t)l * D * D, D, kb * 64, nb * 64, scr, lane);
            } else {
                const int r0 = it - F7, l = r0 / J8, r = r0 % J8, kb = r / 16, nb = r % 16, np = nb * 64 + n4;
                conv_item64(C.a->in[24] + (size_t)l * PLE * D + np, D, nullptr, WSP(bf16_t, WS_WP) + (size_t)l * D * PLE, PLE, kb * 64, nb * 64, scr, lane);
            }
        }
    }
    {
        float* H = WSP(float, WS_H); bf16_t* HB = WSP(bf16_t, WS_HB0); float* SS = WSP(float, WS_SSQ0);
        for (int m = gw; m < T; m += NGW) {
            const f32x4* xr = (const f32x4*)(C.a->in[0] + (size_t)m * D) + lane; f32x4* hr = (f32x4*)(H + (size_t)m * D) + lane;
            u32x2* ob = (u32x2*)(HB + (size_t)m * D) + lane; float s = 0.f;
#pragma unroll
            for (int j = 0; j < 4; ++j) { const f32x4 v = xr[64 * j]; hr[64 * j] = v; s += (v.x * v.x + v.y * v.y) + (v.z * v.z + v.w * v.w); u32x2 o; o.x = pk2(v.x, v.y); o.y = pk2(v.z, v.w); ob[64 * j] = o; }
            s = wave_sum(s);
            if (lane < 16) SS[m * 16 + lane] = (lane == 0) ? s : 0.f;
        }
    }
    {
        const size_t n8 = (size_t)DEPTH * T * PLE / 8; const size_t gt = (size_t)C.bid * NTHREADS + C.tid, NGT = (size_t)C.nblk * NTHREADS;
        const f32x4* src = (const f32x4*)C.a->in[1]; u32x4* dst = WSP(u32x4, WS_PB);
        for (size_t i = gt; i < n8; i += NGT) { const f32x4 a = src[2 * i], b = src[2 * i + 1]; u32x4 o; o.x = pk2(a.x, a.y); o.y = pk2(a.z, a.w); o.z = pk2(b.x, b.y); o.w = pk2(b.z, b.w); dst[i] = o; }
    }
    {
        const int gt = C.bid * NTHREADS + C.tid, NGT = C.nblk * NTHREADS; const int* pos = (const int*)C.a->in[2]; float* R = WSP(float, WS_ROPE);
        for (int i = gt; i < T * 16; i += NGT) {
            const int t = i >> 4, f = i & 15;
            const int q = f & 3; double inv = (q == 0) ? 1.0 : (q == 1) ? 0.5623413251903491 : (q == 2) ? 0.31622776601683794 : 0.17782794100389228;
            const int dec = f >> 2; inv *= (dec == 0) ? 1.0 : (dec == 1) ? 0.1 : (dec == 2) ? 0.01 : 0.001;
            const double ang = (double)pos[t] * inv;
            const double n = __builtin_rint(ang * 0.15915494309189535);
            const double r = ang - n * 6.283185307179586, r2 = r * r;
            double sn = r, cs = 1.0, ts = r, tc = 1.0;
#pragma unroll
            for (int k = 1; k <= 13; ++k) { tc *= -r2 / (double)((2 * k - 1) * (2 * k)); cs += tc; ts *= -r2 / (double)((2 * k) * (2 * k + 1)); sn += ts; }
            R[2 * i] = (float)cs; R[2 * i + 1] = (float)sn;
        }
    }
    {
        const int gt = C.bid * NTHREADS + C.tid, NGT = C.nblk * NTHREADS; float* PR = WSP(float, WS_PAR);
        for (int i = gt; i < PAR_N; i += NGT) {
            float v;
            if (i < PAR_VN) v = C.a->in[6][i]; else if (i < PAR_BS) v = C.a->in[13][i - PAR_VN]; else if (i < PAR_FN) v = C.a->in[15][i - PAR_BS]; else v = C.a->in[25][i - PAR_FN];
            PR[i] = v;
        }
    }
    {
        const int gt = C.bid * NTHREADS + C.tid, NGT = C.nblk * NTHREADS; const float* src = C.a->in[14]; bf16_t* dst = WSP(bf16_t, WS_WS);
        for (int i = gt; i < 2 * 8 * 128 * 128; i += NGT) { const int s = i & 127, t = (i >> 7) & 127; dst[i] = (bf16_t)((s <= t) ? f2bf(src[i]) : 0u); }
    }
}

template <class RM, class Epi>
__device__ __forceinline__ void gemm_naive(Ctx& C, int N, int K, const RM& rm, const Epi& epi) {
    LAS float* As = (LAS float*)C.lds;
    LAS float* Bs = As + 32 * 132;
    const int tid = C.tid, ty = tid >> 4, tx = tid & 15;
    const int nct = N / 128, nunits = rm.ntiles128() * nct;
    for (int u = C.bid; u < nunits; u += C.nblk) {
        const int mt = u / nct, nt = u % nct, row0 = mt * 128, col0 = nt * 128;
        const bf16_t* Bt = rm.bt(row0);
        float acc[4][8];
#pragma unroll
        for (int i = 0; i < 4; ++i)
#pragma unroll
            for (int j = 0; j < 8; ++j) acc[i][j] = 0.f;
        const int lr = tid >> 2, kc = (tid & 3) * 8;
        const bf16_t* ap = rm.arow(row0 + lr);
        const bf16_t* bp = Bt + (size_t)(col0 + lr) * K;
        for (int k0 = 0; k0 < K; k0 += 32) {
            float av[8], bv[8];
            if (ap) { const u32x4 w = *(const u32x4*)(ap + k0 + kc); unpack8(w, av); } else {
#pragma unroll
                for (int i = 0; i < 8; ++i) av[i] = 0.f; }
            { const u32x4 w = *(const u32x4*)(bp + k0 + kc); unpack8(w, bv); }
            __syncthreads();
#pragma unroll
            for (int i = 0; i < 8; ++i) { As[(kc + i) * 132 + lr] = av[i]; Bs[(kc + i) * 132 + lr] = bv[i]; }
            __syncthreads();
#pragma unroll 4
            for (int k = 0; k < 32; ++k) {
                const f32x4 a = *(const LAS f32x4*)(As + k * 132 + ty * 4);
                const f32x4 b0 = *(const LAS f32x4*)(Bs + k * 132 + tx * 8), b1 = *(const LAS f32x4*)(Bs + k * 132 + tx * 8 + 4);
                const float aa[4] = {a.x, a.y, a.z, a.w}; const float bb[8] = {b0.x, b0.y, b0.z, b0.w, b1.x, b1.y, b1.z, b1.w};
#pragma unroll
                for (int i = 0; i < 4; ++i)
#pragma unroll
                    for (int j = 0; j < 8; ++j) acc[i][j] += aa[i] * bb[j];
            }
        }
#pragma unroll
        for (int i = 0; i < 4; ++i) {
            const int srow = row0 + ty * 4 + i;
            const typename Epi::Row rw = epi.row(srow);
            float ss = epi(srow, col0 + tx * 8, acc[i], rw);
            ss += __shfl_xor(ss, 1); ss += __shfl_xor(ss, 2); ss += __shfl_xor(ss, 4);
            if ((tx & 7) == 0) epi.rowsum(srow, (col0 + tx * 8) >> 6, ss);
        }
    }
    __syncthreads();
}

struct DenseRM {
    const bf16_t* A; const bf16_t* Bt; int K;
    __device__ __forceinline__ int ntiles128() const { return T / 128; }
    __device__ __forceinline__ const bf16_t* arow(int r) const { return A + (size_t)r * K; }
    __device__ __forceinline__ const bf16_t* bt(int) const { return Bt; }
};
struct MoeTab { LAS int* ebase; LAS int* tile2e; LAS int* ecnt; };
__device__ __forceinline__ MoeTab moe_tables(Ctx& C, int layer) {
    MoeTab mt; mt.ebase = (LAS int*)(C.lds + LDS_MISC - 2048); mt.tile2e = mt.ebase + 64; mt.ecnt = mt.tile2e + 192;
    __syncthreads();
    if (C.tid < 64) {
        const unsigned* cnt = WSP(unsigned, WS_CTL) + CW_CNT + layer * 64; const int lane = C.tid;
        const int c = (lane < NEXP) ? (int)__hip_atomic_load(cnt + lane, __ATOMIC_RELAXED, __HIP_MEMORY_SCOPE_AGENT) : 0;
        const int nt = (c + 255) >> 8; int incl = nt;
#pragma unroll
        for (int o = 1; o < 32; o <<= 1) { const int v = __shfl_up(incl, o); if (lane >= o) incl += v; }
        const int excl = incl - nt;
        if (lane < NEXP) { mt.ecnt[lane] = c; mt.ebase[lane] = excl; for (int t = 0; t < nt; ++t) mt.tile2e[excl + t] = lane; }
        if (lane == NEXP - 1) mt.ebase[NEXP] = incl;
    }
    __syncthreads();
    return mt;
}
struct MoeRow { int e, pos, tok; };
__device__ __forceinline__ MoeRow moe_row(const MoeTab& mt, const int* list, int srow) {
    MoeRow r; const int t256 = srow >> 8; r.e = mt.tile2e[t256]; r.pos = (t256 - mt.ebase[r.e]) * 256 + (srow & 255);
    r.tok = (r.pos < mt.ecnt[r.e]) ? list[r.e * T + r.pos] : -1; return r;
}
struct MoeGatherRM {
    MoeTab mt; const int* list; const bf16_t* HB; const bf16_t* W;
    __device__ __forceinline__ int ntiles128() const { return mt.ebase[NEXP] * 2; }
    __device__ __forceinline__ const bf16_t* arow(int r) const { const MoeRow m = moe_row(mt, list, r); return m.tok >= 0 ? HB + (size_t)m.tok * D : nullptr; }
    __device__ __forceinline__ const bf16_t* bt(int r0) const { return W + (size_t)mt.tile2e[r0 >> 8] * D * D; }
};
struct MoeDownRM {
    MoeTab mt; const bf16_t* ACT; const bf16_t* W;
    __device__ __forceinline__ int ntiles128() const { return mt.ebase[NEXP] * 2; }
    __device__ __forceinline__ const bf16_t* arow(int r) const { return ACT + (size_t)r * DEXP; }
    __device__ __forceinline__ const bf16_t* bt(int r0) const { return W + (size_t)mt.tile2e[r0 >> 8] * D * DEXP; }
};

__device__ __forceinline__ float rs_from(const float* ss, int n, float inv_n) { float s = 0.f; for (int i = 0; i < n; ++i) s += ss[i]; return rsqrtf(s * inv_n + EPS); }
struct RowS { float s; };
struct EpiE1 {
    const float* ssq_h; bf16_t* P3; bf16_t* CQ; bf16_t* CKV; bf16_t* KPE; float* ssqx; const float* rope;
    typedef RowS Row;
    __device__ __forceinline__ Row row(int r) const { Row w; w.s = rs_from(ssq_h + r * 16, 16, 1.f / D); return w; }
    __device__ __forceinline__ float operator()(int r, int col, const float* v, const Row& w) const {
        float x[8];
#pragma unroll
        for (int i = 0; i < 8; ++i) x[i] = v[i] * w.s;
        float ss = 0.f;
        if (col < 1536) { *(u32x4*)(P3 + (size_t)r * 1536 + col) = pack8(x); }
        else if (col < 1920) { *(u32x4*)(CQ + (size_t)r * QR + (col - 1536)) = pack8(x);
#pragma unroll
            for (int i = 0; i < 8; ++i) ss += x[i] * x[i]; }
        else if (col < 1952) { const int f0 = (col - 1920) >> 1; float o[8];
#pragma unroll
            for (int i = 0; i < 4; ++i) { const float c = rope[(r * 16 + f0 + i) * 2], s = rope[(r * 16 + f0 + i) * 2 + 1]; o[2 * i] = x[2 * i] * c - x[2 * i + 1] * s; o[2 * i + 1] = x[2 * i + 1] * c + x[2 * i] * s; }
            *(u32x4*)(KPE + (size_t)r * 32 + (col - 1920)) = pack8(o); }
        else if (col < 2048) { }
        else { *(u32x4*)(CKV + (size_t)r * KVR + (col - 2048)) = pack8(x);
#pragma unroll
            for (int i = 0; i < 8; ++i) ss += x[i] * x[i]; }
        return ss;
    }
    __device__ __forceinline__ void rowsum(int r, int slot, float ss) const { ssqx[r * 36 + slot] = ss; }
};
struct EpiQ {
    const float* ssqx; bf16_t* Q; const float* rope;
    typedef RowS Row;
    __device__ __forceinline__ Row row(int r) const { Row w; w.s = rs_from(ssqx + r * 36 + 24, 8, 1.f / QR) * QSCALE; return w; }
    __device__ __forceinline__ float operator()(int r, int col, const float* v, const Row& w) const {
        float x[8];
#pragma unroll
        for (int i = 0; i < 8; ++i) x[i] = v[i] * w.s;
        const int dd = col % 96;
        if (dd >= 64) { const int f0 = (dd - 64) >> 1; float o[8];
#pragma unroll
            for (int i = 0; i < 4; ++i) { const float c = rope[(r * 16 + f0 + i) * 2], s = rope[(r * 16 + f0 + i) * 2 + 1]; o[2 * i] = x[2 * i] * c - x[2 * i + 1] * s; o[2 * i + 1] = x[2 * i + 1] * c + x[2 * i] * s; }
            *(u32x4*)(Q + (size_t)r * 768 + col) = pack8(o);
        } else *(u32x4*)(Q + (size_t)r * 768 + col) = pack8(x);
        return 0.f;
    }
    __device__ __forceinline__ void rowsum(int, int, float) const {}
};
struct EpiKV {
    const float* ssqx; bf16_t* KV;
    typedef RowS Row;
    __device__ __forceinline__ Row row(int r) const { Row w; w.s = rs_from(ssqx + r * 36 + 32, 4, 1.f / KVR); return w; }
    __device__ __forceinline__ float operator()(int r, int col, const float* v, const Row& w) const {
        float x[8];
#pragma unroll
        for (int i = 0; i < 8; ++i) x[i] = v[i] * w.s;
        *(u32x4*)(KV + (size_t)r * 1024 + col) = pack8(x); return 0.f;
    }
    __device__ __forceinline__ void rowsum(int, int, float) const {}
};
struct EpiRes {
    float* H; bf16_t* HB; float* ssq;
    typedef RowS Row;
    __device__ __forceinline__ Row row(int) const { Row w; w.s = 1.f; return w; }
    __device__ __forceinline__ float operator()(int r, int col, const float* v, const Row&) const {
        f32x4* hp = (f32x4*)(H + (size_t)r * D + col); const f32x4 a = hp[0], b = hp[1];
        float x[8] = {a.x + v[0], a.y + v[1], a.z + v[2], a.w + v[3], b.x + v[4], b.y + v[5], b.z + v[6], b.w + v[7]};
        hp[0] = (f32x4){x[0], x[1], x[2], x[3]}; hp[1] = (f32x4){x[4], x[5], x[6], x[7]};
        *(u32x4*)(HB + (size_t)r * D + col) = pack8(x);
        float ss = 0.f;
#pragma unroll
        for (int i = 0; i < 8; ++i) ss += x[i] * x[i];
        return ss;
    }
    __device__ __forceinline__ void rowsum(int r, int slot, float ss) const { ssq[r * 16 + slot] = ss; }
};
struct EpiGelu {
    const float* ssq_h; bf16_t* Z; float* ssqx;
    typedef RowS Row;
    __device__ __forceinline__ Row row(int r) const { Row w; w.s = rs_from(ssq_h + r * 16, 16, 1.f / D); return w; }
    __device__ __forceinline__ float operator()(int r, int col, const float* v, const Row& w) const {
        float x[8]; float ss = 0.f;
#pragma unroll
        for (int i = 0; i < 8; ++i) { x[i] = gelu_tanh(v[i] * w.s); ss += x[i] * x[i]; }
        *(u32x4*)(Z + (size_t)r * 2048 + col) = pack8(x);
        return col >= 1024 ? ss : 0.f;
    }
    __device__ __forceinline__ void rowsum(int r, int slot, float ss) const { ssqx[r * 36 + slot] = ss; }
};
struct RowM { float s; int ok; };
struct EpiGU {
    MoeTab mt; const int* list; const float* rffn; bf16_t* ACT;
    typedef RowM Row;
    __device__ __forceinline__ Row row(int r) const { const MoeRow m = moe_row(mt, list, r); Row w; w.ok = m.tok >= 0; w.s = w.ok ? rffn[m.tok] : 0.f; return w; }
    __device__ __forceinline__ float operator()(int r, int col, const float* v, const Row& w) const {
        float a[4];
#pragma unroll
        for (int i = 0; i < 4; ++i) { const float g = v[i] * w.s, u = v[4 + i] * w.s; a[i] = g * sigmoidf_(g) * u; }
        u32x2 o; o.x = pk2(a[0], a[1]); o.y = pk2(a[2], a[3]);
        *(u32x2*)(ACT + (size_t)r * DEXP + (col >> 1)) = o;
        return 0.f;
    }
    __device__ __forceinline__ void rowsum(int, int, float) const {}
};
struct EpiDown {
    MoeTab mt; const int* list; const float* lw; bf16_t* Y;
    typedef RowM Row;
    __device__ __forceinline__ Row row(int r) const { const MoeRow m = moe_row(mt, list, r); Row w; w.ok = m.tok >= 0; w.s = w.ok ? lw[m.e * T + m.pos] : 0.f; return w; }
    __device__ __forceinline__ float operator()(int r, int col, const float* v, const Row& w) const {
        if (w.ok) { float x[8];
#pragma unroll
            for (int i = 0; i < 8; ++i) x[i] = v[i] * w.s;
            *(u32x4*)(Y + (size_t)r * D + col) = pack8(x); }
        return 0.f;
    }
    __device__ __forceinline__ void rowsum(int, int, float) const {}
};
struct EpiPP {
    bf16_t* PP;
    typedef RowS Row;
    __device__ __forceinline__ Row row(int) const { Row w; w.s = 1.f; return w; }
    __device__ __forceinline__ float operator()(int r, int col, const float* v, const Row&) const { *(u32x4*)(PP + (size_t)r * D + col) = pack8(v); return 0.f; }
    __device__ __forceinline__ void rowsum(int, int, float) const {}
};
struct EpiPLE {
    const float* ssq_in; const bf16_t* PP; float* H; bf16_t* HB; float* ssq;
    typedef RowS Row;
    __device__ __forceinline__ Row row(int r) const { Row w; w.s = rs_from(ssq_in + r * 16, 16, 1.f / D); return w; }
    __device__ __forceinline__ float operator()(int r, int col, const float* v, const Row& w) const {
        float pp[8]; unpack8(*(const u32x4*)(PP + (size_t)r * D + col), pp);
        f32x4* hp = (f32x4*)(H + (size_t)r * D + col); const f32x4 a = hp[0], b = hp[1];
        const float h0[8] = {a.x, a.y, a.z, a.w, b.x, b.y, b.z, b.w};
        float x[8]; float ss = 0.f;
#pragma unroll
        for (int i = 0; i < 8; ++i) { x[i] = h0[i] + sigmoidf_(v[i] * w.s) * pp[i]; ss += x[i] * x[i]; }
        hp[0] = (f32x4){x[0], x[1], x[2], x[3]}; hp[1] = (f32x4){x[4], x[5], x[6], x[7]};
        *(u32x4*)(HB + (size_t)r * D + col) = pack8(x);
        return ss;
    }
    __device__ __forceinline__ void rowsum(int r, int slot, float ss) const { ssq[r * 16 + slot] = ss; }
};


namespace pg8 {
constexpr int BM = 256, BK = 64, HALF = 128, HTB = HALF * BK * 2, STAGE_BYTES = 8 * HTB, NXCD = 8, WGM = 8;
__host__ __device__ __forceinline__ int lds_byte(int r, int c) { const int st = (r >> 4) * 2 + (c >> 5), rr = r & 15, cc = c & 31, ob = rr * 64 + cc * 2; return st * 1024 + (ob ^ (((ob >> 9) & 1) << 5)); }
__host__ __device__ __forceinline__ void stage_rc(int b, int& R, int& C) { const int st = b / 1024, sb = b % 1024, swz = sb ^ (((sb >> 9) & 1) << 5); R = (st >> 1) * 16 + swz / 64; C = (st & 1) * 32 + (swz % 64) / 2; }
__host__ __device__ __forceinline__ int perm32(int rho) { const int n = rho >> 4, i = rho & 15; return 8 * (i >> 2) + 4 * n + (i & 3); }
struct Unit { int pm, pn; };
struct StaticOrder {
    int nM, nN, nwg, G, c;
    __device__ void init(int M, int N, int G_, int c_) { nM = M / BM; nN = N / BM; nwg = nM * nN; G = G_; c = c_; }
    __device__ bool next(int i, Unit& u) const {
        const long L = (long)i * G + c; if (L >= nwg) return false;
        int wgid = (int)L; { const int q = nwg / NXCD, r = nwg % NXCD, xcd = wgid % NXCD, off = wgid / NXCD; wgid = (xcd < r ? xcd * (q + 1) : r * (q + 1) + (xcd - r) * q) + off; }
        const int nig = WGM * nN, gid = wgid / nig, fm = gid * WGM, gsz = (nM - fm) < WGM ? (nM - fm) : WGM;
        u.pm = fm + ((wgid % nig) % gsz); u.pn = (wgid % nig) / gsz; return true;
    }
};
struct MoeOrder {
    int ntile, G, c;
    __device__ bool next(int i, Unit& u) const { const int L = i * G + c; if (L >= ntile * 4) return false; u.pm = L >> 2; u.pn = L & 3; return true; }
};
template <class Prob, class Epi, class Sched>
__device__ __forceinline__ void gemm_phase(LAS unsigned char* lds, int tid, const Prob& P, const Sched& S, const Epi& E) {
    constexpr bool GATHER = Prob::GATHER;
    const int wid = __builtin_amdgcn_readfirstlane(tid >> 6), lane = tid & 63, wr = wid >> 2, wc = wid & 3, fr = lane & 15, fq = lane >> 4;
    const int K = P.K, nt = K / BK;
    unsigned voffA[2], voffB[2]; int RA[2], CA2[2];
#pragma unroll
    for (int i = 0; i < 2; ++i) { int R, C; stage_rc(tid * 16 + i * 8192, R, C); const int Rb = (R & ~31) + perm32(R & 31);
        voffA[i] = (unsigned)(R * K + C) * 2u; voffB[i] = (unsigned)(Rb * K + C) * 2u; RA[i] = R; CA2[i] = C * 2; }
    const size_t kstep = (size_t)(BK * 2);
    const size_t hstep = (size_t)HALF * K * 2;
    const unsigned ldsw = (unsigned)wid * 1024u;
    const int aoff = lds_byte(wr * 64 + fr, fq * 8), boff = lds_byte(wc * 32 + fr, fq * 8);
#define PG8_SA(b, h) (((b) * 2 + (h)) * HTB)
#define PG8_SB(b, h) ((4 + (b) * 2 + (h)) * HTB)
#define PG8_STAGE2(bufoff, gbase, v0, v1) do { \
        __builtin_amdgcn_global_load_lds((const unsigned*)((const char*)(gbase) + (v0)), (LAS unsigned*)(lds + (bufoff) + ldsw), 16, 0, 0); \
        __builtin_amdgcn_global_load_lds((const unsigned*)((const char*)(gbase) + (v1)), (LAS unsigned*)(lds + (bufoff) + ldsw + 8192), 16, 0, 0); } while (0)
#define PG8_STAGE_B(bufoff, gbase) PG8_STAGE2(bufoff, gbase, voffB[0], voffB[1])
#define PG8_STAGE_A(bufoff, gbase, h, nx) do { if constexpr (GATHER) { PG8_STAGE2(bufoff, gbase, (nx) ? nvA[h][0] : cvA[h][0], (nx) ? nvA[h][1] : cvA[h][1]); } \
        else { PG8_STAGE2(bufoff, (gbase) + (h) * hstep, voffA[0], voffA[1]); } } while (0)
#define PG8_LDA(dst, b, h) do { _Pragma("unroll") for (int m = 0; m < 4; ++m) _Pragma("unroll") for (int k = 0; k < 2; ++k) dst[m][k] = *(const LAS bf16x8*)(lds + PG8_SA(b, h) + aoff + m * 2048 + k * 1024); } while (0)
#define PG8_LDB(dst, b, h) do { _Pragma("unroll") for (int n = 0; n < 2; ++n) _Pragma("unroll") for (int k = 0; k < 2; ++k) dst[n][k] = *(const LAS bf16x8*)(lds + PG8_SB(b, h) + boff + n * 2048 + k * 1024); } while (0)
#define PG8_MMA(ai, bj, At, Bt) do { __builtin_amdgcn_s_setprio(1); _Pragma("unroll") for (int m = 0; m < 4; ++m) _Pragma("unroll") for (int n = 0; n < 2; ++n) _Pragma("unroll") for (int k = 0; k < 2; ++k) \
        acc[ai][bj][m][n] = __builtin_amdgcn_mfma_f32_16x16x32_bf16(Bt[n][k], At[m][k], acc[ai][bj][m][n], 0, 0, 0); __builtin_amdgcn_s_setprio(0); } while (0)
#define PG8_WAIT_V(n) asm volatile("s_waitcnt vmcnt(" #n ")" ::: "memory")
#define PG8_WAIT_L(n) asm volatile("s_waitcnt lgkmcnt(" #n ")" ::: "memory")
#define PG8_BAR __builtin_amdgcn_s_barrier()
#define PG8_SCHED __builtin_amdgcn_sched_barrier(0)
    Unit cur, nxt; int ui = 0;
    if (!S.next(0, cur)) return;
    f32x4 acc[2][2][4][2];
#pragma unroll
    for (int a = 0; a < 2; ++a)
#pragma unroll
        for (int b = 0; b < 2; ++b)
#pragma unroll
            for (int m = 0; m < 4; ++m)
#pragma unroll
                for (int n = 0; n < 2; ++n) acc[a][b][m][n] = (f32x4){0.f, 0.f, 0.f, 0.f};
    bf16x8 At[4][2], B0[2][2], B1[2][2];
    unsigned cvA[2][2], nvA[2][2];
    if constexpr (GATHER) {
#pragma unroll
        for (int h = 0; h < 2; ++h)
#pragma unroll
            for (int i = 0; i < 2; ++i) { cvA[h][i] = P.arow_off(cur, h * HALF + RA[i]) + (unsigned)CA2[i]; nvA[h][i] = cvA[h][i]; }
    } else { cvA[0][0] = cvA[0][1] = cvA[1][0] = cvA[1][1] = 0u; nvA[0][0] = nvA[0][1] = nvA[1][0] = nvA[1][1] = 0u; }
    const char* cA = P.abase(cur); const char* cB = P.bbase(cur);
    PG8_STAGE_B(PG8_SB(0, 0), cB); PG8_STAGE_B(PG8_SB(0, 1), cB + hstep); PG8_STAGE_A(PG8_SA(0, 0), cA, 0, false); PG8_STAGE_A(PG8_SA(0, 1), cA, 1, false);
    if (wr == 1) PG8_BAR;
    PG8_WAIT_V(2); PG8_BAR;
    PG8_STAGE_B(PG8_SB(1, 0), cB + kstep); PG8_STAGE_A(PG8_SA(1, 0), cA + kstep, 0, false); PG8_STAGE_B(PG8_SB(1, 1), cB + hstep + kstep);
    PG8_WAIT_V(6); PG8_BAR;
    for (;;) {
        const bool has_next = S.next(ui + 1, nxt);
        const char* nA = has_next ? P.abase(nxt) : cA; const char* nB = has_next ? P.bbase(nxt) : cB;
        if constexpr (GATHER) {
            if (has_next) {
#pragma unroll
                for (int h = 0; h < 2; ++h)
#pragma unroll
                    for (int i = 0; i < 2; ++i) nvA[h][i] = P.arow_off(nxt, h * HALF + RA[i]) + (unsigned)CA2[i];
            }
        }
        for (int t = 0; t < nt; t += 2) {
            const bool last = (t == nt - 2);
            const char* a1 = cA + (size_t)(t + 1) * kstep;
            const char* a2 = last ? nA : cA + (size_t)(t + 2) * kstep; const char* b2 = last ? nB : cB + (size_t)(t + 2) * kstep;
            const char* a3 = a2 + kstep; const char* b3 = b2 + kstep;
            PG8_LDB(B0, 0, 0); PG8_LDB(B1, 0, 1); PG8_SCHED; PG8_LDA(At, 0, 0); PG8_STAGE_A(PG8_SA(1, 1), a1, 1, false);
            PG8_WAIT_V(8); PG8_WAIT_L(0); PG8_BAR; PG8_MMA(0, 0, At, B0); PG8_MMA(0, 1, At, B1); PG8_BAR; PG8_SCHED;
            PG8_LDA(At, 0, 1); PG8_STAGE_B(PG8_SB(0, 0), b2); PG8_STAGE_B(PG8_SB(0, 1), b2 + hstep); PG8_STAGE_A(PG8_SA(0, 0), a2, 0, last);
            PG8_WAIT_V(8); PG8_WAIT_L(0); PG8_BAR; PG8_MMA(1, 0, At, B0); PG8_MMA(1, 1, At, B1); PG8_BAR; PG8_SCHED;
            PG8_LDB(B0, 1, 0); PG8_LDB(B1, 1, 1); PG8_SCHED; PG8_LDA(At, 1, 0); PG8_STAGE_A(PG8_SA(0, 1), a2, 1, last);
            PG8_WAIT_V(8); PG8_WAIT_L(0); PG8_BAR; PG8_MMA(0, 0, At, B0); PG8_MMA(0, 1, At, B1); PG8_BAR; PG8_SCHED;
            PG8_LDA(At, 1, 1); PG8_STAGE_B(PG8_SB(1, 0), b3); PG8_STAGE_B(PG8_SB(1, 1), b3 + hstep); PG8_STAGE_A(PG8_SA(1, 0), a3, 0, last);
            PG8_WAIT_V(8); PG8_WAIT_L(0); PG8_BAR; PG8_MMA(1, 0, At, B0); PG8_MMA(1, 1, At, B1); PG8_BAR; PG8_SCHED;
        }
        if (wr == 0) PG8_BAR;
        { int fr_e = fr, fq_e = fq; asm volatile("" : "+v"(fr_e), "+v"(fq_e));
          E(acc, cur, wr, wc, fr_e, fq_e); }
        if (!has_next) break;
#pragma unroll
        for (int a = 0; a < 2; ++a)
#pragma unroll
            for (int b = 0; b < 2; ++b)
#pragma unroll
                for (int m = 0; m < 4; ++m)
#pragma unroll
                    for (int n = 0; n < 2; ++n) acc[a][b][m][n] = (f32x4){0.f, 0.f, 0.f, 0.f};
        cur = nxt; cA = nA; cB = nB; ++ui;
        if constexpr (GATHER) {
#pragma unroll
            for (int h = 0; h < 2; ++h)
#pragma unroll
                for (int i = 0; i < 2; ++i) cvA[h][i] = nvA[h][i];
        }
        if (wr == 1) PG8_BAR;
    }
    PG8_WAIT_V(0);
    PG8_BAR;
#undef PG8_SA
#undef PG8_SB
#undef PG8_STAGE2
#undef PG8_STAGE_A
#undef PG8_STAGE_B
#undef PG8_LDA
#undef PG8_LDB
#undef PG8_MMA
#undef PG8_WAIT_V
#undef PG8_WAIT_L
#undef PG8_BAR
#undef PG8_SCHED
}
template <class E> struct EpiAdapt {
    E e;
    __device__ __forceinline__ void operator()(const f32x4 (&acc)[2][2][4][2], const Unit& u, int wr, int wc, int fr, int fq) const {
#pragma unroll
        for (int ai = 0; ai < 2; ++ai)
#pragma unroll
            for (int m = 0; m < 4; ++m) {
                const int row = u.pm * BM + ai * HALF + wr * 64 + m * 16 + fr;
                const typename E::Row rw = e.row(row);
                float ss = 0.f;
#pragma unroll
                for (int bj = 0; bj < 2; ++bj) {
                    const int col = u.pn * BM + bj * HALF + wc * 32 + fq * 8;
                    const f32x4 a0 = acc[ai][bj][m][0], a1 = acc[ai][bj][m][1];
                    const float v[8] = {a0[0], a0[1], a0[2], a0[3], a1[0], a1[1], a1[2], a1[3]};
                    ss += e(row, col, v, rw);
                }
                ss += __shfl_xor(ss, 16); ss += __shfl_xor(ss, 32);
                if (fq == 0) e.rowsum(row, u.pn * 4 + wc, ss);
            }
    }
};
struct DenseProb {
    static constexpr bool GATHER = false;
    const bf16_t* A; const bf16_t* Bt; int K;
    __device__ __forceinline__ const char* abase(const Unit& u) const { return (const char*)A + (size_t)u.pm * BM * K * 2; }
    __device__ __forceinline__ unsigned arow_off(const Unit&, int) const { return 0u; }
    __device__ __forceinline__ const char* bbase(const Unit& u) const { return (const char*)Bt + (size_t)u.pn * BM * K * 2; }
};
}
struct MoeGatherProb {
    static constexpr bool GATHER = true;
    MoeTab mt; const int* list; const bf16_t* HB; const bf16_t* W; int K;
    __device__ __forceinline__ const char* abase(const pg8::Unit&) const { return (const char*)HB; }
    __device__ __forceinline__ unsigned arow_off(const pg8::Unit& u, int r) const { const MoeRow m = moe_row(mt, list, u.pm * 256 + r); return (unsigned)(m.tok >= 0 ? m.tok : 0) * (unsigned)(D * 2); }
    __device__ __forceinline__ const char* bbase(const pg8::Unit& u) const { return (const char*)W + ((size_t)mt.tile2e[u.pm] * D + (size_t)u.pn * 256) * D * 2; }
};
struct MoeDownProb {
    static constexpr bool GATHER = false;
    MoeTab mt; const bf16_t* ACT; const bf16_t* W; int K;
    __device__ __forceinline__ const char* abase(const pg8::Unit& u) const { return (const char*)ACT + (size_t)u.pm * 256 * DEXP * 2; }
    __device__ __forceinline__ unsigned arow_off(const pg8::Unit&, int) const { return 0u; }
    __device__ __forceinline__ const char* bbase(const pg8::Unit& u) const { return (const char*)W + ((size_t)mt.tile2e[u.pm] * D + (size_t)u.pn * 256) * DEXP * 2; }
};
template <class E> __device__ __forceinline__ void gemm_dense(Ctx& C, const bf16_t* A, const bf16_t* Bt, int N, int K, const E& e) {
    pg8::DenseProb P{A, Bt, K}; pg8::StaticOrder S; S.init(T, N, C.nblk, C.bid); pg8::EpiAdapt<E> ea{e};
    pg8::gemm_phase(C.lds, C.tid, P, S, ea);
}

__device__ __forceinline__ void phase_conv(Ctx& C, int j) {
    const bf16_t* P3 = WSP(bf16_t, WS_P3); bf16_t* MIX = WSP(bf16_t, WS_MIX); const float* cw = WSP(float, WS_PAR) + PAR_CONV + (size_t)j * 3 * 512;
    const int gt = C.bid * NTHREADS + C.tid, NGT = C.nblk * NTHREADS;
    for (int i = gt; i < T * 64; i += NGT) {
        const int t = i >> 6, c = (i & 63) * 8, s = t & (SEQ - 1);
        float acc[8];
#pragma unroll
        for (int q = 0; q < 8; ++q) acc[q] = 0.f;
#pragma unroll
        for (int k = 0; k < 3; ++k) {
            const int dt = 2 - k;
            if (s - dt >= 0) {
                float xc[8], gc[8]; unpack8(*(const u32x4*)(P3 + (size_t)(t - dt) * 1536 + c), xc); unpack8(*(const u32x4*)(P3 + (size_t)(t - dt) * 1536 + 1024 + c), gc);
#pragma unroll
                for (int q = 0; q < 8; ++q) acc[q] += cw[k * 512 + c + q] * (gc[q] * xc[q]);
            }
        }
        float gb[8]; unpack8(*(const u32x4*)(P3 + (size_t)t * 1536 + 512 + c), gb);
#pragma unroll
        for (int q = 0; q < 8; ++q) acc[q] *= gb[q];
        *(u32x4*)(MIX + (size_t)t * D + c) = pack8(acc);
    }
}

__device__ __forceinline__ void phase_attn_naive(Ctx& C) {
    const bf16_t* Q = WSP(bf16_t, WS_Q); const bf16_t* KV = WSP(bf16_t, WS_KV); const bf16_t* KPE = WSP(bf16_t, WS_KPE); bf16_t* MIX = WSP(bf16_t, WS_MIX);
    LAS float* Ks = (LAS float*)C.lds;
    LAS float* Vs = Ks + 64 * 97;
    LAS float* Qs = Vs + 64 * 64;
    LAS float* Ps = Qs + 64 * 96;
    const int tid = C.tid, lane = C.lane, wave = C.wave;
    const int nunits = NBATCH * NH * (SEQ / 64);
    for (int u = C.bid; u < nunits; u += C.nblk) {
        const int qb = (SEQ / 64 - 1) - (u / (NBATCH * NH)), bh = u % (NBATCH * NH), b = bh / NH, h = bh % NH;
        const int t0 = b * SEQ + qb * 64;
        __syncthreads();
        for (int i = tid; i < 64 * 12; i += NTHREADS) { const int r = i / 12, c8 = (i % 12) * 8; float v[8]; unpack8(*(const u32x4*)(Q + (size_t)(t0 + r) * 768 + h * 96 + c8), v);
#pragma unroll
            for (int q = 0; q < 8; ++q) Qs[r * 96 + c8 + q] = v[q]; }
        float m[8], l[8], o[8];
#pragma unroll
        for (int i = 0; i < 8; ++i) { m[i] = -1e30f; l[i] = 0.f; o[i] = 0.f; }
        for (int kt = 0; kt <= qb; ++kt) {
            const int k0 = b * SEQ + kt * 64;
            __syncthreads();
            for (int i = tid; i < 64 * 20; i += NTHREADS) { const int r = i / 20, c = i % 20; float v[8];
                if (c < 8) { unpack8(*(const u32x4*)(KV + (size_t)(k0 + r) * 1024 + h * 128 + c * 8), v);
#pragma unroll
                    for (int q = 0; q < 8; ++q) Ks[r * 97 + c * 8 + q] = v[q]; }
                else if (c < 12) { unpack8(*(const u32x4*)(KPE + (size_t)(k0 + r) * 32 + (c - 8) * 8), v);
#pragma unroll
                    for (int q = 0; q < 8; ++q) Ks[r * 97 + c * 8 + q] = v[q]; }
                else { unpack8(*(const u32x4*)(KV + (size_t)(k0 + r) * 1024 + h * 128 + 64 + (c - 12) * 8), v);
#pragma unroll
                    for (int q = 0; q < 8; ++q) Vs[r * 64 + (c - 12) * 8 + q] = v[q]; } }
            __syncthreads();
#pragma unroll
            for (int qi = 0; qi < 8; ++qi) {
                const int qr = wave * 8 + qi;
                float s = 0.f;
                for (int d = 0; d < 96; ++d) s += Qs[qr * 96 + d] * Ks[lane * 97 + d];
                if (kt == qb && lane > qr) s = -1e30f;
                const float mn = fmaxf(m[qi], wave_max(s));
                const float p = exp2f(s - mn), al = exp2f(m[qi] - mn);
                const float pb = rbf(p);
                l[qi] = l[qi] * al + wave_sum(p); m[qi] = mn;
                Ps[wave * 64 + lane] = pb;
                asm volatile("s_waitcnt lgkmcnt(0)" ::: "memory");
                float acc = 0.f;
                for (int k = 0; k < 64; ++k) acc += Ps[wave * 64 + k] * Vs[k * 64 + lane];
                o[qi] = o[qi] * al + acc;
                asm volatile("s_waitcnt lgkmcnt(0)" ::: "memory");
            }
        }
#pragma unroll
        for (int qi = 0; qi < 8; ++qi) MIX[(size_t)(t0 + wave * 8 + qi) * D + 512 + h * 64 + lane] = (bf16_t)f2bf(o[qi] / l[qi]);
    }
    __syncthreads();
}


typedef float f32x16 __attribute__((ext_vector_type(16)));
typedef short s16x4 __attribute__((ext_vector_type(4)));
typedef short v4i16_t __attribute__((ext_vector_type(4)));
__device__ __forceinline__ int crow(int r, int hi) { return (r & 3) + 8 * (r >> 2) + 4 * hi; }
__device__ __forceinline__ s16x4 vtr(const LAS unsigned char* p) { return __builtin_bit_cast(s16x4, __builtin_amdgcn_ds_read_tr16_b64_v4i16((LAS v4i16_t*)p)); }
#ifndef ATT_THR
#define ATT_THR 5.0f
#endif
__device__ __forceinline__ void phase_attn(Ctx& C) {
    const bf16_t* Q = WSP(bf16_t, WS_Q); const bf16_t* KV = WSP(bf16_t, WS_KV); const bf16_t* KPE = WSP(bf16_t, WS_KPE); bf16_t* MIX = WSP(bf16_t, WS_MIX);
    constexpr int KROW = 208, KBUF = 64 * KROW, VBUF = 8192, OFF_K = 0, OFF_V = 2 * KBUF, OFF_WS = OFF_V + 2 * VBUF, OFF_OST = OFF_WS + 8 * 128;
    LAS unsigned char* lds = C.lds;
    const int tid = C.tid, lane = C.lane, wave = C.wave, r32 = lane & 31, hi = lane >> 5;
    LAS float* wsf = (LAS float*)(lds + OFF_WS + wave * 128);
    LAS unsigned char* ost = lds + OFF_OST + wave * 4096;
    const int krow = tid >> 3, kch = tid & 7, prow = tid >> 2, pch = tid & 3;
    const int kdst = krow * KROW + kch * 16, vdst = (kch >> 2) * 4096 + krow * 64 + (kch & 3) * 16, pdst = prow * KROW + 128 + pch * 16;
    const int kfrag = r32 * KROW + hi * 16;
    const int vfrag = ((lane >> 4) & 1) * 32 + (lane & 3) * 8 + (4 * hi + ((lane & 15) >> 2)) * 64;
    for (int pr = C.bid; pr < 256; pr += C.nblk) {
        for (int half = 0; half < 2; ++half) {
            const int bh = pr >> 3, qq = pr & 7, qb = half == 0 ? 15 - qq : qq, b = bh >> 3, h = bh & 7;
            const int tb = b * SEQ, t0 = tb + qb * 256, NT = 4 * qb + 4;
            bf16x8 qf[6];
            { const bf16_t* qp = Q + (size_t)(t0 + wave * 32 + r32) * 768 + h * 96 + hi * 8;
#pragma unroll
              for (int s = 0; s < 6; ++s) qf[s] = *(const bf16x8*)(qp + 16 * s); }
            f32x16 o0, o1;
#pragma unroll
            for (int r = 0; r < 16; ++r) { o0[r] = 0.f; o1[r] = 0.f; }
            float mref = -1e30f, lsum = 0.f;
            const bf16_t* ksrc = KV + (size_t)(tb + krow) * 1024 + h * 128 + kch * 8;
            const bf16_t* vsrc = ksrc + 64;
            const bf16_t* psrc = KPE + (size_t)(tb + prow) * 32 + pch * 8;
            u32x4 kreg, vreg, preg;
            kreg = *(const u32x4*)ksrc; vreg = *(const u32x4*)vsrc; preg = (tid < 256) ? *(const u32x4*)psrc : (u32x4){0u, 0u, 0u, 0u};
            __syncthreads();
            *(LAS u32x4*)(lds + OFF_K + kdst) = kreg; *(LAS u32x4*)(lds + OFF_V + vdst) = vreg; if (tid < 256) *(LAS u32x4*)(lds + OFF_K + pdst) = preg;
            __syncthreads();
            const int qmin = qb * 256 + wave * 32;
            for (int t = 0; t < NT; ++t) {
                const int cur = t & 1;
                if (t + 1 < NT) { const size_t adv = (size_t)(t + 1) * 64; kreg = *(const u32x4*)(ksrc + adv * 1024); vreg = *(const u32x4*)(vsrc + adv * 1024); if (tid < 256) preg = *(const u32x4*)(psrc + adv * 32); }
                const int kmin = 64 * t;
                if (kmin <= qmin + 31) {
                    f32x16 p0, p1;
#pragma unroll
                    for (int r = 0; r < 16; ++r) { p0[r] = 0.f; p1[r] = 0.f; }
                    const LAS unsigned char* kb = lds + OFF_K + cur * KBUF + kfrag;
#pragma unroll
                    for (int s = 0; s < 6; ++s) {
                        const bf16x8 k0 = *(const LAS bf16x8*)(kb + s * 32), k1 = *(const LAS bf16x8*)(kb + 32 * KROW + s * 32);
                        p0 = __builtin_amdgcn_mfma_f32_32x32x16_bf16(k0, qf[s], p0, 0, 0, 0);
                        p1 = __builtin_amdgcn_mfma_f32_32x32x16_bf16(k1, qf[s], p1, 0, 0, 0);
                    }
                    if (kmin + 63 > qmin) {
                        const int qd = qmin + r32 - kmin;
#pragma unroll
                        for (int r = 0; r < 16; ++r) { const int kv = crow(r, hi); if (kv > qd) p0[r] = -1e30f; if (kv + 32 > qd) p1[r] = -1e30f; }
                    }
                    float rm = fmaxf(p0[0], p1[0]);
#pragma unroll
                    for (int r = 1; r < 16; ++r) rm = fmaxf(rm, fmaxf(p0[r], p1[r]));
                    rm = fmaxf(rm, __shfl_xor(rm, 32));
                    if (__any(rm > mref + ATT_THR)) {
                        const float mnew = fmaxf(mref, rm), f = __builtin_amdgcn_exp2f(mref - mnew);
                        lsum *= f; mref = mnew;
                        if (hi == 0) wsf[r32] = f;
                        asm volatile("s_waitcnt lgkmcnt(0)" ::: "memory");
#pragma unroll
                        for (int r = 0; r < 16; ++r) { const float fr = wsf[crow(r, hi)]; o0[r] *= fr; o1[r] *= fr; }
                        asm volatile("s_waitcnt lgkmcnt(0)" ::: "memory");
                    }
#pragma unroll
                    for (int r = 0; r < 16; ++r) { p0[r] = __builtin_amdgcn_exp2f(p0[r] - mref); p1[r] = __builtin_amdgcn_exp2f(p1[r] - mref); lsum += p0[r] + p1[r]; }
                    u32x4 pw[4];
#pragma unroll
                    for (int i = 0; i < 4; ++i) { pw[0][i] = pk2(p0[2 * i], p0[2 * i + 1]); pw[1][i] = pk2(p0[8 + 2 * i], p0[9 + 2 * i]); pw[2][i] = pk2(p1[2 * i], p1[2 * i + 1]); pw[3][i] = pk2(p1[8 + 2 * i], p1[9 + 2 * i]); }
                    const LAS unsigned char* vb = lds + OFF_V + cur * VBUF + vfrag;
#pragma unroll
                    for (int ks = 0; ks < 4; ++ks) {
                        const s16x4 a0 = vtr(vb + ks * 1024), a1 = vtr(vb + ks * 1024 + 512), b0 = vtr(vb + 4096 + ks * 1024), b1 = vtr(vb + 4096 + ks * 1024 + 512);
                        const bf16x8 v0 = (bf16x8){a0[0], a0[1], a0[2], a0[3], a1[0], a1[1], a1[2], a1[3]}, v1 = (bf16x8){b0[0], b0[1], b0[2], b0[3], b1[0], b1[1], b1[2], b1[3]};
                        const bf16x8 pa = __builtin_bit_cast(bf16x8, pw[ks]);
                        o0 = __builtin_amdgcn_mfma_f32_32x32x16_bf16(pa, v0, o0, 0, 0, 0);
                        o1 = __builtin_amdgcn_mfma_f32_32x32x16_bf16(pa, v1, o1, 0, 0, 0);
                    }
                }
                if (t + 1 < NT) { const int nb = cur ^ 1; *(LAS u32x4*)(lds + OFF_K + nb * KBUF + kdst) = kreg; *(LAS u32x4*)(lds + OFF_V + nb * VBUF + vdst) = vreg; if (tid < 256) *(LAS u32x4*)(lds + OFF_K + nb * KBUF + pdst) = preg; }
                __syncthreads();
            }
            const float ltot = lsum + __shfl_xor(lsum, 32);
            if (hi == 0) wsf[r32] = 1.0f / ltot;
            asm volatile("s_waitcnt lgkmcnt(0)" ::: "memory");
#pragma unroll
            for (int r = 0; r < 16; ++r) { const int q = crow(r, hi); const float fr = wsf[q];
                *(LAS bf16_t*)(ost + q * 128 + r32 * 2) = (bf16_t)f2bf(o0[r] * fr); *(LAS bf16_t*)(ost + q * 128 + 64 + r32 * 2) = (bf16_t)f2bf(o1[r] * fr); }
            asm volatile("s_waitcnt lgkmcnt(0)" ::: "memory");
#pragma unroll
            for (int i = 0; i < 4; ++i) { const int idx = i * 64 + lane, q = idx >> 3, c = idx & 7;
                const u32x4 w = *(const LAS u32x4*)(ost + q * 128 + c * 16);
                *(u32x4*)(MIX + (size_t)(t0 + wave * 32 + q) * D + 512 + h * 64 + c * 8) = w; }
        }
    }
    __syncthreads();
}


__device__ __forceinline__ void phase_sg(Ctx& C, int j) {
    const bf16_t* Z = WSP(bf16_t, WS_Z); const float* ssqx = WSP(float, WS_SSQX); const bf16_t* WS = WSP(bf16_t, WS_WS) + (size_t)j * 8 * 128 * 128; bf16_t* MIX = WSP(bf16_t, WS_MIX);
    const float* vg = WSP(float, WS_PAR) + PAR_VN + j * D; const float* bs = WSP(float, WS_PAR) + PAR_BS + (size_t)j * 8 * 128;
    LAS unsigned char* lds = C.lds;
    const int tid = C.tid, lane = C.lane, wave = C.wave, r32 = lane & 31, hi = lane >> 5, wr = wave >> 1, wc = wave & 1;
    const int srow = tid >> 2, sblk = tid & 3;
    const int vfrag = ((lane >> 4) & 1) * 32 + (lane & 3) * 8 + (8 * hi + ((lane & 15) >> 2)) * 64;
    for (int u = C.bid; u < NBATCH * 32 * 8; u += C.nblk) {
        const int g = u & 7, bc = u >> 3, t0 = bc * 128;
        __syncthreads();
        {
            const float rv = rs_from(ssqx + (t0 + srow) * 36 + 16, 16, 1.f / 1024);
            const bf16_t* zp = Z + (size_t)(t0 + srow) * 2048 + 1024 + g * 128 + sblk * 32; const float* gp = vg + g * 128 + sblk * 32;
#pragma unroll
            for (int c = 0; c < 4; ++c) { float v[8]; unpack8(*(const u32x4*)(zp + c * 8), v);
#pragma unroll
                for (int q = 0; q < 8; ++q) v[q] = v[q] * rv * gp[c * 8 + q];
                *(LAS u32x4*)(lds + sblk * 8192 + srow * 64 + c * 16) = pack8(v); }
        }
        __syncthreads();
        f32x16 a0, a1;
#pragma unroll
        for (int r = 0; r < 16; ++r) { a0[r] = 0.f; a1[r] = 0.f; }
        const bf16_t* wp = WS + (size_t)g * 16384 + (32 * wr + r32) * 128 + 8 * hi;
        const LAS unsigned char* vb = lds + (2 * wc) * 8192 + vfrag;
        for (int ks = 0; ks < 2 * wr + 2; ++ks) {
            const bf16x8 wf = *(const bf16x8*)(wp + 16 * ks);
            const s16x4 x0 = vtr(vb + ks * 1024), x1 = vtr(vb + ks * 1024 + 256), y0 = vtr(vb + 8192 + ks * 1024), y1 = vtr(vb + 8192 + ks * 1024 + 256);
            const bf16x8 v0 = (bf16x8){x0[0], x0[1], x0[2], x0[3], x1[0], x1[1], x1[2], x1[3]}, v1 = (bf16x8){y0[0], y0[1], y0[2], y0[3], y1[0], y1[1], y1[2], y1[3]};
            a0 = __builtin_amdgcn_mfma_f32_32x32x16_bf16(wf, v0, a0, 0, 0, 0);
            a1 = __builtin_amdgcn_mfma_f32_32x32x16_bf16(wf, v1, a1, 0, 0, 0);
        }
#pragma unroll
        for (int r = 0; r < 16; ++r) {
            const int t = 32 * wr + crow(r, hi); const float bias = bs[g * 128 + t];
            const size_t zo = (size_t)(t0 + t) * 2048 + g * 128 + 64 * wc + r32, mo = (size_t)(t0 + t) * D + g * 128 + 64 * wc + r32;
            MIX[mo] = (bf16_t)f2bf(bf2f(Z[zo]) * (a0[r] + bias)); MIX[mo + 32] = (bf16_t)f2bf(bf2f(Z[zo + 32]) * (a1[r] + bias));
        }
    }
    __syncthreads();
}

__device__ __forceinline__ void phase_sg_naive(Ctx& C, int j) {
    const bf16_t* Z = WSP(bf16_t, WS_Z); const float* ssqx = WSP(float, WS_SSQX); const bf16_t* WS = WSP(bf16_t, WS_WS) + (size_t)j * 8 * 128 * 128; bf16_t* MIX = WSP(bf16_t, WS_MIX);
    const float* vg = WSP(float, WS_PAR) + PAR_VN + j * D; const float* bs = WSP(float, WS_PAR) + PAR_BS + (size_t)j * 8 * 128;
    LAS float* Wt = (LAS float*)C.lds;
    LAS float* Vn = Wt + 128 * 129;
    const int tid = C.tid;
    for (int u = C.bid; u < NBATCH * 32 * 8; u += C.nblk) {
        const int g = u & 7, bc = u >> 3, t0 = bc * 128;
        __syncthreads();
        for (int i = tid; i < 128 * 16; i += NTHREADS) { const int r = i >> 4, c8 = (i & 15) * 8; float v[8];
            unpack8(*(const u32x4*)(WS + (size_t)g * 16384 + r * 128 + c8), v);
#pragma unroll
            for (int q = 0; q < 8; ++q) Wt[r * 129 + c8 + q] = v[q];
            unpack8(*(const u32x4*)(Z + (size_t)(t0 + r) * 2048 + 1024 + g * 128 + c8), v);
            const float rv = rs_from(ssqx + (t0 + r) * 36 + 16, 16, 1.f / 1024);
#pragma unroll
            for (int q = 0; q < 8; ++q) Vn[r * 128 + c8 + q] = rbf(v[q] * rv * vg[g * 128 + c8 + q]); }
        __syncthreads();
        const int t = tid >> 2, d0 = (tid & 3) * 32;
        float acc[32];
#pragma unroll
        for (int i = 0; i < 32; ++i) acc[i] = 0.f;
        for (int s = 0; s <= t; ++s) { const float w = Wt[t * 129 + s];
#pragma unroll
            for (int i = 0; i < 32; ++i) acc[i] += w * Vn[s * 128 + d0 + i]; }
        const float bias = bs[g * 128 + t];
#pragma unroll
        for (int i8 = 0; i8 < 4; ++i8) { float uu[8], o[8]; unpack8(*(const u32x4*)(Z + (size_t)(t0 + t) * 2048 + g * 128 + d0 + i8 * 8), uu);
#pragma unroll
            for (int q = 0; q < 8; ++q) o[q] = uu[q] * (acc[i8 * 8 + q] + bias);
            *(u32x4*)(MIX + (size_t)(t0 + t) * D + g * 128 + d0 + i8 * 8) = pack8(o); }
    }
    __syncthreads();
}

__device__ __forceinline__ void phase_router(Ctx& C, int layer) {
    const bf16_t* HB = WSP(bf16_t, WS_HB0); const float* ssq = WSP(float, WS_SSQ0); const bf16_t* WR = WSP(bf16_t, WS_WR) + (size_t)layer * 64 * D;
    int* tok_e = WSP(int, WS_TOK); int* tok_pos = tok_e + 2 * T; float* rffn = (float*)(tok_pos + 2 * T);
    int* list = WSP(int, WS_LIST); float* lw = WSP(float, WS_LW); unsigned* cnt = WSP(unsigned, WS_CTL) + CW_CNT + layer * 64;
    LAS u32x4* Wl = (LAS u32x4*)C.lds;
    const int lane = C.lane;
    __syncthreads();
    for (int i = C.tid; i < 36 * 128; i += NTHREADS) Wl[i] = *(const u32x4*)(WR + (size_t)i * 8);
    __syncthreads();
    const int gw = C.bid * NWAVES + C.wave, NGW = C.nblk * NWAVES;
    for (int m = gw; m < T; m += NGW) {
        const float r = rs_from(ssq + m * 16, 16, 1.f / D);
        float x0[8], x1[8];
        unpack8(*(const u32x4*)(HB + (size_t)m * D + lane * 8), x0); unpack8(*(const u32x4*)(HB + (size_t)m * D + 512 + lane * 8), x1);
        LAS float* lgs = (LAS float*)(C.lds + 36 * 128 * 16) + C.wave * 64;
#pragma unroll 2
        for (int n = 0; n < 36; ++n) {
            float w0[8], w1[8]; unpack8(Wl[n * 128 + lane], w0); unpack8(Wl[n * 128 + 64 + lane], w1);
            float s = 0.f;
#pragma unroll
            for (int i = 0; i < 8; ++i) s += x0[i] * w0[i] + x1[i] * w1[i];
            s = wave_sum(s) * r;
            if (lane == 0) lgs[n] = s;
        }
        asm volatile("s_waitcnt lgkmcnt(0)" ::: "memory");
        const float g0 = lgs[0], g1 = lgs[1], g2 = lgs[2], g3 = lgs[3];
        int g = 0; float gm = g0;
        if (g1 > gm) { gm = g1; g = 1; }
        if (g2 > gm) { gm = g2; g = 2; }
        if (g3 > gm) { gm = g3; g = 3; }
        const float gs = __expf(g0 - gm) + __expf(g1 - gm) + __expf(g2 - gm) + __expf(g3 - gm);
        const float gw_ = 1.0f / gs;
        float el[8];
#pragma unroll
        for (int q = 0; q < 8; ++q) el[q] = lgs[4 + g * 8 + q];
        asm volatile("s_waitcnt lgkmcnt(0)" ::: "memory");
        int i1 = 0; float m1 = el[0];
#pragma unroll
        for (int q = 1; q < 8; ++q) if (el[q] > m1) { m1 = el[q]; i1 = q; }
        int i2 = -1; float m2 = -3.0e38f;
#pragma unroll
        for (int q = 0; q < 8; ++q) if (q != i1 && el[q] > m2) { m2 = el[q]; i2 = q; }
        const float e2 = __expf(m2 - m1), p1 = 1.0f / (1.0f + e2), p2 = e2 / (1.0f + e2);
        if (lane == 0) {
            rffn[m] = r;
            const int ea = g * 8 + i1, eb = g * 8 + i2;
            const int pa = (int)atomicAdd(cnt + ea, 1u), pb = (int)atomicAdd(cnt + eb, 1u);
            list[ea * T + pa] = m; lw[ea * T + pa] = gw_ * p1; list[eb * T + pb] = m; lw[eb * T + pb] = gw_ * p2;
            tok_e[2 * m] = ea; tok_e[2 * m + 1] = eb; tok_pos[2 * m] = pa; tok_pos[2 * m + 1] = pb;
        }
    }
    __syncthreads();
}

__device__ __forceinline__ void phase_combine(Ctx& C, int layer) {
    const MoeTab mt = moe_tables(C, layer);
    float* H = WSP(float, WS_H); bf16_t* HB = WSP(bf16_t, WS_HB1); float* SS = WSP(float, WS_SSQ1); const bf16_t* Y = WSP(bf16_t, WS_Y);
    const int* tok_e = WSP(int, WS_TOK); const int* tok_pos = tok_e + 2 * T;
    const int gw = C.bid * NWAVES + C.wave, NGW = C.nblk * NWAVES, lane = C.lane;
    for (int m = gw; m < T; m += NGW) {
        const int ea = tok_e[2 * m], eb = tok_e[2 * m + 1];
        const size_t sa = (size_t)mt.ebase[ea] * 256 + tok_pos[2 * m], sb = (size_t)mt.ebase[eb] * 256 + tok_pos[2 * m + 1];
        f32x4* hr = (f32x4*)(H + (size_t)m * D) + lane; const u32x2* ya = (const u32x2*)(Y + sa * D) + lane; const u32x2* yb = (const u32x2*)(Y + sb * D) + lane;
        u32x2* ob = (u32x2*)(HB + (size_t)m * D) + lane; float s = 0.f;
#pragma unroll
        for (int j = 0; j < 4; ++j) {
            f32x4 v = hr[64 * j]; const u32x2 a = ya[64 * j], b = yb[64 * j];
            v.x += bf2f(a.x & 0xffffu) + bf2f(b.x & 0xffffu); v.y += bf2f(a.x >> 16) + bf2f(b.x >> 16); v.z += bf2f(a.y & 0xffffu) + bf2f(b.y & 0xffffu); v.w += bf2f(a.y >> 16) + bf2f(b.y >> 16);
            hr[64 * j] = v; s += (v.x * v.x + v.y * v.y) + (v.z * v.z + v.w * v.w); u32x2 o; o.x = pk2(v.x, v.y); o.y = pk2(v.z, v.w); ob[64 * j] = o;
        }
        s = wave_sum(s);
        if (lane < 16) SS[m * 16 + lane] = (lane == 0) ? s : 0.f;
    }
    __syncthreads();
}

__device__ __forceinline__ void phase_final(Ctx& C, float* outp) {
    const float* H = WSP(float, WS_H); const float* SS = WSP(float, WS_SSQ0); const float* g = WSP(float, WS_PAR) + PAR_FN;
    const int gw = C.bid * NWAVES + C.wave, NGW = C.nblk * NWAVES, lane = C.lane;
    for (int m = gw; m < T; m += NGW) {
        const float r = rs_from(SS + m * 16, 16, 1.f / D);
        const f32x4* hr = (const f32x4*)(H + (size_t)m * D) + lane; f32x4* o = (f32x4*)(outp + (size_t)m * D) + lane; const f32x4* gg = (const f32x4*)g + lane;
#pragma unroll
        for (int j = 0; j < 4; ++j) { const f32x4 v = hr[64 * j], w = gg[64 * j]; o[64 * j] = (f32x4){v.x * r * w.x, v.y * r * w.y, v.z * r * w.z, v.w * r * w.w}; }
    }
}

constexpr int NPHASES = 42;
template <int ph> __device__ __forceinline__ void run_phase(Ctx& C) {
    constexpr int layer = (ph - 1) / 10, sub = (ph - 1) % 10, j = layer >> 1; constexpr bool even = (layer & 1) == 0;
    float* H = WSP(float, WS_H); bf16_t* HB0 = WSP(bf16_t, WS_HB0); bf16_t* HB1 = WSP(bf16_t, WS_HB1); float* SSQ0 = WSP(float, WS_SSQ0); float* SSQ1 = WSP(float, WS_SSQ1); float* SSQX = WSP(float, WS_SSQX);
    const float* ROPE = WSP(float, WS_ROPE); bf16_t* MIX = WSP(bf16_t, WS_MIX);
    switch (sub) {
    case 0:
        if (even) { const bf16_t* W = WSP(bf16_t, WS_WINE) + (size_t)j * EINP * D; EpiE1 e{SSQ0, WSP(bf16_t, WS_P3), WSP(bf16_t, WS_CQ), WSP(bf16_t, WS_CKV), WSP(bf16_t, WS_KPE), SSQX, ROPE};
            if (FASTMASK & 1) gemm_dense(C, HB0, W, EINP, D, e); else { DenseRM rm{HB0, W, D}; gemm_naive(C, EINP, D, rm, e); } }
        else { const bf16_t* W = WSP(bf16_t, WS_WINO) + (size_t)j * 2048 * D; EpiGelu e{SSQ0, WSP(bf16_t, WS_Z), SSQX};
            if (FASTMASK & 2) gemm_dense(C, HB0, W, 2048, D, e); else { DenseRM rm{HB0, W, D}; gemm_naive(C, 2048, D, rm, e); } }
        break;
    case 1:
        if (even) {
            { const bf16_t* W = WSP(bf16_t, WS_WQ) + (size_t)j * 768 * QR; EpiQ e{SSQX, WSP(bf16_t, WS_Q), ROPE};
              if (FASTMASK & 4) gemm_dense(C, WSP(bf16_t, WS_CQ), W, 768, QR, e); else { DenseRM rm{WSP(bf16_t, WS_CQ), W, QR}; gemm_naive(C, 768, QR, rm, e); } }
            { const bf16_t* W = WSP(bf16_t, WS_WKV) + (size_t)j * 1024 * KVR; EpiKV e{SSQX, WSP(bf16_t, WS_KV)};
              if (FASTMASK & 8) gemm_dense(C, WSP(bf16_t, WS_CKV), W, 1024, KVR, e); else { DenseRM rm{WSP(bf16_t, WS_CKV), W, KVR}; gemm_naive(C, 1024, KVR, rm, e); } }
            phase_conv(C, j);
        } else { if (FASTMASK & 1024) phase_sg(C, j); else phase_sg_naive(C, j); }
        break;
    case 2:
        if (even) { if (FASTMASK & 512) phase_attn(C); else phase_attn_naive(C); }
        break;
    case 3: {
        const bf16_t* W = (even ? WSP(bf16_t, WS_WOE) : WSP(bf16_t, WS_WOO)) + (size_t)j * D * D; EpiRes e{H, HB0, SSQ0};
        if (FASTMASK & 16) gemm_dense(C, MIX, W, D, D, e); else { DenseRM rm{MIX, W, D}; gemm_naive(C, D, D, rm, e); }
        break; }
    case 4: phase_router(C, layer); break;
    case 5: { const MoeTab mt = moe_tables(C, layer); const int* tok_e = WSP(int, WS_TOK); const bf16_t* W = WSP(bf16_t, WS_WGU) + (size_t)layer * NEXP * D * D;
        EpiGU e{mt, WSP(int, WS_LIST), (const float*)(tok_e + 4 * T), WSP(bf16_t, WS_ACT)};
        if (FASTMASK & 32) { MoeGatherProb P{mt, WSP(int, WS_LIST), HB0, W, D}; pg8::MoeOrder S{mt.ebase[NEXP], C.nblk, C.bid}; pg8::EpiAdapt<EpiGU> ea{e}; pg8::gemm_phase(C.lds, C.tid, P, S, ea); }
        else { MoeGatherRM rm{mt, WSP(int, WS_LIST), HB0, W}; gemm_naive(C, D, D, rm, e); }
        break; }
    case 6: { const MoeTab mt = moe_tables(C, layer); const bf16_t* W = WSP(bf16_t, WS_WDN) + (size_t)layer * NEXP * D * DEXP;
        EpiDown e{mt, WSP(int, WS_LIST), WSP(float, WS_LW), WSP(bf16_t, WS_Y)};
        if (FASTMASK & 64) { MoeDownProb P{mt, WSP(bf16_t, WS_ACT), W, DEXP}; pg8::MoeOrder S{mt.ebase[NEXP], C.nblk, C.bid}; pg8::EpiAdapt<EpiDown> ea{e}; pg8::gemm_phase(C.lds, C.tid, P, S, ea); }
        else { MoeDownRM rm{mt, WSP(bf16_t, WS_ACT), W}; gemm_naive(C, D, DEXP, rm, e); }
        break; }
    case 7: phase_combine(C, layer); break;
    case 8: { const bf16_t* A = WSP(bf16_t, WS_PB) + (size_t)layer * T * PLE; const bf16_t* W = WSP(bf16_t, WS_WP) + (size_t)layer * D * PLE; EpiPP e{WSP(bf16_t, WS_PP)};
        if (FASTMASK & 128) gemm_dense(C, A, W, D, PLE, e); else { DenseRM rm{A, W, PLE}; gemm_naive(C, D, PLE, rm, e); }
        break; }
    case 9: { const bf16_t* W = WSP(bf16_t, WS_WG) + (size_t)layer * D * D; EpiPLE e{SSQ1, WSP(bf16_t, WS_PP), H, HB0, SSQ0};
        if (FASTMASK & 256) gemm_dense(C, HB1, W, D, D, e); else { DenseRM rm{HB1, W, D}; gemm_naive(C, D, D, rm, e); }
        break; }
    }
}
__host__ __device__ constexpr bool phase_is_nop(int ph) { return (ph != 0 && ph != NPHASES - 1) && ((((ph - 1) / 10) & 1) != 0) && (((ph - 1) % 10) == 2); }

__device__ __forceinline__ void phase_enter(Ctx& C, unsigned char* ws) {
    int t = threadIdx.x; asm volatile("" : "+v"(t)); C.tid = t; C.lane = t & 63; C.wave = __builtin_amdgcn_readfirstlane(t >> 6);
    unsigned char* w = ws; asm volatile("" : "+s"(w)); C.ws = w;
    int b = blockIdx.x; asm volatile("" : "+s"(b)); C.bid = b;
}
template <int PH> __device__ __forceinline__ void run_all(Ctx& C, unsigned char* ws, const XcdBarrier& bar) {
    if constexpr (PH < NPHASES - 1) {
        if constexpr (!phase_is_nop(PH)) { phase_enter(C, ws); run_phase<PH>(C); xcd_barrier(bar);
            if constexpr ((DUPMASK >> PH) & 1ull) { phase_enter(C, ws); run_phase<PH>(C); xcd_barrier(bar); } }
        run_all<PH + 1>(C, ws, bar);
    }
}
template <int PH> __device__ __forceinline__ void run_one(Ctx& C, unsigned char* ws, int ph) {
    if constexpr (PH < NPHASES - 1) {
        if (ph == PH) { if constexpr (!phase_is_nop(PH)) { phase_enter(C, ws); run_phase<PH>(C); } }
        else run_one<PH + 1>(C, ws, ph);
    }
}
__global__ void __launch_bounds__(NTHREADS, 2) fwd_kernel(Args args) {
    extern __shared__ __attribute__((aligned(16))) unsigned char lds_raw[];
    Ctx C;
    C.lds = (LAS unsigned char*)lds_raw;
    C.a = &args; C.ws = args.ws;
    C.tid = threadIdx.x; C.lane = C.tid & 63; C.wave = __builtin_amdgcn_readfirstlane(C.tid >> 6);
    C.bid = blockIdx.x; C.nblk = gridDim.x;
    volatile LAS unsigned* misc = (volatile LAS unsigned*)(C.lds + LDS_MISC);
    if (C.tid < 64) misc[C.tid] = 0u;
    __syncthreads();
#if MEGA
    XcdBarrier bar = xcd_barrier_post(WSP(unsigned, WS_CTL) + CW_BAR, misc + 8);
#endif
#if MEGA
    int lo = 0; constexpr int hi = NPHASES;
#else
    int lo = args.ph_lo; const int hi = args.ph_hi;
#endif
#if MEGA
#define SEAM(p) do { if ((p) + 1 < hi) xcd_barrier(bar); } while (0)
#else
#define SEAM(p) do { } while (0)
#endif
    if (lo == 0) { phase_prologue(C); SEAM(0); if (DUPMASK & 1ull) { phase_prologue(C); SEAM(0); } lo = 1; }
#if MEGA
    run_all<1>(C, args.ws, bar);
#else
    run_one<1>(C, args.ws, lo);
#endif
    if (hi == NPHASES && lo <= NPHASES - 1) {
        int t = threadIdx.x; asm volatile("" : "+v"(t)); C.tid = t; C.lane = t & 63; C.wave = __builtin_amdgcn_readfirstlane(t >> 6);
        unsigned char* w = args.ws; asm volatile("" : "+s"(w)); C.ws = w;
        phase_final(C, args.out);
    }
#undef SEAM
}

extern "C" void kernel_launch(void* const* d_in, const int* in_sizes, int n_in, void* d_out, int out_size, void* d_ws, size_t ws_size, hipStream_t stream) {
    static int grid = 0;
    if (grid == 0) {
        if (n_in != 26 || out_size != T * D || ws_size < WS_END) { fprintf(stderr, "kernel_launch: unexpected shapes (n_in %d out %d ws %zu)\n", n_in, out_size, ws_size); grid = -1; return; }
        int dev = 0, cus = 0;
        if (hipGetDevice(&dev) != hipSuccess || hipDeviceGetAttribute(&cus, hipDeviceAttributeMultiprocessorCount, dev) != hipSuccess) { grid = -1; return; }
        if (hipFuncSetAttribute((const void*)fwd_kernel, hipFuncAttributeMaxDynamicSharedMemorySize, LDS_BYTES) != hipSuccess) { fprintf(stderr, "kernel_launch: hipFuncSetAttribute failed\n"); grid = -1; return; }
        grid = cus;
    }
    if (grid < 0) return;
    (void)hipMemsetAsync((char*)d_ws + WS_CTL, 0, CTL_ZERO_BYTES, stream);
    Args a{};
    for (int i = 0; i < 26; ++i) a.in[i] = (const float*)d_in[i];
    a.out = (float*)d_out; a.ws = (unsigned char*)d_ws;
#if MEGA
    a.ph_lo = 0; a.ph_hi = NPHASES;
    hipLaunchKernelGGL(fwd_kernel, dim3(grid), dim3(NTHREADS), LDS_BYTES, stream, a);
#else
    for (int ph = 0; ph < NPHASES; ++ph) {
        if (phase_is_nop(ph)) continue;
        a.ph_lo = ph; a.ph_hi = ph + 1;
        hipLaunchKernelGGL(fwd_kernel, dim3(grid), dim3(NTHREADS), LDS_BYTES, stream, a);
    }
#endif
}
```

```cpp
#include <hip/hip_runtime.h>
#include <cstdio>
#include <cstdint>

#ifndef FASTMASK
#define FASTMASK 0x7ff
#endif
#ifndef DUPMASK
#define DUPMASK 0ull
#endif
#ifndef MEGA
#define MEGA 1
#endif

#define LAS __attribute__((address_space(3)))
#define GAS __attribute__((address_space(1)))
typedef unsigned short bf16_t;
typedef float f32x4 __attribute__((ext_vector_type(4)));
typedef unsigned u32x4 __attribute__((ext_vector_type(4)));
typedef unsigned u32x2 __attribute__((ext_vector_type(2)));
typedef short bf16x8 __attribute__((ext_vector_type(8)));

constexpr int T = 16384, D = 1024, SEQ = 4096, NBATCH = 4, DEPTH = 4;
constexpr int EIN = 2208, EINP = 2304;
constexpr int NH = 8, DQK = 96, DV = 64;
constexpr int QR = 384, KVR = 256;
constexpr int NEXP = 32, DEXP = 512;
constexpr int PLE = 256;
constexpr float EPS = 1e-6f;
constexpr int NWAVES = 8, NTHREADS = 512;
constexpr int MOE_ROWS = 40960;
constexpr float QSCALE = 0.10206207261596577f * 1.4426950408889634f;

constexpr size_t MiB = 1u << 20;
constexpr size_t WS_CTL = 0, CTL_ZERO_BYTES = 1 * MiB;
constexpr size_t WS_WINE = 1 * MiB;
constexpr size_t WS_WQ = 10 * MiB;
constexpr size_t WS_WKV = 12 * MiB;
constexpr size_t WS_WOE = 13 * MiB;
constexpr size_t WS_WINO = 17 * MiB;
constexpr size_t WS_WOO = 25 * MiB;
constexpr size_t WS_WS = 29 * MiB;
constexpr size_t WS_WR = 30 * MiB;
constexpr size_t WS_WG = 31 * MiB;
constexpr size_t WS_WP = 39 * MiB;
constexpr size_t WS_WGU = 41 * MiB;
constexpr size_t WS_WDN = 297 * MiB;
constexpr size_t WS_H = 425 * MiB;
constexpr size_t WS_HB0 = 489 * MiB;
constexpr size_t WS_HB1 = 521 * MiB;
constexpr size_t WS_SSQ0 = 553 * MiB;
constexpr size_t WS_SSQ1 = 554 * MiB;
constexpr size_t WS_SSQX = 555 * MiB;
constexpr size_t WS_ROPE = 558 * MiB;
constexpr size_t WS_PB = 560 * MiB;
constexpr size_t WS_P3 = 592 * MiB;
constexpr size_t WS_CQ = 640 * MiB;
constexpr size_t WS_CKV = 652 * MiB;
constexpr size_t WS_KPE = 660 * MiB;
constexpr size_t WS_Z = 592 * MiB;
constexpr size_t WS_Q = 661 * MiB;
constexpr size_t WS_KV = 685 * MiB;
constexpr size_t WS_MIX = 717 * MiB;
constexpr size_t WS_LIST = 749 * MiB;
constexpr size_t WS_LW = 751 * MiB;
constexpr size_t WS_TOK = 753 * MiB;
constexpr size_t WS_ACT = 754 * MiB;
constexpr size_t WS_Y = 794 * MiB;
constexpr size_t WS_PP = 874 * MiB;
constexpr size_t WS_PAR = 906 * MiB;
constexpr int PAR_CONV = 0, PAR_VN = 3072, PAR_BS = 5120, PAR_FN = 7168, PAR_N = 8192;
constexpr size_t WS_END = 907 * MiB;

constexpr int CW_CNT = 64;
constexpr int CW_BAR = 4096;

constexpr int LDS_BYTES = 147456;
constexpr int LDS_MISC = LDS_BYTES - 256;

__device__ __forceinline__ float bf2f(unsigned b) { return __uint_as_float(b << 16); }
__device__ __forceinline__ unsigned f2bf(float f) { unsigned u = __float_as_uint(f); return (u + 0x7fffu + ((u >> 16) & 1u)) >> 16; }
typedef float f32x2_t __attribute__((ext_vector_type(2))); typedef __bf16 bf16x2_t __attribute__((ext_vector_type(2)));
__device__ __forceinline__ unsigned pk2(float lo, float hi) { f32x2_t v = {lo, hi}; bf16x2_t b = __builtin_convertvector(v, bf16x2_t); return __builtin_bit_cast(unsigned, b); }
__device__ __forceinline__ void unpack8(const u32x4 w, float* v) {
    v[0] = __uint_as_float(w.x << 16); v[1] = __uint_as_float(w.x & 0xffff0000u);
    v[2] = __uint_as_float(w.y << 16); v[3] = __uint_as_float(w.y & 0xffff0000u);
    v[4] = __uint_as_float(w.z << 16); v[5] = __uint_as_float(w.z & 0xffff0000u);
    v[6] = __uint_as_float(w.w << 16); v[7] = __uint_as_float(w.w & 0xffff0000u);
}
__device__ __forceinline__ u32x4 pack8(const float* v) { u32x4 w; w.x = pk2(v[0], v[1]); w.y = pk2(v[2], v[3]); w.z = pk2(v[4], v[5]); w.w = pk2(v[6], v[7]); return w; }
__device__ __forceinline__ float rbf(float f) { return bf2f(f2bf(f)); }
__device__ __forceinline__ float wave_sum(float v) {
#pragma unroll
    for (int o = 1; o < 64; o <<= 1) v += __shfl_xor(v, o);
    return v;
}
__device__ __forceinline__ float wave_max(float v) {
#pragma unroll
    for (int o = 1; o < 64; o <<= 1) v = fmaxf(v, __shfl_xor(v, o));
    return v;
}
__device__ __forceinline__ float sigmoidf_(float x) { return 1.0f / (1.0f + __expf(-x)); }
__device__ __forceinline__ float gelu_tanh(float x) {
    const float u = 0.7978845608028654f * (x + 0.044715f * x * x * x);
    const float e = __expf(2.0f * u);
    const float th = 1.0f - 2.0f / (e + 1.0f);
    return 0.5f * x * (1.0f + th);
}

#define XB_TMO      128
#define XB_XCNT(j)  (256  + 64 * (j))
#define XB_XSUB(j)  (1280 + 64 * (j))
#define XB_XGEN(j)  (2304 + 64 * (j))
#define XB_TOP      3328
#define XB_TOPGEN   3392
#define XCD_BAR_WORDS 3456
#define XB_SPIN_CAP (1u << 22)
__device__ __forceinline__ unsigned xb_ld(unsigned* p)              { return __hip_atomic_load(p, __ATOMIC_RELAXED, __HIP_MEMORY_SCOPE_AGENT); }
__device__ __forceinline__ unsigned xb_add(unsigned* p, unsigned v) { return __hip_atomic_fetch_add(p, v, __ATOMIC_RELAXED, __HIP_MEMORY_SCOPE_AGENT); }
__device__ __forceinline__ unsigned xb_xcc_id() { return (unsigned)__builtin_amdgcn_s_getreg((3 << 11) | 20) & 0xFu; }
#define XB_SPIN(cond, bar) do { unsigned _sp = 0; while (cond) { __builtin_amdgcn_s_sleep(1); \
    if ((++_sp & 255u) == 0u) { if (xb_ld(&(bar)[XB_TMO])) break; if (_sp > XB_SPIN_CAP) { atomicAdd(&(bar)[XB_TMO], 1u); break; } } } } while (0)
struct XcdBarrier { unsigned* bar; unsigned x; volatile LAS unsigned* st; };
__device__ __forceinline__ XcdBarrier xcd_barrier_post(unsigned* bar, volatile LAS unsigned* st) {
    XcdBarrier b; b.bar = bar; b.x = xb_xcc_id(); b.st = st;
    if (threadIdx.x == 0) (void)xb_add(&bar[XB_XCNT(b.x)], 1u);
    return b;
}
__device__ __forceinline__ void xcd_barrier_complete(unsigned* bar, unsigned x, unsigned& nloc, unsigned& nx) {
    const unsigned G = gridDim.x * gridDim.y * gridDim.z;
    unsigned sum, cnt, mine, sp = 0u;
    for (;;) {
        sum = 0u; cnt = 0u; mine = 0u;
#pragma unroll
        for (unsigned j = 0; j < 16; ++j) { const unsigned c = xb_ld(&bar[XB_XCNT(j)]); sum += c; cnt += (c > 0u) ? 1u : 0u; mine = (j == x) ? c : mine; }
        if (sum == G) break;
        __builtin_amdgcn_s_sleep(1);
        if ((++sp & 255u) == 0u) { if (xb_ld(&bar[XB_TMO])) break; if (sp > XB_SPIN_CAP) { atomicAdd(&bar[XB_TMO], 1u); break; } }
    }
    nloc = mine > 0u ? mine : 1u; nx = cnt > 0u ? cnt : 1u;
}
__device__ __forceinline__ void xcd_barrier(const XcdBarrier& b) {
    asm volatile("s_waitcnt vmcnt(0)" ::: "memory");
    __syncthreads();
    if (threadIdx.x == 0) {
        unsigned* bar = b.bar;
        __builtin_amdgcn_s_waitcnt(0);
        unsigned nloc = b.st[0], nx = b.st[1];
        if (nloc == 0u) { xcd_barrier_complete(bar, b.x, nloc, nx); b.st[0] = nloc; b.st[1] = nx; }
        const unsigned old = xb_add(&bar[XB_XSUB(b.x)], 1u);
        const unsigned gen = old / nloc;
        if (old + 1u == (gen + 1u) * nloc) {
            __builtin_amdgcn_fence(__ATOMIC_RELEASE, "agent");
            asm volatile("s_waitcnt vmcnt(0)" ::: "memory");
            const unsigned og = xb_add(&bar[XB_TOP], 1u);
            const unsigned tg = og / nx;
            if (og + 1u == (tg + 1u) * nx) xb_add(&bar[XB_TOPGEN], 1u);
            else XB_SPIN(xb_ld(&bar[XB_TOPGEN]) == tg, bar);
            __builtin_amdgcn_fence(__ATOMIC_ACQUIRE, "agent");
            xb_add(&bar[XB_XGEN(b.x)], 1u);
            asm volatile("s_waitcnt vmcnt(0)" ::: "memory");
        } else {
            XB_SPIN(xb_ld(&bar[XB_XGEN(b.x)]) == gen, bar);
            __builtin_amdgcn_fence(__ATOMIC_ACQUIRE, "agent");
            asm volatile("s_waitcnt vmcnt(0)" ::: "memory");
        }
    }
    __syncthreads();
}

struct Args { const float* in[26]; float* out; unsigned char* ws; int ph_lo, ph_hi; };
struct Ctx {
    LAS unsigned char* lds;
    const Args* a; unsigned char* ws;
    int tid, lane, wave, bid, nblk;
};
#define WSP(T_, off) ((T_*)(C.ws + (off)))

__device__ __forceinline__ void conv_item(const float* colp, int ldw, const float* gain, bf16_t* WT, int K, int k0, int n0, LAS float* scr, int lane) {
#pragma unroll 8
    for (int i = 0; i < 32; ++i) {
        const int kk = 2 * i + (lane >> 5);
        float v = colp ? colp[(size_t)(k0 + kk) * ldw] : 0.f;
        if (gain) v *= gain[k0 + kk];
        scr[kk * 33 + (lane & 31)] = v;
    }
    asm volatile("s_waitcnt lgkmcnt(0)" ::: "memory");
    const int c = lane & 7;
#pragma unroll
    for (int j = 0; j < 4; ++j) {
        const int n = (lane >> 3) + 8 * j; const LAS float* s = scr + (8 * c) * 33 + n;
        u32x4 o; o.x = pk2(s[0 * 33], s[1 * 33]); o.y = pk2(s[2 * 33], s[3 * 33]); o.z = pk2(s[4 * 33], s[5 * 33]); o.w = pk2(s[6 * 33], s[7 * 33]);
        *(u32x4*)(WT + (size_t)(n0 + n) * K + k0 + 8 * c) = o;
    }
    asm volatile("s_waitcnt lgkmcnt(0)" ::: "memory");
}


__device__ __forceinline__ void conv_item64(const float* colp  , int ldw, const float* gain, bf16_t* WT, int K, int k0, int n0, LAS float* scr, int lane) {
    f32x4 v[16];
#pragma unroll
    for (int i = 0; i < 16; ++i) v[i] = *(const f32x4*)(colp + (size_t)(k0 + 4 * i + (lane >> 4)) * ldw);
#pragma unroll
    for (int i = 0; i < 16; ++i) {
        const int kk = 4 * i + (lane >> 4); const float g = gain ? gain[k0 + kk] : 1.f; LAS float* s = scr + kk * 65 + (lane & 15) * 4;
        s[0] = v[i].x * g; s[1] = v[i].y * g; s[2] = v[i].z * g; s[3] = v[i].w * g;
    }
    asm volatile("s_waitcnt lgkmcnt(0)" ::: "memory");
    const int c = lane & 7;
#pragma unroll
    for (int j = 0; j < 8; ++j) {
        const int n = (lane >> 3) + 8 * j; const LAS float* s = scr + (8 * c) * 65 + n;
        u32x4 o; o.x = pk2(s[0 * 65], s[1 * 65]); o.y = pk2(s[2 * 65], s[3 * 65]); o.z = pk2(s[4 * 65], s[5 * 65]); o.w = pk2(s[6 * 65], s[7 * 65]);
        *(u32x4*)(WT + (size_t)(n0 + n) * K + k0 + 8 * c) = o;
    }
    asm volatile("s_waitcnt lgkmcnt(0)" ::: "memory");
}

__device__ __forceinline__ void phase_prologue(Ctx& C) {
    LAS float* scr = (LAS float*)(C.lds + C.wave * 16896);
    const int gw = C.bid * NWAVES + C.wave, NGW = C.nblk * NWAVES, lane = C.lane;
    {
        constexpr int I0 = 16 * 72, I1 = 6 * 24, I6 = 16 * 2;
        constexpr int E0 = 2 * I0, E1 = E0 + 2 * I1, E6 = E1 + 4 * I6;
        for (int it = gw; it < E6; it += NGW) {
            const int nl = lane & 31;
            if (it < E0) {
                const int j = it / I0, r = it % I0, kb = r / 72, nb = r % 72, np = nb * 32 + nl;
                int n;
                if (np < 1920) n = np; else if (np < 1952) { const int q = np - 1920; n = 2176 + (q & 1) * 16 + (q >> 1); } else if (np < 2048) n = -1; else n = 1920 + (np - 2048);
                const float* base = C.a->in[5] + (size_t)j * D * EIN;
                conv_item(n >= 0 ? base + n : nullptr, EIN, C.a->in[3] + (2 * j) * D, WSP(bf16_t, WS_WINE) + (size_t)j * EINP * D, D, kb * 64, nb * 32, scr, lane);
            } else if (it < E1) {
                const int r0 = it - E0, j = r0 / I1, r = r0 % I1, kb = r / 24, nb = r % 24, np = nb * 32 + nl;
                const int hd = np / 96, dd = np % 96; int n = np;
                if (dd >= 64) { const int q = dd - 64; n = hd * 96 + 64 + (q & 1) * 16 + (q >> 1); }
                conv_item(C.a->in[8] + (size_t)j * QR * 768 + n, 768, C.a->in[7] + j * QR, WSP(bf16_t, WS_WQ) + (size_t)j * 768 * QR, QR, kb * 64, nb * 32, scr, lane);
            } else {
                const int r0 = it - E1, l = r0 / I6, r = r0 % I6, kb = r / 2, nb = r % 2, np = nb * 32 + nl;
                const float* cp = nullptr; int ld = 4;
                if (np < 4) { cp = C.a->in[17] + (size_t)l * D * 4 + np; ld = 4; } else if (np < 36) { cp = C.a->in[18] + (size_t)l * D * 32 + (np - 4); ld = 32; }
                conv_item(cp, ld, C.a->in[4] + l * D, WSP(bf16_t, WS_WR) + (size_t)l * 64 * D, D, kb * 64, nb * 32, scr, lane);
            }
        }
        constexpr int J2 = 4 * 16, J3 = 16 * 16, J4 = 16 * 32, J5 = 16 * 16, J7 = 16 * 16, J8 = 4 * 16, J9 = 16 * 16, J10 = 8 * 16;
        constexpr int F2 = 2 * J2, F3 = F2 + 2 * J3, F4 = F3 + 2 * J4, F5 = F4 + 2 * J5, F7 = F5 + 4 * J7, F8 = F7 + 4 * J8, F9 = F8 + 128 * J9, F10 = F9 + 128 * J10;
        const int n4 = (lane & 15) * 4;
        for (int it = gw; it < F10; it += NGW) {
            if (it >= F8) {
                if (it < F9) {
                    const int r0 = it - F8, m = r0 / J9, r = r0 % J9, kb = r / 16, nb = r % 16, np = nb * 64 + n4;
                    const int l = m >> 5, b4 = np >> 2;
                    const float* cp = ((b4 & 1) ? C.a->in[20] : C.a->in[19]) + (size_t)m * D * DEXP + (b4 >> 1) * 4;
                    conv_item64(cp, DEXP, C.a->in[4] + l * D, WSP(bf16_t, WS_WGU) + (size_t)m * D * D, D, kb * 64, nb * 64, scr, lane);
                } else {
                    const int r0 = it - F9, m = r0 / J10, r = r0 % J10, kb = r / 16, nb = r % 16, np = nb * 64 + n4;
                    conv_item64(C.a->in[21] + (size_t)m * DEXP * D + np, D, nullptr, WSP(bf16_t, WS_WDN) + (size_t)m * D * DEXP, DEXP, kb * 64, nb * 64, scr, lane);
                }
            } else if (it < F2) {
                const int j = it / J2, r = it % J2, kb = r / 16, nb = r % 16, np = nb * 64 + n4;
                conv_item64(C.a->in[10] + (size_t)j * KVR * 1024 + np, 1024, C.a->in[9] + j * KVR, WSP(bf16_t, WS_WKV) + (size_t)j * 1024 * KVR, KVR, kb * 64, nb * 64, scr, lane);
            } else if (it < F3) {
                const int r0 = it - F2, j = r0 / J3, r = r0 % J3, kb = r / 16, nb = r % 16, np = nb * 64 + n4;
                conv_item64(C.a->in[11] + (size_t)j * D * D + np, D, nullptr, WSP(bf16_t, WS_WOE) + (size_t)j * D * D, D, kb * 64, nb * 64, scr, lane);
            } else if (it < F4) {
                const int r0 = it - F3, j = r0 / J4, r = r0 % J4, kb = r / 32, nb = r % 32, np = nb * 64 + n4;
                conv_item64(C.a->in[12] + (size_t)j * D * 2048 + np, 2048, C.a->in[3] + (2 * j + 1) * D, WSP(bf16_t, WS_WINO) + (size_t)j * 2048 * D, D, kb * 64, nb * 64, scr, lane);
            } else if (it < F5) {
                const int r0 = it - F4, j = r0 / J5, r = r0 % J5, kb = r / 16, nb = r % 16, np = nb * 64 + n4;
                conv_item64(C.a->in[16] + (size_t)j * D * D + np, D, nullptr, WSP(bf16_t, WS_WOO) + (size_t)j * D * D, D, kb * 64, nb * 64, scr, lane);
            } else if (it < F7) {
                const int r0 = it - F5, l = r0 / J7, r = r0 % J7, kb = r / 16, nb = r % 16, np = nb * 64 + n4;
                conv_item64(C.a->in[23] + (size_t)l * D * D + np, D, C.a->in[22] + l * D, WSP(bf16_t, WS_WG) + (size_t)l * D * D, D, kb * 64, nb * 64, scr, lane);
            } else {
                const int r0 = it - F7, l = r0 / J8, r = r0 % J8, kb = r / 16, nb = r % 16, np = nb * 64 + n4;
                conv_item64(C.a->in[24] + (size_t)l * PLE * D + np, D, nullptr, WSP(bf16_t, WS_WP) + (size_t)l * D * PLE, PLE, kb * 64, nb * 64, scr, lane);
            }
        }
    }
    {
        float* H = WSP(float, WS_H); bf16_t* HB = WSP(bf16_t, WS_HB0); float* SS = WSP(float, WS_SSQ0);
        for (int m = gw; m < T; m += NGW) {
            const f32x4* xr = (const f32x4*)(C.a->in[0] + (size_t)m * D) + lane; f32x4* hr = (f32x4*)(H + (size_t)m * D) + lane;
            u32x2* ob = (u32x2*)(HB + (size_t)m * D) + lane; float s = 0.f;
#pragma unroll
            for (int j = 0; j < 4; ++j) { const f32x4 v = xr[64 * j]; hr[64 * j] = v; s += (v.x * v.x + v.y * v.y) + (v.z * v.z + v.w * v.w); u32x2 o; o.x = pk2(v.x, v.y); o.y = pk2(v.z, v.w); ob[64 * j] = o; }
            s = wave_sum(s);
            if (lane < 16) SS[m * 16 + lane] = (lane == 0) ? s : 0.f;
        }
    }
    {
        const size_t n8 = (size_t)DEPTH * T * PLE / 8; const size_t gt = (size_t)C.bid * NTHREADS + C.tid, NGT = (size_t)C.nblk * NTHREADS;
        const f32x4* src = (const f32x4*)C.a->in[1]; u32x4* dst = WSP(u32x4, WS_PB);
        for (size_t i = gt; i < n8; i += NGT) { const f32x4 a = src[2 * i], b = src[2 * i + 1]; u32x4 o; o.x = pk2(a.x, a.y); o.y = pk2(a.z, a.w); o.z = pk2(b.x, b.y); o.w = pk2(b.z, b.w); dst[i] = o; }
    }
    {
        const int gt = C.bid * NTHREADS + C.tid, NGT = C.nblk * NTHREADS; const int* pos = (const int*)C.a->in[2]; float* R = WSP(float, WS_ROPE);
        for (int i = gt; i < T * 16; i += NGT) {
            const int t = i >> 4, f = i & 15;
            const int q = f & 3; double inv = (q == 0) ? 1.0 : (q == 1) ? 0.5623413251903491 : (q == 2) ? 0.31622776601683794 : 0.17782794100389228;
            const int dec = f >> 2; inv *= (dec == 0) ? 1.0 : (dec == 1) ? 0.1 : (dec == 2) ? 0.01 : 0.001;
            const double ang = (double)pos[t] * inv;
            const double n = __builtin_rint(ang * 0.15915494309189535);
            const double r = ang - n * 6.283185307179586, r2 = r * r;
            double sn = r, cs = 1.0, ts = r, tc = 1.0;
#pragma unroll
            for (int k = 1; k <= 13; ++k) { tc *= -r2 / (double)((2 * k - 1) * (2 * k)); cs += tc; ts *= -r2 / (double)((2 * k) * (2 * k + 1)); sn += ts; }
            R[2 * i] = (float)cs; R[2 * i + 1] = (float)sn;
        }
    }
    {
        const int gt = C.bid * NTHREADS + C.tid, NGT = C.nblk * NTHREADS; float* PR = WSP(float, WS_PAR);
        for (int i = gt; i < PAR_N; i += NGT) {
            float v;
            if (i < PAR_VN) v = C.a->in[6][i]; else if (i < PAR_BS) v = C.a->in[13][i - PAR_VN]; else if (i < PAR_FN) v = C.a->in[15][i - PAR_BS]; else v = C.a->in[25][i - PAR_FN];
            PR[i] = v;
        }
    }
    {
        const int gt = C.bid * NTHREADS + C.tid, NGT = C.nblk * NTHREADS; const float* src = C.a->in[14]; bf16_t* dst = WSP(bf16_t, WS_WS);
        for (int i = gt; i < 2 * 8 * 128 * 128; i += NGT) { const int s = i & 127, t = (i >> 7) & 127; dst[i] = (bf16_t)((s <= t) ? f2bf(src[i]) : 0u); }
    }
}

template <class RM, class Epi>
__device__ __forceinline__ void gemm_naive(Ctx& C, int N, int K, const RM& rm, const Epi& epi) {
    LAS float* As = (LAS float*)C.lds;
    LAS float* Bs = As + 32 * 132;
    const int tid = C.tid, ty = tid >> 4, tx = tid & 15;
    const int nct = N / 128, nunits = rm.ntiles128() * nct;
    for (int u = C.bid; u < nunits; u += C.nblk) {
        const int mt = u / nct, nt = u % nct, row0 = mt * 128, col0 = nt * 128;
        const bf16_t* Bt = rm.bt(row0);
        float acc[4][8];
#pragma unroll
        for (int i = 0; i < 4; ++i)
#pragma unroll
            for (int j = 0; j < 8; ++j) acc[i][j] = 0.f;
        const int lr = tid >> 2, kc = (tid & 3) * 8;
        const bf16_t* ap = rm.arow(row0 + lr);
        const bf16_t* bp = Bt + (size_t)(col0 + lr) * K;
        for (int k0 = 0; k0 < K; k0 += 32) {
            float av[8], bv[8];
            if (ap) { const u32x4 w = *(const u32x4*)(ap + k0 + kc); unpack8(w, av); } else {
#pragma unroll
                for (int i = 0; i < 8; ++i) av[i] = 0.f; }
            { const u32x4 w = *(const u32x4*)(bp + k0 + kc); unpack8(w, bv); }
            __syncthreads();
#pragma unroll
            for (int i = 0; i < 8; ++i) { As[(kc + i) * 132 + lr] = av[i]; Bs[(kc + i) * 132 + lr] = bv[i]; }
            __syncthreads();
#pragma unroll 4
            for (int k = 0; k < 32; ++k) {
                const f32x4 a = *(const LAS f32x4*)(As + k * 132 + ty * 4);
                const f32x4 b0 = *(const LAS f32x4*)(Bs + k * 132 + tx * 8), b1 = *(const LAS f32x4*)(Bs + k * 132 + tx * 8 + 4);
                const float aa[4] = {a.x, a.y, a.z, a.w}; const float bb[8] = {b0.x, b0.y, b0.z, b0.w, b1.x, b1.y, b1.z, b1.w};
#pragma unroll
                for (int i = 0; i < 4; ++i)
#pragma unroll
                    for (int j = 0; j < 8; ++j) acc[i][j] += aa[i] * bb[j];
            }
        }
#pragma unroll
        for (int i = 0; i < 4; ++i) {
            const int srow = row0 + ty * 4 + i;
            const typename Epi::Row rw = epi.row(srow);
            float ss = epi(srow, col0 + tx * 8, acc[i], rw);
            ss += __shfl_xor(ss, 1); ss += __shfl_xor(ss, 2); ss += __shfl_xor(ss, 4);
            if ((tx & 7) == 0) epi.rowsum(srow, (col0 + tx * 8) >> 6, ss);
        }
    }
    __syncthreads();
}

struct DenseRM {
    const bf16_t* A; const bf16_t* Bt; int K;
    __device__ __forceinline__ int ntiles128() const { return T / 128; }
    __device__ __forceinline__ const bf16_t* arow(int r) const { return A + (size_t)r * K; }
    __device__ __forceinline__ const bf16_t* bt(int) const { return Bt; }
};
struct MoeTab { LAS int* ebase; LAS int* tile2e; LAS int* ecnt; };
__device__ __forceinline__ MoeTab moe_tables(Ctx& C, int layer) {
    MoeTab mt; mt.ebase = (LAS int*)(C.lds + LDS_MISC - 2048); mt.tile2e = mt.ebase + 64; mt.ecnt = mt.tile2e + 192;
    __syncthreads();
    if (C.tid < 64) {
        const unsigned* cnt = WSP(unsigned, WS_CTL) + CW_CNT + layer * 64; const int lane = C.tid;
        const int c = (lane < NEXP) ? (int)__hip_atomic_load(cnt + lane, __ATOMIC_RELAXED, __HIP_MEMORY_SCOPE_AGENT) : 0;
        const int nt = (c + 255) >> 8; int incl = nt;
#pragma unroll
        for (int o = 1; o < 32; o <<= 1) { const int v = __shfl_up(incl, o); if (lane >= o) incl += v; }
        const int excl = incl - nt;
        if (lane < NEXP) { mt.ecnt[lane] = c; mt.ebase[lane] = excl; for (int t = 0; t < nt; ++t) mt.tile2e[excl + t] = lane; }
        if (lane == NEXP - 1) mt.ebase[NEXP] = incl;
    }
    __syncthreads();
    return mt;
}
struct MoeRow { int e, pos, tok; };
__device__ __forceinline__ MoeRow moe_row(const MoeTab& mt, const int* list, int srow) {
    MoeRow r; const int t256 = srow >> 8; r.e = mt.tile2e[t256]; r.pos = (t256 - mt.ebase[r.e]) * 256 + (srow & 255);
    r.tok = (r.pos < mt.ecnt[r.e]) ? list[r.e * T + r.pos] : -1; return r;
}
struct MoeGatherRM {
    MoeTab mt; const int* list; const bf16_t* HB; const bf16_t* W;
    __device__ __forceinline__ int ntiles128() const { return mt.ebase[NEXP] * 2; }
    __device__ __forceinline__ const bf16_t* arow(int r) const { const MoeRow m = moe_row(mt, list, r); return m.tok >= 0 ? HB + (size_t)m.tok * D : nullptr; }
    __device__ __forceinline__ const bf16_t* bt(int r0) const { return W + (size_t)mt.tile2e[r0 >> 8] * D * D; }
};
struct MoeDownRM {
    MoeTab mt; const bf16_t* ACT; const bf16_t* W;
    __device__ __forceinline__ int ntiles128() const { return mt.ebase[NEXP] * 2; }
    __device__ __forceinline__ const bf16_t* arow(int r) const { return ACT + (size_t)r * DEXP; }
    __device__ __forceinline__ const bf16_t* bt(int r0) const { return W + (size_t)mt.tile2e[r0 >> 8] * D * DEXP; }
};

__device__ __forceinline__ float rs_from(const float* ss, int n, float inv_n) { float s = 0.f; for (int i = 0; i < n; ++i) s += ss[i]; return rsqrtf(s * inv_n + EPS); }
struct RowS { float s; };
struct EpiE1 {
    const float* ssq_h; bf16_t* P3; bf16_t* CQ; bf16_t* CKV; bf16_t* KPE; float* ssqx; const float* rope;
    typedef RowS Row;
    __device__ __forceinline__ Row row(int r) const { Row w; w.s = rs_from(ssq_h + r * 16, 16, 1.f / D); return w; }
    __device__ __forceinline__ float operator()(int r, int col, const float* v, const Row& w) const {
        float x[8];
#pragma unroll
        for (int i = 0; i < 8; ++i) x[i] = v[i] * w.s;
        float ss = 0.f;
        if (col < 1536) { *(u32x4*)(P3 + (size_t)r * 1536 + col) = pack8(x); }
        else if (col < 1920) { *(u32x4*)(CQ + (size_t)r * QR + (col - 1536)) = pack8(x);
#pragma unroll
            for (int i = 0; i < 8; ++i) ss += x[i] * x[i]; }
        else if (col < 1952) { const int f0 = (col - 1920) >> 1; float o[8];
#pragma unroll
            for (int i = 0; i < 4; ++i) { const float c = rope[(r * 16 + f0 + i) * 2], s = rope[(r * 16 + f0 + i) * 2 + 1]; o[2 * i] = x[2 * i] * c - x[2 * i + 1] * s; o[2 * i + 1] = x[2 * i + 1] * c + x[2 * i] * s; }
            *(u32x4*)(KPE + (size_t)r * 32 + (col - 1920)) = pack8(o); }
        else if (col < 2048) { }
        else { *(u32x4*)(CKV + (size_t)r * KVR + (col - 2048)) = pack8(x);
#pragma unroll
            for (int i = 0; i < 8; ++i) ss += x[i] * x[i]; }
        return ss;
    }
    __device__ __forceinline__ void rowsum(int r, int slot, float ss) const { ssqx[r * 36 + slot] = ss; }
};
struct EpiQ {
    const float* ssqx; bf16_t* Q; const float* rope;
    typedef RowS Row;
    __device__ __forceinline__ Row row(int r) const { Row w; w.s = rs_from(ssqx + r * 36 + 24, 8, 1.f / QR) * QSCALE; return w; }
    __device__ __forceinline__ float operator()(int r, int col, const float* v, const Row& w) const {
        float x[8];
#pragma unroll
        for (int i = 0; i < 8; ++i) x[i] = v[i] * w.s;
        const int dd = col % 96;
        if (dd >= 64) { const int f0 = (dd - 64) >> 1; float o[8];
#pragma unroll
            for (int i = 0; i < 4; ++i) { const float c = rope[(r * 16 + f0 + i) * 2], s = rope[(r * 16 + f0 + i) * 2 + 1]; o[2 * i] = x[2 * i] * c - x[2 * i + 1] * s; o[2 * i + 1] = x[2 * i + 1] * c + x[2 * i] * s; }
            *(u32x4*)(Q + (size_t)r * 768 + col) = pack8(o);
        } else *(u32x4*)(Q + (size_t)r * 768 + col) = pack8(x);
        return 0.f;
    }
    __device__ __forceinline__ void rowsum(int, int, float) const {}
};
struct EpiKV {
    const float* ssqx; bf16_t* KV;
    typedef RowS Row;
    __device__ __forceinline__ Row row(int r) const { Row w; w.s = rs_from(ssqx + r * 36 + 32, 4, 1.f / KVR); return w; }
    __device__ __forceinline__ float operator()(int r, int col, const float* v, const Row& w) const {
        float x[8];
#pragma unroll
        for (int i = 0; i < 8; ++i) x[i] = v[i] * w.s;
        *(u32x4*)(KV + (size_t)r * 1024 + col) = pack8(x); return 0.f;
    }
    __device__ __forceinline__ void rowsum(int, int, float) const {}
};
struct EpiRes {
    const float* Hr; float* H; bf16_t* HB; float* ssq;
    typedef RowS Row;
    __device__ __forceinline__ Row row(int) const { Row w; w.s = 1.f; return w; }
    __device__ __forceinline__ float operator()(int r, int col, const float* v, const Row&) const {
        const f32x4* hr_ = (const f32x4*)(Hr + (size_t)r * D + col); f32x4* hp = (f32x4*)(H + (size_t)r * D + col); const f32x4 a = hr_[0], b = hr_[1];
        float x[8] = {a.x + v[0], a.y + v[1], a.z + v[2], a.w + v[3], b.x + v[4], b.y + v[5], b.z + v[6], b.w + v[7]};
        hp[0] = (f32x4){x[0], x[1], x[2], x[3]}; hp[1] = (f32x4){x[4], x[5], x[6], x[7]};
        *(u32x4*)(HB + (size_t)r * D + col) = pack8(x);
        float ss = 0.f;
#pragma unroll
        for (int i = 0; i < 8; ++i) ss += x[i] * x[i];
        return ss;
    }
    __device__ __forceinline__ void rowsum(int r, int slot, float ss) const { ssq[r * 16 + slot] = ss; }
};
struct EpiGelu {
    const float* ssq_h; bf16_t* Z; float* ssqx;
    typedef RowS Row;
    __device__ __forceinline__ Row row(int r) const { Row w; w.s = rs_from(ssq_h + r * 16, 16, 1.f / D); return w; }
    __device__ __forceinline__ float operator()(int r, int col, const float* v, const Row& w) const {
        float x[8]; float ss = 0.f;
#pragma unroll
        for (int i = 0; i < 8; ++i) { x[i] = gelu_tanh(v[i] * w.s); ss += x[i] * x[i]; }
        *(u32x4*)(Z + (size_t)r * 2048 + col) = pack8(x);
        return col >= 1024 ? ss : 0.f;
    }
    __device__ __forceinline__ void rowsum(int r, int slot, float ss) const { ssqx[r * 36 + slot] = ss; }
};
struct RowM { float s; int ok; };
struct EpiGU {
    MoeTab mt; const int* list; const float* rffn; bf16_t* ACT;
    typedef RowM Row;
    __device__ __forceinline__ Row row(int r) const { const MoeRow m = moe_row(mt, list, r); Row w; w.ok = m.tok >= 0; w.s = w.ok ? rffn[m.tok] : 0.f; return w; }
    __device__ __forceinline__ float operator()(int r, int col, const float* v, const Row& w) const {
        float a[4];
#pragma unroll
        for (int i = 0; i < 4; ++i) { const float g = v[i] * w.s, u = v[4 + i] * w.s; a[i] = g * sigmoidf_(g) * u; }
        u32x2 o; o.x = pk2(a[0], a[1]); o.y = pk2(a[2], a[3]);
        *(u32x2*)(ACT + (size_t)r * DEXP + (col >> 1)) = o;
        return 0.f;
    }
    __device__ __forceinline__ void rowsum(int, int, float) const {}
};
struct EpiDown {
    MoeTab mt; const int* list; const float* lw; bf16_t* Y;
    typedef RowM Row;
    __device__ __forceinline__ Row row(int r) const { const MoeRow m = moe_row(mt, list, r); Row w; w.ok = m.tok >= 0; w.s = w.ok ? lw[m.e * T + m.pos] : 0.f; return w; }
    __device__ __forceinline__ float operator()(int r, int col, const float* v, const Row& w) const {
        if (w.ok) { float x[8];
#pragma unroll
            for (int i = 0; i < 8; ++i) x[i] = v[i] * w.s;
            *(u32x4*)(Y + (size_t)r * D + col) = pack8(x); }
        return 0.f;
    }
    __device__ __forceinline__ void rowsum(int, int, float) const {}
};
struct EpiPP {
    bf16_t* PP;
    typedef RowS Row;
    __device__ __forceinline__ Row row(int) const { Row w; w.s = 1.f; return w; }
    __device__ __forceinline__ float operator()(int r, int col, const float* v, const Row&) const { *(u32x4*)(PP + (size_t)r * D + col) = pack8(v); return 0.f; }
    __device__ __forceinline__ void rowsum(int, int, float) const {}
};
struct EpiPLE {
    const float* ssq_in; const bf16_t* PP; const float* Hr; float* H; bf16_t* HB; float* ssq;
    typedef RowS Row;
    __device__ __forceinline__ Row row(int r) const { Row w; w.s = rs_from(ssq_in + r * 16, 16, 1.f / D); return w; }
    __device__ __forceinline__ float operator()(int r, int col, const float* v, const Row& w) const {
        float pp[8]; unpack8(*(const u32x4*)(PP + (size_t)r * D + col), pp);
        const f32x4* hr_ = (const f32x4*)(Hr + (size_t)r * D + col); f32x4* hp = (f32x4*)(H + (size_t)r * D + col); const f32x4 a = hr_[0], b = hr_[1];
        const float h0[8] = {a.x, a.y, a.z, a.w, b.x, b.y, b.z, b.w};
        float x[8]; float ss = 0.f;
#pragma unroll
        for (int i = 0; i < 8; ++i) { x[i] = h0[i] + sigmoidf_(v[i] * w.s) * pp[i]; ss += x[i] * x[i]; }
        hp[0] = (f32x4){x[0], x[1], x[2], x[3]}; hp[1] = (f32x4){x[4], x[5], x[6], x[7]};
        *(u32x4*)(HB + (size_t)r * D + col) = pack8(x);
        return ss;
    }
    __device__ __forceinline__ void rowsum(int r, int slot, float ss) const { ssq[r * 16 + slot] = ss; }
};


namespace pg8 {
constexpr int BM = 256, BK = 64, HALF = 128, HTB = HALF * BK * 2, STAGE_BYTES = 8 * HTB, NXCD = 8, WGM = 8;
__host__ __device__ __forceinline__ int lds_byte(int r, int c) { const int st = (r >> 4) * 2 + (c >> 5), rr = r & 15, cc = c & 31, ob = rr * 64 + cc * 2; return st * 1024 + (ob ^ (((ob >> 9) & 1) << 5)); }
__host__ __device__ __forceinline__ void stage_rc(int b, int& R, int& C) { const int st = b / 1024, sb = b % 1024, swz = sb ^ (((sb >> 9) & 1) << 5); R = (st >> 1) * 16 + swz / 64; C = (st & 1) * 32 + (swz % 64) / 2; }
__host__ __device__ __forceinline__ int perm32(int rho) { const int n = rho >> 4, i = rho & 15; return 8 * (i >> 2) + 4 * n + (i & 3); }
struct Unit { int pm, pn; };
struct StaticOrder {
    int nM, nN, nwg, G, c;
    __device__ void init(int M, int N, int G_, int c_) { nM = M / BM; nN = N / BM; nwg = nM * nN; G = G_; c = c_; }
    __device__ bool next(int i, Unit& u) const {
        const long L = (long)i * G + c; if (L >= nwg) return false;
        int wgid = (int)L; { const int q = nwg / NXCD, r = nwg % NXCD, xcd = wgid % NXCD, off = wgid / NXCD; wgid = (xcd < r ? xcd * (q + 1) : r * (q + 1) + (xcd - r) * q) + off; }
        const int nig = WGM * nN, gid = wgid / nig, fm = gid * WGM, gsz = (nM - fm) < WGM ? (nM - fm) : WGM;
        u.pm = fm + ((wgid % nig) % gsz); u.pn = (wgid % nig) / gsz; return true;
    }
};
struct MoeOrder {
    int ntile, G, c;
    __device__ bool next(int i, Unit& u) const { const int L = i * G + c; if (L >= ntile * 4) return false; u.pm = L >> 2; u.pn = L & 3; return true; }
};
template <class Prob, class Epi, class Sched>
__device__ __forceinline__ void gemm_phase(LAS unsigned char* lds, int tid, const Prob& P, const Sched& S, const Epi& E) {
    constexpr bool GATHER = Prob::GATHER;
    const int wid = __builtin_amdgcn_readfirstlane(tid >> 6), lane = tid & 63, wr = wid >> 2, wc = wid & 3, fr = lane & 15, fq = lane >> 4;
    const int K = P.K, nt = K / BK;
    unsigned voffA[2], voffB[2]; int RA[2], CA2[2];
#pragma unroll
    for (int i = 0; i < 2; ++i) { int R, C; stage_rc(tid * 16 + i * 8192, R, C); const int Rb = (R & ~31) + perm32(R & 31);
        voffA[i] = (unsigned)(R * K + C) * 2u; voffB[i] = (unsigned)(Rb * K + C) * 2u; RA[i] = R; CA2[i] = C * 2; }
    const size_t kstep = (size_t)(BK * 2);
    const size_t hstep = (size_t)HALF * K * 2;
    const unsigned ldsw = (unsigned)wid * 1024u;
    const int aoff = lds_byte(wr * 64 + fr, fq * 8), boff = lds_byte(wc * 32 + fr, fq * 8);
#define PG8_SA(b, h) (((b) * 2 + (h)) * HTB)
#define PG8_SB(b, h) ((4 + (b) * 2 + (h)) * HTB)
#define PG8_STAGE2(bufoff, gbase, v0, v1) do { \
        __builtin_amdgcn_global_load_lds((const unsigned*)((const char*)(gbase) + (v0)), (LAS unsigned*)(lds + (bufoff) + ldsw), 16, 0, 0); \
        __builtin_amdgcn_global_load_lds((const unsigned*)((const char*)(gbase) + (v1)), (LAS unsigned*)(lds + (bufoff) + ldsw + 8192), 16, 0, 0); } while (0)
#define PG8_STAGE_B(bufoff, gbase) PG8_STAGE2(bufoff, gbase, voffB[0], voffB[1])
#define PG8_STAGE_A(bufoff, gbase, h, nx) do { if constexpr (GATHER) { PG8_STAGE2(bufoff, gbase, (nx) ? nvA[h][0] : cvA[h][0], (nx) ? nvA[h][1] : cvA[h][1]); } \
        else { PG8_STAGE2(bufoff, (gbase) + (h) * hstep, voffA[0], voffA[1]); } } while (0)
#define PG8_LDA(dst, b, h) do { _Pragma("unroll") for (int m = 0; m < 4; ++m) _Pragma("unroll") for (int k = 0; k < 2; ++k) dst[m][k] = *(const LAS bf16x8*)(lds + PG8_SA(b, h) + aoff + m * 2048 + k * 1024); } while (0)
#define PG8_LDB(dst, b, h) do { _Pragma("unroll") for (int n = 0; n < 2; ++n) _Pragma("unroll") for (int k = 0; k < 2; ++k) dst[n][k] = *(const LAS bf16x8*)(lds + PG8_SB(b, h) + boff + n * 2048 + k * 1024); } while (0)
#define PG8_MMA(ai, bj, At, Bt) do { __builtin_amdgcn_s_setprio(1); _Pragma("unroll") for (int m = 0; m < 4; ++m) _Pragma("unroll") for (int n = 0; n < 2; ++n) _Pragma("unroll") for (int k = 0; k < 2; ++k) \
        acc[ai][bj][m][n] = __builtin_amdgcn_mfma_f32_16x16x32_bf16(Bt[n][k], At[m][k], acc[ai][bj][m][n], 0, 0, 0); __builtin_amdgcn_s_setprio(0); } while (0)
#define PG8_WAIT_V(n) asm volatile("s_waitcnt vmcnt(" #n ")" ::: "memory")
#define PG8_WAIT_L(n) asm volatile("s_waitcnt lgkmcnt(" #n ")" ::: "memory")
#define PG8_BAR __builtin_amdgcn_s_barrier()
#define PG8_SCHED __builtin_amdgcn_sched_barrier(0)
    Unit cur, nxt; int ui = 0;
    if (!S.next(0, cur)) return;
    f32x4 acc[2][2][4][2];
#pragma unroll
    for (int a = 0; a < 2; ++a)
#pragma unroll
        for (int b = 0; b < 2; ++b)
#pragma unroll
            for (int m = 0; m < 4; ++m)
#pragma unroll
                for (int n = 0; n < 2; ++n) acc[a][b][m][n] = (f32x4){0.f, 0.f, 0.f, 0.f};
    bf16x8 At[4][2], B0[2][2], B1[2][2];
    unsigned cvA[2][2], nvA[2][2];
    if constexpr (GATHER) {
#pragma unroll
        for (int h = 0; h < 2; ++h)
#pragma unroll
            for (int i = 0; i < 2; ++i) { cvA[h][i] = P.arow_off(cur, h * HALF + RA[i]) + (unsigned)CA2[i]; nvA[h][i] = cvA[h][i]; }
    } else { cvA[0][0] = cvA[0][1] = cvA[1][0] = cvA[1][1] = 0u; nvA[0][0] = nvA[0][1] = nvA[1][0] = nvA[1][1] = 0u; }
    const char* cA = P.abase(cur); const char* cB = P.bbase(cur);
    PG8_STAGE_B(PG8_SB(0, 0), cB); PG8_STAGE_B(PG8_SB(0, 1), cB + hstep); PG8_STAGE_A(PG8_SA(0, 0), cA, 0, false); PG8_STAGE_A(PG8_SA(0, 1), cA, 1, false);
    if (wr == 1) PG8_BAR;
    PG8_WAIT_V(2); PG8_BAR;
    PG8_STAGE_B(PG8_SB(1, 0), cB + kstep); PG8_STAGE_A(PG8_SA(1, 0), cA + kstep, 0, false); PG8_STAGE_B(PG8_SB(1, 1), cB + hstep + kstep);
    PG8_WAIT_V(6); PG8_BAR;
    for (;;) {
        const bool has_next = S.next(ui + 1, nxt);
        const char* nA = has_next ? P.abase(nxt) : cA; const char* nB = has_next ? P.bbase(nxt) : cB;
        if constexpr (GATHER) {
            if (has_next) {
#pragma unroll
                for (int h = 0; h < 2; ++h)
#pragma unroll
                    for (int i = 0; i < 2; ++i) nvA[h][i] = P.arow_off(nxt, h * HALF + RA[i]) + (unsigned)CA2[i];
            }
        }
        for (int t = 0; t < nt; t += 2) {
            const bool last = (t == nt - 2);
            const char* a1 = cA + (size_t)(t + 1) * kstep;
            const char* a2 = last ? nA : cA + (size_t)(t + 2) * kstep; const char* b2 = last ? nB : cB + (size_t)(t + 2) * kstep;
            const char* a3 = a2 + kstep; const char* b3 = b2 + kstep;
            PG8_LDB(B0, 0, 0); PG8_LDB(B1, 0, 1); PG8_SCHED; PG8_LDA(At, 0, 0); PG8_STAGE_A(PG8_SA(1, 1), a1, 1, false);
            PG8_WAIT_V(8); PG8_WAIT_L(0); PG8_BAR; PG8_MMA(0, 0, At, B0); PG8_MMA(0, 1, At, B1); PG8_BAR; PG8_SCHED;
            PG8_LDA(At, 0, 1); PG8_STAGE_B(PG8_SB(0, 0), b2); PG8_STAGE_B(PG8_SB(0, 1), b2 + hstep); PG8_STAGE_A(PG8_SA(0, 0), a2, 0, last);
            PG8_WAIT_V(8); PG8_WAIT_L(0); PG8_BAR; PG8_MMA(1, 0, At, B0); PG8_MMA(1, 1, At, B1); PG8_BAR; PG8_SCHED;
            PG8_LDB(B0, 1, 0); PG8_LDB(B1, 1, 1); PG8_SCHED; PG8_LDA(At, 1, 0); PG8_STAGE_A(PG8_SA(0, 1), a2, 1, last);
            PG8_WAIT_V(8); PG8_WAIT_L(0); PG8_BAR; PG8_MMA(0, 0, At, B0); PG8_MMA(0, 1, At, B1); PG8_BAR; PG8_SCHED;
            PG8_LDA(At, 1, 1); PG8_STAGE_B(PG8_SB(1, 0), b3); PG8_STAGE_B(PG8_SB(1, 1), b3 + hstep); PG8_STAGE_A(PG8_SA(1, 0), a3, 0, last);
            PG8_WAIT_V(8); PG8_WAIT_L(0); PG8_BAR; PG8_MMA(1, 0, At, B0); PG8_MMA(1, 1, At, B1); PG8_BAR; PG8_SCHED;
        }
        if (wr == 0) PG8_BAR;
        { int fr_e = fr, fq_e = fq; asm volatile("" : "+v"(fr_e), "+v"(fq_e));
          E(acc, cur, wr, wc, fr_e, fq_e); }
        if (!has_next) break;
#pragma unroll
        for (int a = 0; a < 2; ++a)
#pragma unroll
            for (int b = 0; b < 2; ++b)
#pragma unroll
                for (int m = 0; m < 4; ++m)
#pragma unroll
                    for (int n = 0; n < 2; ++n) acc[a][b][m][n] = (f32x4){0.f, 0.f, 0.f, 0.f};
        cur = nxt; cA = nA; cB = nB; ++ui;
        if constexpr (GATHER) {
#pragma unroll
            for (int h = 0; h < 2; ++h)
#pragma unroll
                for (int i = 0; i < 2; ++i) cvA[h][i] = nvA[h][i];
        }
        if (wr == 1) PG8_BAR;
    }
    PG8_WAIT_V(0);
    PG8_BAR;
#undef PG8_SA
#undef PG8_SB
#undef PG8_STAGE2
#undef PG8_STAGE_A
#undef PG8_STAGE_B
#undef PG8_LDA
#undef PG8_LDB
#undef PG8_MMA
#undef PG8_WAIT_V
#undef PG8_WAIT_L
#undef PG8_BAR
#undef PG8_SCHED
}
template <class E> struct EpiAdapt {
    E e;
    __device__ __forceinline__ void operator()(const f32x4 (&acc)[2][2][4][2], const Unit& u, int wr, int wc, int fr, int fq) const {
#pragma unroll
        for (int ai = 0; ai < 2; ++ai)
#pragma unroll
            for (int m = 0; m < 4; ++m) {
                const int row = u.pm * BM + ai * HALF + wr * 64 + m * 16 + fr;
                const typename E::Row rw = e.row(row);
                float ss = 0.f;
#pragma unroll
                for (int bj = 0; bj < 2; ++bj) {
                    const int col = u.pn * BM + bj * HALF + wc * 32 + fq * 8;
                    const f32x4 a0 = acc[ai][bj][m][0], a1 = acc[ai][bj][m][1];
                    const float v[8] = {a0[0], a0[1], a0[2], a0[3], a1[0], a1[1], a1[2], a1[3]};
                    ss += e(row, col, v, rw);
                }
                ss += __shfl_xor(ss, 16); ss += __shfl_xor(ss, 32);
                if (fq == 0) e.rowsum(row, u.pn * 4 + wc, ss);
            }
    }
};
struct DenseProb {
    static constexpr bool GATHER = false;
    const bf16_t* A; const bf16_t* Bt; int K;
    __device__ __forceinline__ const char* abase(const Unit& u) const { return (const char*)A + (size_t)u.pm * BM * K * 2; }
    __device__ __forceinline__ unsigned arow_off(const Unit&, int) const { return 0u; }
    __device__ __forceinline__ const char* bbase(const Unit& u) const { return (const char*)Bt + (size_t)u.pn * BM * K * 2; }
};
}
struct MoeGatherProb {
    static constexpr bool GATHER = true;
    MoeTab mt; const int* list; const bf16_t* HB; const bf16_t* W; int K;
    __device__ __forceinline__ const char* abase(const pg8::Unit&) const { return (const char*)HB; }
    __device__ __forceinline__ unsigned arow_off(const pg8::Unit& u, int r) const { const MoeRow m = moe_row(mt, list, u.pm * 256 + r); return (unsigned)(m.tok >= 0 ? m.tok : 0) * (unsigned)(D * 2); }
    __device__ __forceinline__ const char* bbase(const pg8::Unit& u) const { return (const char*)W + ((size_t)mt.tile2e[u.pm] * D + (size_t)u.pn * 256) * D * 2; }
};
struct MoeDownProb {
    static constexpr bool GATHER = false;
    MoeTab mt; const bf16_t* ACT; const bf16_t* W; int K;
    __device__ __forceinline__ const char* abase(const pg8::Unit& u) const { return (const char*)ACT + (size_t)u.pm * 256 * DEXP * 2; }
    __device__ __forceinline__ unsigned arow_off(const pg8::Unit&, int) const { return 0u; }
    __device__ __forceinline__ const char* bbase(const pg8::Unit& u) const { return (const char*)W + ((size_t)mt.tile2e[u.pm] * D + (size_t)u.pn * 256) * DEXP * 2; }
};
template <class E> __device__ __forceinline__ void gemm_dense(Ctx& C, const bf16_t* A, const bf16_t* Bt, int N, int K, const E& e) {
    pg8::DenseProb P{A, Bt, K}; pg8::StaticOrder S; S.init(T, N, C.nblk, C.bid); pg8::EpiAdapt<E> ea{e};
    pg8::gemm_phase(C.lds, C.tid, P, S, ea);
}

__device__ __forceinline__ void phase_conv(Ctx& C, int j) {
    const bf16_t* P3 = WSP(bf16_t, WS_P3); bf16_t* MIX = WSP(bf16_t, WS_MIX); const float* cw = WSP(float, WS_PAR) + PAR_CONV + (size_t)j * 3 * 512;
    const int gt = C.bid * NTHREADS + C.tid, NGT = C.nblk * NTHREADS;
    for (int i = gt; i < T * 64; i += NGT) {
        const int t = i >> 6, c = (i & 63) * 8, s = t & (SEQ - 1);
        float acc[8];
#pragma unroll
        for (int q = 0; q < 8; ++q) acc[q] = 0.f;
#pragma unroll
        for (int k = 0; k < 3; ++k) {
            const int dt = 2 - k;
            if (s - dt >= 0) {
                float xc[8], gc[8]; unpack8(*(const u32x4*)(P3 + (size_t)(t - dt) * 1536 + c), xc); unpack8(*(const u32x4*)(P3 + (size_t)(t - dt) * 1536 + 1024 + c), gc);
#pragma unroll
                for (int q = 0; q < 8; ++q) acc[q] += cw[k * 512 + c + q] * (gc[q] * xc[q]);
            }
        }
        float gb[8]; unpack8(*(const u32x4*)(P3 + (size_t)t * 1536 + 512 + c), gb);
#pragma unroll
        for (int q = 0; q < 8; ++q) acc[q] *= gb[q];
        *(u32x4*)(MIX + (size_t)t * D + c) = pack8(acc);
    }
}

__device__ __forceinline__ void phase_attn_naive(Ctx& C) {
    const bf16_t* Q = WSP(bf16_t, WS_Q); const bf16_t* KV = WSP(bf16_t, WS_KV); const bf16_t* KPE = WSP(bf16_t, WS_KPE); bf16_t* MIX = WSP(bf16_t, WS_MIX);
    LAS float* Ks = (LAS float*)C.lds;
    LAS float* Vs = Ks + 64 * 97;
    LAS float* Qs = Vs + 64 * 64;
    LAS float* Ps = Qs + 64 * 96;
    const int tid = C.tid, lane = C.lane, wave = C.wave;
    const int nunits = NBATCH * NH * (SEQ / 64);
    for (int u = C.bid; u < nunits; u += C.nblk) {
        const int qb = (SEQ / 64 - 1) - (u / (NBATCH * NH)), bh = u % (NBATCH * NH), b = bh / NH, h = bh % NH;
        const int t0 = b * SEQ + qb * 64;
        __syncthreads();
        for (int i = tid; i < 64 * 12; i += NTHREADS) { const int r = i / 12, c8 = (i % 12) * 8; float v[8]; unpack8(*(const u32x4*)(Q + (size_t)(t0 + r) * 768 + h * 96 + c8), v);
#pragma unroll
            for (int q = 0; q < 8; ++q) Qs[r * 96 + c8 + q] = v[q]; }
        float m[8], l[8], o[8];
#pragma unroll
        for (int i = 0; i < 8; ++i) { m[i] = -1e30f; l[i] = 0.f; o[i] = 0.f; }
        for (int kt = 0; kt <= qb; ++kt) {
            const int k0 = b * SEQ + kt * 64;
            __syncthreads();
            for (int i = tid; i < 64 * 20; i += NTHREADS) { const int r = i / 20, c = i % 20; float v[8];
                if (c < 8) { unpack8(*(const u32x4*)(KV + (size_t)(k0 + r) * 1024 + h * 128 + c * 8), v);
#pragma unroll
                    for (int q = 0; q < 8; ++q) Ks[r * 97 + c * 8 + q] = v[q]; }
                else if (c < 12) { unpack8(*(const u32x4*)(KPE + (size_t)(k0 + r) * 32 + (c - 8) * 8), v);
#pragma unroll
                    for (int q = 0; q < 8; ++q) Ks[r * 97 + c * 8 + q] = v[q]; }
                else { unpack8(*(const u32x4*)(KV + (size_t)(k0 + r) * 1024 + h * 128 + 64 + (c - 12) * 8), v);
#pragma unroll
                    for (int q = 0; q < 8; ++q) Vs[r * 64 + (c - 12) * 8 + q] = v[q]; } }
            __syncthreads();
#pragma unroll
            for (int qi = 0; qi < 8; ++qi) {
                const int qr = wave * 8 + qi;
                float s = 0.f;
                for (int d = 0; d < 96; ++d) s += Qs[qr * 96 + d] * Ks[lane * 97 + d];
                if (kt == qb && lane > qr) s = -1e30f;
                const float mn = fmaxf(m[qi], wave_max(s));
                const float p = exp2f(s - mn), al = exp2f(m[qi] - mn);
                const float pb = rbf(p);
                l[qi] = l[qi] * al + wave_sum(p); m[qi] = mn;
                Ps[wave * 64 + lane] = pb;
                asm volatile("s_waitcnt lgkmcnt(0)" ::: "memory");
                float acc = 0.f;
                for (int k = 0; k < 64; ++k) acc += Ps[wave * 64 + k] * Vs[k * 64 + lane];
                o[qi] = o[qi] * al + acc;
                asm volatile("s_waitcnt lgkmcnt(0)" ::: "memory");
            }
        }
#pragma unroll
        for (int qi = 0; qi < 8; ++qi) MIX[(size_t)(t0 + wave * 8 + qi) * D + 512 + h * 64 + lane] = (bf16_t)f2bf(o[qi] / l[qi]);
    }
    __syncthreads();
}


typedef float f32x16 __attribute__((ext_vector_type(16)));
typedef short s16x4 __attribute__((ext_vector_type(4)));
typedef short v4i16_t __attribute__((ext_vector_type(4)));
__device__ __forceinline__ int crow(int r, int hi) { return (r & 3) + 8 * (r >> 2) + 4 * hi; }
__device__ __forceinline__ s16x4 vtr(const LAS unsigned char* p) { return __builtin_bit_cast(s16x4, __builtin_amdgcn_ds_read_tr16_b64_v4i16((LAS v4i16_t*)p)); }
#ifndef ATT_THR
#define ATT_THR 5.0f
#endif
__device__ __forceinline__ void phase_attn(Ctx& C) {
    const bf16_t* Q = WSP(bf16_t, WS_Q); const bf16_t* KV = WSP(bf16_t, WS_KV); const bf16_t* KPE = WSP(bf16_t, WS_KPE); bf16_t* MIX = WSP(bf16_t, WS_MIX);
    constexpr int KROW = 208, KBUF = 64 * KROW, VBUF = 8192, OFF_K = 0, OFF_V = 2 * KBUF, OFF_WS = OFF_V + 2 * VBUF, OFF_OST = OFF_WS + 8 * 128;
    LAS unsigned char* lds = C.lds;
    const int tid = C.tid, lane = C.lane, wave = C.wave, r32 = lane & 31, hi = lane >> 5;
    LAS float* wsf = (LAS float*)(lds + OFF_WS + wave * 128);
    LAS unsigned char* ost = lds + OFF_OST + wave * 4096;
    const int krow = tid >> 3, kch = tid & 7, prow = tid >> 2, pch = tid & 3;
    const int kdst = krow * KROW + kch * 16, vdst = (kch >> 2) * 4096 + krow * 64 + (kch & 3) * 16, pdst = prow * KROW + 128 + pch * 16;
    const int kfrag = r32 * KROW + hi * 16;
    const int vfrag = ((lane >> 4) & 1) * 32 + (lane & 3) * 8 + (4 * hi + ((lane & 15) >> 2)) * 64;
    for (int pr = C.bid; pr < 256; pr += C.nblk) {
        for (int half = 0; half < 2; ++half) {
            const int bh = pr >> 3, qq = pr & 7, qb = half == 0 ? 15 - qq : qq, b = bh >> 3, h = bh & 7;
            const int tb = b * SEQ, t0 = tb + qb * 256, NT = 4 * qb + 4;
            bf16x8 qf[6];
            { const bf16_t* qp = Q + (size_t)(t0 + wave * 32 + r32) * 768 + h * 96 + hi * 8;
#pragma unroll
              for (int s = 0; s < 6; ++s) qf[s] = *(const bf16x8*)(qp + 16 * s); }
            f32x16 o0, o1;
#pragma unroll
            for (int r = 0; r < 16; ++r) { o0[r] = 0.f; o1[r] = 0.f; }
            float mref = -1e30f, lsum = 0.f;
            const bf16_t* ksrc = KV + (size_t)(tb + krow) * 1024 + h * 128 + kch * 8;
            const bf16_t* vsrc = ksrc + 64;
            const bf16_t* psrc = KPE + (size_t)(tb + prow) * 32 + pch * 8;
            u32x4 kreg, vreg, preg;
            kreg = *(const u32x4*)ksrc; vreg = *(const u32x4*)vsrc; preg = (tid < 256) ? *(const u32x4*)psrc : (u32x4){0u, 0u, 0u, 0u};
            __syncthreads();
            *(LAS u32x4*)(lds + OFF_K + kdst) = kreg; *(LAS u32x4*)(lds + OFF_V + vdst) = vreg; if (tid < 256) *(LAS u32x4*)(lds + OFF_K + pdst) = preg;
            __syncthreads();
            const int qmin = qb * 256 + wave * 32;
            for (int t = 0; t < NT; ++t) {
                const int cur = t & 1;
                if (t + 1 < NT) { const size_t adv = (size_t)(t + 1) * 64; kreg = *(const u32x4*)(ksrc + adv * 1024); vreg = *(const u32x4*)(vsrc + adv * 1024); if (tid < 256) preg = *(const u32x4*)(psrc + adv * 32); }
                const int kmin = 64 * t;
                if (kmin <= qmin + 31) {
                    f32x16 p0, p1;
#pragma unroll
                    for (int r = 0; r < 16; ++r) { p0[r] = 0.f; p1[r] = 0.f; }
                    const LAS unsigned char* kb = lds + OFF_K + cur * KBUF + kfrag;
#pragma unroll
                    for (int s = 0; s < 6; ++s) {
                        const bf16x8 k0 = *(const LAS bf16x8*)(kb + s * 32), k1 = *(const LAS bf16x8*)(kb + 32 * KROW + s * 32);
                        p0 = __builtin_amdgcn_mfma_f32_32x32x16_bf16(k0, qf[s], p0, 0, 0, 0);
                        p1 = __builtin_amdgcn_mfma_f32_32x32x16_bf16(k1, qf[s], p1, 0, 0, 0);
                    }
                    if (kmin + 63 > qmin) {
                        const int qd = qmin + r32 - kmin;
#pragma unroll
                        for (int r = 0; r < 16; ++r) { const int kv = crow(r, hi); if (kv > qd) p0[r] = -1e30f; if (kv + 32 > qd) p1[r] = -1e30f; }
                    }
                    float rm = fmaxf(p0[0], p1[0]);
#pragma unroll
                    for (int r = 1; r < 16; ++r) rm = fmaxf(rm, fmaxf(p0[r], p1[r]));
                    rm = fmaxf(rm, __shfl_xor(rm, 32));
                    if (__any(rm > mref + ATT_THR)) {
                        const float mnew = fmaxf(mref, rm), f = __builtin_amdgcn_exp2f(mref - mnew);
                        lsum *= f; mref = mnew;
                        if (hi == 0) wsf[r32] = f;
                        asm volatile("s_waitcnt lgkmcnt(0)" ::: "memory");
#pragma unroll
                        for (int r = 0; r < 16; ++r) { const float fr = wsf[crow(r, hi)]; o0[r] *= fr; o1[r] *= fr; }
                        asm volatile("s_waitcnt lgkmcnt(0)" ::: "memory");
                    }
#pragma unroll
                    for (int r = 0; r < 16; ++r) { p0[r] = __builtin_amdgcn_exp2f(p0[r] - mref); p1[r] = __builtin_amdgcn_exp2f(p1[r] - mref); lsum += p0[r] + p1[r]; }
                    u32x4 pw[4];
#pragma unroll
                    for (int i = 0; i < 4; ++i) { pw[0][i] = pk2(p0[2 * i], p0[2 * i + 1]); pw[1][i] = pk2(p0[8 + 2 * i], p0[9 + 2 * i]); pw[2][i] = pk2(p1[2 * i], p1[2 * i + 1]); pw[3][i] = pk2(p1[8 + 2 * i], p1[9 + 2 * i]); }
                    const LAS unsigned char* vb = lds + OFF_V + cur * VBUF + vfrag;
#pragma unroll
                    for (int ks = 0; ks < 4; ++ks) {
                        const s16x4 a0 = vtr(vb + ks * 1024), a1 = vtr(vb + ks * 1024 + 512), b0 = vtr(vb + 4096 + ks * 1024), b1 = vtr(vb + 4096 + ks * 1024 + 512);
                        const bf16x8 v0 = (bf16x8){a0[0], a0[1], a0[2], a0[3], a1[0], a1[1], a1[2], a1[3]}, v1 = (bf16x8){b0[0], b0[1], b0[2], b0[3], b1[0], b1[1], b1[2], b1[3]};
                        const bf16x8 pa = __builtin_bit_cast(bf16x8, pw[ks]);
                        o0 = __builtin_amdgcn_mfma_f32_32x32x16_bf16(pa, v0, o0, 0, 0, 0);
                        o1 = __builtin_amdgcn_mfma_f32_32x32x16_bf16(pa, v1, o1, 0, 0, 0);
                    }
                }
                if (t + 1 < NT) { const int nb = cur ^ 1; *(LAS u32x4*)(lds + OFF_K + nb * KBUF + kdst) = kreg; *(LAS u32x4*)(lds + OFF_V + nb * VBUF + vdst) = vreg; if (tid < 256) *(LAS u32x4*)(lds + OFF_K + nb * KBUF + pdst) = preg; }
                __syncthreads();
            }
            const float ltot = lsum + __shfl_xor(lsum, 32);
            if (hi == 0) wsf[r32] = 1.0f / ltot;
            asm volatile("s_waitcnt lgkmcnt(0)" ::: "memory");
#pragma unroll
            for (int r = 0; r < 16; ++r) { const int q = crow(r, hi); const float fr = wsf[q];
                *(LAS bf16_t*)(ost + q * 128 + r32 * 2) = (bf16_t)f2bf(o0[r] * fr); *(LAS bf16_t*)(ost + q * 128 + 64 + r32 * 2) = (bf16_t)f2bf(o1[r] * fr); }
            asm volatile("s_waitcnt lgkmcnt(0)" ::: "memory");
#pragma unroll
            for (int i = 0; i < 4; ++i) { const int idx = i * 64 + lane, q = idx >> 3, c = idx & 7;
                const u32x4 w = *(const LAS u32x4*)(ost + q * 128 + c * 16);
                *(u32x4*)(MIX + (size_t)(t0 + wave * 32 + q) * D + 512 + h * 64 + c * 8) = w; }
        }
    }
    __syncthreads();
}


__device__ __forceinline__ void phase_sg(Ctx& C, int j) {
    const bf16_t* Z = WSP(bf16_t, WS_Z); const float* ssqx = WSP(float, WS_SSQX); const bf16_t* WS = WSP(bf16_t, WS_WS) + (size_t)j * 8 * 128 * 128; bf16_t* MIX = WSP(bf16_t, WS_MIX);
    const float* vg = WSP(float, WS_PAR) + PAR_VN + j * D; const float* bs = WSP(float, WS_PAR) + PAR_BS + (size_t)j * 8 * 128;
    LAS unsigned char* lds = C.lds;
    const int tid = C.tid, lane = C.lane, wave = C.wave, r32 = lane & 31, hi = lane >> 5, wr = wave >> 1, wc = wave & 1;
    const int srow = tid >> 2, sblk = tid & 3;
    const int vfrag = ((lane >> 4) & 1) * 32 + (lane & 3) * 8 + (8 * hi + ((lane & 15) >> 2)) * 64;
    for (int u = C.bid; u < NBATCH * 32 * 8; u += C.nblk) {
        const int g = u & 7, bc = u >> 3, t0 = bc * 128;
        __syncthreads();
        {
            const float rv = rs_from(ssqx + (t0 + srow) * 36 + 16, 16, 1.f / 1024);
            const bf16_t* zp = Z + (size_t)(t0 + srow) * 2048 + 1024 + g * 128 + sblk * 32; const float* gp = vg + g * 128 + sblk * 32;
#pragma unroll
            for (int c = 0; c < 4; ++c) { float v[8]; unpack8(*(const u32x4*)(zp + c * 8), v);
#pragma unroll
                for (int q = 0; q < 8; ++q) v[q] = v[q] * rv * gp[c * 8 + q];
                *(LAS u32x4*)(lds + sblk * 8192 + srow * 64 + c * 16) = pack8(v); }
        }
        __syncthreads();
        f32x16 a0, a1;
#pragma unroll
        for (int r = 0; r < 16; ++r) { a0[r] = 0.f; a1[r] = 0.f; }
        const bf16_t* wp = WS + (size_t)g * 16384 + (32 * wr + r32) * 128 + 8 * hi;
        const LAS unsigned char* vb = lds + (2 * wc) * 8192 + vfrag;
        for (int ks = 0; ks < 2 * wr + 2; ++ks) {
            const bf16x8 wf = *(const bf16x8*)(wp + 16 * ks);
            const s16x4 x0 = vtr(vb + ks * 1024), x1 = vtr(vb + ks * 1024 + 256), y0 = vtr(vb + 8192 + ks * 1024), y1 = vtr(vb + 8192 + ks * 1024 + 256);
            const bf16x8 v0 = (bf16x8){x0[0], x0[1], x0[2], x0[3], x1[0], x1[1], x1[2], x1[3]}, v1 = (bf16x8){y0[0], y0[1], y0[2], y0[3], y1[0], y1[1], y1[2], y1[3]};
            a0 = __builtin_amdgcn_mfma_f32_32x32x16_bf16(wf, v0, a0, 0, 0, 0);
            a1 = __builtin_amdgcn_mfma_f32_32x32x16_bf16(wf, v1, a1, 0, 0, 0);
        }
#pragma unroll
        for (int r = 0; r < 16; ++r) {
            const int t = 32 * wr + crow(r, hi); const float bias = bs[g * 128 + t];
            const size_t zo = (size_t)(t0 + t) * 2048 + g * 128 + 64 * wc + r32, mo = (size_t)(t0 + t) * D + g * 128 + 64 * wc + r32;
            MIX[mo] = (bf16_t)f2bf(bf2f(Z[zo]) * (a0[r] + bias)); MIX[mo + 32] = (bf16_t)f2bf(bf2f(Z[zo + 32]) * (a1[r] + bias));
        }
    }
    __syncthreads();
}

__device__ __forceinline__ void phase_sg_naive(Ctx& C, int j) {
    const bf16_t* Z = WSP(bf16_t, WS_Z); const float* ssqx = WSP(float, WS_SSQX); const bf16_t* WS = WSP(bf16_t, WS_WS) + (size_t)j * 8 * 128 * 128; bf16_t* MIX = WSP(bf16_t, WS_MIX);
    const float* vg = WSP(float, WS_PAR) + PAR_VN + j * D; const float* bs = WSP(float, WS_PAR) + PAR_BS + (size_t)j * 8 * 128;
    LAS float* Wt = (LAS float*)C.lds;
    LAS float* Vn = Wt + 128 * 129;
    const int tid = C.tid;
    for (int u = C.bid; u < NBATCH * 32 * 8; u += C.nblk) {
        const int g = u & 7, bc = u >> 3, t0 = bc * 128;
        __syncthreads();
        for (int i = tid; i < 128 * 16; i += NTHREADS) { const int r = i >> 4, c8 = (i & 15) * 8; float v[8];
            unpack8(*(const u32x4*)(WS + (size_t)g * 16384 + r * 128 + c8), v);
#pragma unroll
            for (int q = 0; q < 8; ++q) Wt[r * 129 + c8 + q] = v[q];
            unpack8(*(const u32x4*)(Z + (size_t)(t0 + r) * 2048 + 1024 + g * 128 + c8), v);
            const float rv = rs_from(ssqx + (t0 + r) * 36 + 16, 16, 1.f / 1024);
#pragma unroll
            for (int q = 0; q < 8; ++q) Vn[r * 128 + c8 + q] = rbf(v[q] * rv * vg[g * 128 + c8 + q]); }
        __syncthreads();
        const int t = tid >> 2, d0 = (tid & 3) * 32;
        float acc[32];
#pragma unroll
        for (int i = 0; i < 32; ++i) acc[i] = 0.f;
        for (int s = 0; s <= t; ++s) { const float w = Wt[t * 129 + s];
#pragma unroll
            for (int i = 0; i < 32; ++i) acc[i] += w * Vn[s * 128 + d0 + i]; }
        const float bias = bs[g * 128 + t];
#pragma unroll
        for (int i8 = 0; i8 < 4; ++i8) { float uu[8], o[8]; unpack8(*(const u32x4*)(Z + (size_t)(t0 + t) * 2048 + g * 128 + d0 + i8 * 8), uu);
#pragma unroll
            for (int q = 0; q < 8; ++q) o[q] = uu[q] * (acc[i8 * 8 + q] + bias);
            *(u32x4*)(MIX + (size_t)(t0 + t) * D + g * 128 + d0 + i8 * 8) = pack8(o); }
    }
    __syncthreads();
}

__device__ __forceinline__ void phase_router(Ctx& C, int layer, bool sh = false) {
    const bf16_t* HB = WSP(bf16_t, WS_HB0); const float* ssq = WSP(float, WS_SSQ0); const bf16_t* WR = WSP(bf16_t, WS_WR) + (size_t)layer * 64 * D;
    int* tok_e = sh ? WSP(int, WS_Y + 4 * MiB) : WSP(int, WS_TOK); int* tok_pos = tok_e + 2 * T; float* rffn = (float*)(tok_pos + 2 * T);
    int* list = sh ? WSP(int, WS_Y) : WSP(int, WS_LIST); float* lw = sh ? WSP(float, WS_Y + 2 * MiB) : WSP(float, WS_LW); unsigned* cnt = WSP(unsigned, WS_CTL) + CW_CNT + (layer + (sh ? 4 : 0)) * 64;
    LAS u32x4* Wl = (LAS u32x4*)C.lds;
    const int lane = C.lane;
    __syncthreads();
    for (int i = C.tid; i < 48 * 128; i += NTHREADS) Wl[(i >> 7) * 129 + (i & 127)] = *(const u32x4*)(WR + (size_t)i * 8);
    __syncthreads();
    LAS float* lgw = (LAS float*)(C.lds + 48 * 129 * 16) + C.wave * (16 * 49);
    const int gw = C.bid * NWAVES + C.wave, NGW = C.nblk * NWAVES, fr = lane & 15, fq = lane >> 4;
    for (int grp = gw; grp < T / 16; grp += NGW) {
        const int tok0 = grp * 16;
        f32x4 acc[3];
#pragma unroll
        for (int n = 0; n < 3; ++n) acc[n] = (f32x4){0.f, 0.f, 0.f, 0.f};
        const bf16_t* ap = HB + (size_t)(tok0 + fr) * D + fq * 8;
#pragma unroll 8
        for (int ks = 0; ks < 32; ++ks) {
            const bf16x8 a = *(const bf16x8*)(ap + 32 * ks);
#pragma unroll
            for (int n = 0; n < 3; ++n) { const bf16x8 b = __builtin_bit_cast(bf16x8, Wl[(16 * n + fr) * 129 + 4 * ks + fq]); acc[n] = __builtin_amdgcn_mfma_f32_16x16x32_bf16(a, b, acc[n], 0, 0, 0); }
        }
#pragma unroll
        for (int n = 0; n < 3; ++n)
#pragma unroll
            for (int r = 0; r < 4; ++r) lgw[(4 * fq + r) * 49 + 16 * n + fr] = acc[n][r];
        asm volatile("s_waitcnt lgkmcnt(0)" ::: "memory");
        if (lane < 16) {
            const int m = tok0 + lane; const LAS float* lg = lgw + lane * 49;
            const float r = rs_from(ssq + m * 16, 16, 1.f / D);
            const float g0 = lg[0] * r, g1 = lg[1] * r, g2 = lg[2] * r, g3 = lg[3] * r;
            int g = 0; float gm = g0;
            if (g1 > gm) { gm = g1; g = 1; }
            if (g2 > gm) { gm = g2; g = 2; }
            if (g3 > gm) { gm = g3; g = 3; }
            const float gs = __expf(g0 - gm) + __expf(g1 - gm) + __expf(g2 - gm) + __expf(g3 - gm);
            const float gw_ = 1.0f / gs;
            float el[8];
#pragma unroll
            for (int q = 0; q < 8; ++q) el[q] = lg[4 + g * 8 + q] * r;
            int i1 = 0; float m1 = el[0];
#pragma unroll
            for (int q = 1; q < 8; ++q) if (el[q] > m1) { m1 = el[q]; i1 = q; }
            int i2 = -1; float m2 = -3.0e38f;
#pragma unroll
            for (int q = 0; q < 8; ++q) if (q != i1 && el[q] > m2) { m2 = el[q]; i2 = q; }
            const float e2 = __expf(m2 - m1), p1 = 1.0f / (1.0f + e2), p2 = e2 / (1.0f + e2);
            rffn[m] = r;
            const int ea = g * 8 + i1, eb = g * 8 + i2;
            const int pa = (int)atomicAdd(cnt + ea, 1u), pb = (int)atomicAdd(cnt + eb, 1u);
            list[ea * T + pa] = m; lw[ea * T + pa] = gw_ * p1; list[eb * T + pb] = m; lw[eb * T + pb] = gw_ * p2;
            tok_e[2 * m] = ea; tok_e[2 * m + 1] = eb; tok_pos[2 * m] = pa; tok_pos[2 * m + 1] = pb;
        }
        asm volatile("s_waitcnt lgkmcnt(0)" ::: "memory");
    }
    __syncthreads();
}

__device__ __forceinline__ void phase_combine(Ctx& C, int layer, bool sh = false) {
    const MoeTab mt = moe_tables(C, layer);
    const float* H = WSP(float, WS_H); float* Ho = sh ? WSP(float, WS_P3) : WSP(float, WS_H); bf16_t* HB = sh ? WSP(bf16_t, WS_KV) : WSP(bf16_t, WS_HB1); float* SS = sh ? WSP(float, WS_SSQX) : WSP(float, WS_SSQ1); const bf16_t* Y = WSP(bf16_t, WS_Y);
    const int* tok_e = WSP(int, WS_TOK); const int* tok_pos = tok_e + 2 * T;
    const int gw = C.bid * NWAVES + C.wave, NGW = C.nblk * NWAVES, lane = C.lane;
    for (int m = gw; m < T; m += NGW) {
        const int ea = tok_e[2 * m], eb = tok_e[2 * m + 1];
        const size_t sa = (size_t)mt.ebase[ea] * 256 + tok_pos[2 * m], sb = (size_t)mt.ebase[eb] * 256 + tok_pos[2 * m + 1];
        const f32x4* hr = (const f32x4*)(H + (size_t)m * D) + lane; f32x4* ho = (f32x4*)(Ho + (size_t)m * D) + lane; const u32x2* ya = (const u32x2*)(Y + sa * D) + lane; const u32x2* yb = (const u32x2*)(Y + sb * D) + lane;
        u32x2* ob = (u32x2*)(HB + (size_t)m * D) + lane; float s = 0.f;
#pragma unroll
        for (int j = 0; j < 4; ++j) {
            f32x4 v = hr[64 * j]; const u32x2 a = ya[64 * j], b = yb[64 * j];
            v.x += bf2f(a.x & 0xffffu) + bf2f(b.x & 0xffffu); v.y += bf2f(a.x >> 16) + bf2f(b.x >> 16); v.z += bf2f(a.y & 0xffffu) + bf2f(b.y & 0xffffu); v.w += bf2f(a.y >> 16) + bf2f(b.y >> 16);
            ho[64 * j] = v; s += (v.x * v.x + v.y * v.y) + (v.z * v.z + v.w * v.w); u32x2 o; o.x = pk2(v.x, v.y); o.y = pk2(v.z, v.w); ob[64 * j] = o;
        }
        s = wave_sum(s);
        if (lane < 16) SS[m * 16 + lane] = (lane == 0) ? s : 0.f;
    }
    __syncthreads();
}

__device__ __forceinline__ void phase_final(Ctx& C, float* outp) {
    const float* H = WSP(float, WS_H); const float* SS = WSP(float, WS_SSQ0); const float* g = WSP(float, WS_PAR) + PAR_FN;
    const int gw = C.bid * NWAVES + C.wave, NGW = C.nblk * NWAVES, lane = C.lane;
    for (int m = gw; m < T; m += NGW) {
        const float r = rs_from(SS + m * 16, 16, 1.f / D);
        const f32x4* hr = (const f32x4*)(H + (size_t)m * D) + lane; f32x4* o = (f32x4*)(outp + (size_t)m * D) + lane; const f32x4* gg = (const f32x4*)g + lane;
#pragma unroll
        for (int j = 0; j < 4; ++j) { const f32x4 v = hr[64 * j], w = gg[64 * j]; o[64 * j] = (f32x4){v.x * r * w.x, v.y * r * w.y, v.z * r * w.z, v.w * r * w.w}; }
    }
}

constexpr int NPHASES = 42;
template <int ph, bool SH = false> __device__ __forceinline__ void run_phase(Ctx& C) {
    constexpr int layer = (ph - 1) / 10, sub = (ph - 1) % 10, j = layer >> 1; constexpr bool even = (layer & 1) == 0;
    float* H = WSP(float, WS_H); bf16_t* HB0 = WSP(bf16_t, WS_HB0); bf16_t* HB1 = WSP(bf16_t, WS_HB1); float* SSQ0 = WSP(float, WS_SSQ0); float* SSQ1 = WSP(float, WS_SSQ1); float* SSQX = WSP(float, WS_SSQX);
    float* Hw = SH ? WSP(float, WS_P3) : H; bf16_t* HB0w = SH ? WSP(bf16_t, WS_KV) : HB0; float* SSQ0w = SH ? SSQX : SSQ0;
    const float* ROPE = WSP(float, WS_ROPE); bf16_t* MIX = WSP(bf16_t, WS_MIX);
    switch (sub) {
    case 0:
        if (even) { const bf16_t* W = WSP(bf16_t, WS_WINE) + (size_t)j * EINP * D; EpiE1 e{SSQ0, WSP(bf16_t, WS_P3), WSP(bf16_t, WS_CQ), WSP(bf16_t, WS_CKV), WSP(bf16_t, WS_KPE), SSQX, ROPE};
            if (FASTMASK & 1) gemm_dense(C, HB0, W, EINP, D, e); else { DenseRM rm{HB0, W, D}; gemm_naive(C, EINP, D, rm, e); } }
        else { const bf16_t* W = WSP(bf16_t, WS_WINO) + (size_t)j * 2048 * D; EpiGelu e{SSQ0, WSP(bf16_t, WS_Z), SSQX};
            if (FASTMASK & 2) gemm_dense(C, HB0, W, 2048, D, e); else { DenseRM rm{HB0, W, D}; gemm_naive(C, 2048, D, rm, e); } }
        break;
    case 1:
        if (even) {
            { const bf16_t* W = WSP(bf16_t, WS_WQ) + (size_t)j * 768 * QR; EpiQ e{SSQX, WSP(bf16_t, WS_Q), ROPE};
              if (FASTMASK & 4) gemm_dense(C, WSP(bf16_t, WS_CQ), W, 768, QR, e); else { DenseRM rm{WSP(bf16_t, WS_CQ), W, QR}; gemm_naive(C, 768, QR, rm, e); } }
            { const bf16_t* W = WSP(bf16_t, WS_WKV) + (size_t)j * 1024 * KVR; EpiKV e{SSQX, WSP(bf16_t, WS_KV)};
              if (FASTMASK & 8) gemm_dense(C, WSP(bf16_t, WS_CKV), W, 1024, KVR, e); else { DenseRM rm{WSP(bf16_t, WS_CKV), W, KVR}; gemm_naive(C, 1024, KVR, rm, e); } }
            phase_conv(C, j);
        } else { if (FASTMASK & 1024) phase_sg(C, j); else phase_sg_naive(C, j); }
        break;
    case 2:
        if (even) { if (FASTMASK & 512) phase_attn(C); else phase_attn_naive(C); }
        break;
    case 3: {
        const bf16_t* W = (even ? WSP(bf16_t, WS_WOE) : WSP(bf16_t, WS_WOO)) + (size_t)j * D * D; EpiRes e{H, Hw, HB0w, SSQ0w};
        if (FASTMASK & 16) gemm_dense(C, MIX, W, D, D, e); else { DenseRM rm{MIX, W, D}; gemm_naive(C, D, D, rm, e); }
        break; }
    case 4: phase_router(C, layer, SH); break;
    case 5: { const MoeTab mt = moe_tables(C, layer); const int* tok_e = WSP(int, WS_TOK); const bf16_t* W = WSP(bf16_t, WS_WGU) + (size_t)layer * NEXP * D * D;
        EpiGU e{mt, WSP(int, WS_LIST), (const float*)(tok_e + 4 * T), WSP(bf16_t, WS_ACT)};
        if (FASTMASK & 32) { MoeGatherProb P{mt, WSP(int, WS_LIST), HB0, W, D}; pg8::MoeOrder S{mt.ebase[NEXP], C.nblk, C.bid}; pg8::EpiAdapt<EpiGU> ea{e}; pg8::gemm_phase(C.lds, C.tid, P, S, ea); }
        else { MoeGatherRM rm{mt, WSP(int, WS_LIST), HB0, W}; gemm_naive(C, D, D, rm, e); }
        break; }
    case 6: { const MoeTab mt = moe_tables(C, layer); const bf16_t* W = WSP(bf16_t, WS_WDN) + (size_t)layer * NEXP * D * DEXP;
        EpiDown e{mt, WSP(int, WS_LIST), WSP(float, WS_LW), WSP(bf16_t, WS_Y)};
        if (FASTMASK & 64) { MoeDownProb P{mt, WSP(bf16_t, WS_ACT), W, DEXP}; pg8::MoeOrder S{mt.ebase[NEXP], C.nblk, C.bid}; pg8::EpiAdapt<EpiDown> ea{e}; pg8::gemm_phase(C.lds, C.tid, P, S, ea); }
        else { MoeDownRM rm{mt, WSP(bf16_t, WS_ACT), W}; gemm_naive(C, D, DEXP, rm, e); }
        break; }
    case 7: phase_combine(C, layer, SH); break;
    case 8: { const bf16_t* A = WSP(bf16_t, WS_PB) + (size_t)layer * T * PLE; const bf16_t* W = WSP(bf16_t, WS_WP) + (size_t)layer * D * PLE; EpiPP e{WSP(bf16_t, WS_PP)};
        if (FASTMASK & 128) gemm_dense(C, A, W, D, PLE, e); else { DenseRM rm{A, W, PLE}; gemm_naive(C, D, PLE, rm, e); }
        break; }
    case 9: { const bf16_t* W = WSP(bf16_t, WS_WG) + (size_t)layer * D * D; EpiPLE e{SSQ1, WSP(bf16_t, WS_PP), H, Hw, HB0w, SSQ0w};
        if (FASTMASK & 256) gemm_dense(C, HB1, W, D, D, e); else { DenseRM rm{HB1, W, D}; gemm_naive(C, D, D, rm, e); }
        break; }
    }
}
__host__ __device__ constexpr bool phase_is_nop(int ph) { return (ph != 0 && ph != NPHASES - 1) && ((((ph - 1) / 10) & 1) != 0) && (((ph - 1) % 10) == 2); }

__device__ __forceinline__ void phase_enter(Ctx& C, unsigned char* ws) {
    int t = threadIdx.x; asm volatile("" : "+v"(t)); C.tid = t; C.lane = t & 63; C.wave = __builtin_amdgcn_readfirstlane(t >> 6);
    unsigned char* w = ws; asm volatile("" : "+s"(w)); C.ws = w;
    int b = blockIdx.x; asm volatile("" : "+s"(b)); C.bid = b;
}
template <int PH> __device__ __forceinline__ void run_all(Ctx& C, unsigned char* ws, const XcdBarrier& bar) {
    if constexpr (PH < NPHASES - 1) {
        if constexpr (!phase_is_nop(PH)) { phase_enter(C, ws); run_phase<PH>(C); xcd_barrier(bar);
            if constexpr ((DUPMASK >> PH) & 1ull) { phase_enter(C, ws); run_phase<PH, true>(C); xcd_barrier(bar); } }
        run_all<PH + 1>(C, ws, bar);
    }
}
template <int PH> __device__ __forceinline__ void run_one(Ctx& C, unsigned char* ws, int ph) {
    if constexpr (PH < NPHASES - 1) {
        if (ph == PH) { if constexpr (!phase_is_nop(PH)) { phase_enter(C, ws); run_phase<PH>(C); } }
        else run_one<PH + 1>(C, ws, ph);
    }
}
__global__ void __launch_bounds__(NTHREADS, 2) fwd_kernel(Args args) {
    extern __shared__ __attribute__((aligned(16))) unsigned char lds_raw[];
    Ctx C;
    C.lds = (LAS unsigned char*)lds_raw;
    C.a = &args; C.ws = args.ws;
    C.tid = threadIdx.x; C.lane = C.tid & 63; C.wave = __builtin_amdgcn_readfirstlane(C.tid >> 6);
    C.bid = blockIdx.x; C.nblk = gridDim.x;
    volatile LAS unsigned* misc = (volatile LAS unsigned*)(C.lds + LDS_MISC);
    if (C.tid < 64) misc[C.tid] = 0u;
    __syncthreads();
#if MEGA
    XcdBarrier bar = xcd_barrier_post(WSP(unsigned, WS_CTL) + CW_BAR, misc + 8);
#endif
#if MEGA
    int lo = 0; constexpr int hi = NPHASES;
#else
    int lo = args.ph_lo; const int hi = args.ph_hi;
#endif
#if MEGA
#define SEAM(p) do { if ((p) + 1 < hi) xcd_barrier(bar); } while (0)
#else
#define SEAM(p) do { } while (0)
#endif
    if (lo == 0) { phase_prologue(C); SEAM(0); if (DUPMASK & 1ull) { phase_prologue(C); SEAM(0); } lo = 1; }
#if MEGA
    run_all<1>(C, args.ws, bar);
#else
    run_one<1>(C, args.ws, lo);
#endif
    if (hi == NPHASES && lo <= NPHASES - 1) {
        int t = threadIdx.x; asm volatile("" : "+v"(t)); C.tid = t; C.lane = t & 63; C.wave = __builtin_amdgcn_readfirstlane(t >> 6);
        unsigned char* w = args.ws; asm volatile("" : "+s"(w)); C.ws = w;
        phase_final(C, args.out);
    }
#undef SEAM
}

extern "C" void kernel_launch(void* const* d_in, const int* in_sizes, int n_in, void* d_out, int out_size, void* d_ws, size_t ws_size, hipStream_t stream) {
    static int grid = 0;
    if (grid == 0) {
        if (n_in != 26 || out_size != T * D || ws_size < WS_END) { fprintf(stderr, "kernel_launch: unexpected shapes (n_in %d out %d ws %zu)\n", n_in, out_size, ws_size); grid = -1; return; }
        int dev = 0, cus = 0;
        if (hipGetDevice(&dev) != hipSuccess || hipDeviceGetAttribute(&cus, hipDeviceAttributeMultiprocessorCount, dev) != hipSuccess) { grid = -1; return; }
        if (hipFuncSetAttribute((const void*)fwd_kernel, hipFuncAttributeMaxDynamicSharedMemorySize, LDS_BYTES) != hipSuccess) { fprintf(stderr, "kernel_launch: hipFuncSetAttribute failed\n"); grid = -1; return; }
        grid = cus;
    }
    if (grid < 0) return;
    (void)hipMemsetAsync((char*)d_ws + WS_CTL, 0, CTL_ZERO_BYTES, stream);
    Args a{};
    for (int i = 0; i < 26; ++i) a.in[i] = (const float*)d_in[i];
    a.out = (float*)d_out; a.ws = (unsigned char*)d_ws;
#if MEGA
    a.ph_lo = 0; a.ph_hi = NPHASES;
    hipLaunchKernelGGL(fwd_kernel, dim3(grid), dim3(NTHREADS), LDS_BYTES, stream, a);
#else
    for (int ph = 0; ph < NPHASES; ++ph) {
        if (phase_is_nop(ph)) continue;
        a.ph_lo = ph; a.ph_hi = ph + 1;
        hipLaunchKernelGGL(fwd_kernel, dim3(grid), dim3(NTHREADS), LDS_BYTES, stream, a);
    }
#endif
}
```

```cpp
#include <hip/hip_runtime.h>
#include <cstdio>
#include <cstdint>

#ifndef FASTMASK
#define FASTMASK 0x7ff
#endif
#ifndef DUPMASK
#define DUPMASK 0ull
#endif
#ifndef MEGA
#define MEGA 1
#endif

#define LAS __attribute__((address_space(3)))
#define GAS __attribute__((address_space(1)))
typedef unsigned short bf16_t;
typedef float f32x4 __attribute__((ext_vector_type(4)));
typedef unsigned u32x4 __attribute__((ext_vector_type(4)));
typedef unsigned u32x2 __attribute__((ext_vector_type(2)));
typedef short bf16x8 __attribute__((ext_vector_type(8)));

constexpr int T = 16384, D = 1024, SEQ = 4096, NBATCH = 4, DEPTH = 4;
constexpr int EIN = 2208, EINP = 2304;
constexpr int NH = 8, DQK = 96, DV = 64;
constexpr int QR = 384, KVR = 256;
constexpr int NEXP = 32, DEXP = 512;
constexpr int PLE = 256;
constexpr float EPS = 1e-6f;
constexpr int NWAVES = 8, NTHREADS = 512;
constexpr int MOE_ROWS = 40960;
constexpr float QSCALE = 0.10206207261596577f * 1.4426950408889634f;

constexpr size_t MiB = 1u << 20;
constexpr size_t WS_CTL = 0, CTL_ZERO_BYTES = 1 * MiB;
constexpr size_t WS_WINE = 1 * MiB;
constexpr size_t WS_WQ = 10 * MiB;
constexpr size_t WS_WKV = 12 * MiB;
constexpr size_t WS_WOE = 13 * MiB;
constexpr size_t WS_WINO = 17 * MiB;
constexpr size_t WS_WOO = 25 * MiB;
constexpr size_t WS_WS = 29 * MiB;
constexpr size_t WS_WR = 30 * MiB;
constexpr size_t WS_WG = 31 * MiB;
constexpr size_t WS_WP = 39 * MiB;
constexpr size_t WS_WGU = 41 * MiB;
constexpr size_t WS_WDN = 297 * MiB;
constexpr size_t WS_H = 425 * MiB;
constexpr size_t WS_HB0 = 489 * MiB;
constexpr size_t WS_HB1 = 521 * MiB;
constexpr size_t WS_SSQ0 = 553 * MiB;
constexpr size_t WS_SSQ1 = 554 * MiB;
constexpr size_t WS_SSQX = 555 * MiB;
constexpr size_t WS_ROPE = 558 * MiB;
constexpr size_t WS_PB = 560 * MiB;
constexpr size_t WS_P3 = 592 * MiB;
constexpr size_t WS_CQ = 640 * MiB;
constexpr size_t WS_CKV = 652 * MiB;
constexpr size_t WS_KPE = 660 * MiB;
constexpr size_t WS_Z = 592 * MiB;
constexpr size_t WS_Q = 661 * MiB;
constexpr size_t WS_KV = 685 * MiB;
constexpr size_t WS_MIX = 717 * MiB;
constexpr size_t WS_LIST = 749 * MiB;
constexpr size_t WS_LW = 751 * MiB;
constexpr size_t WS_TOK = 753 * MiB;
constexpr size_t WS_ACT = 754 * MiB;
constexpr size_t WS_Y = 794 * MiB;
constexpr size_t WS_PP = 874 * MiB;
constexpr size_t WS_PAR = 906 * MiB;
constexpr int PAR_CONV = 0, PAR_VN = 3072, PAR_BS = 5120, PAR_FN = 7168, PAR_N = 8192;
constexpr size_t WS_END = 907 * MiB;

constexpr int CW_CNT = 8192;
constexpr int CW_BAR = 4096;

constexpr int LDS_BYTES = 147456;
constexpr int LDS_MISC = LDS_BYTES - 256;

__device__ __forceinline__ float bf2f(unsigned b) { return __uint_as_float(b << 16); }
__device__ __forceinline__ unsigned f2bf(float f) { unsigned u = __float_as_uint(f); return (u + 0x7fffu + ((u >> 16) & 1u)) >> 16; }
typedef float f32x2_t __attribute__((ext_vector_type(2))); typedef __bf16 bf16x2_t __attribute__((ext_vector_type(2)));
__device__ __forceinline__ unsigned pk2(float lo, float hi) { f32x2_t v = {lo, hi}; bf16x2_t b = __builtin_convertvector(v, bf16x2_t); return __builtin_bit_cast(unsigned, b); }
__device__ __forceinline__ void unpack8(const u32x4 w, float* v) {
    v[0] = __uint_as_float(w.x << 16); v[1] = __uint_as_float(w.x & 0xffff0000u);
    v[2] = __uint_as_float(w.y << 16); v[3] = __uint_as_float(w.y & 0xffff0000u);
    v[4] = __uint_as_float(w.z << 16); v[5] = __uint_as_float(w.z & 0xffff0000u);
    v[6] = __uint_as_float(w.w << 16); v[7] = __uint_as_float(w.w & 0xffff0000u);
}
__device__ __forceinline__ u32x4 pack8(const float* v) { u32x4 w; w.x = pk2(v[0], v[1]); w.y = pk2(v[2], v[3]); w.z = pk2(v[4], v[5]); w.w = pk2(v[6], v[7]); return w; }
__device__ __forceinline__ float rbf(float f) { return bf2f(f2bf(f)); }
__device__ __forceinline__ float wave_sum(float v) {
#pragma unroll
    for (int o = 1; o < 64; o <<= 1) v += __shfl_xor(v, o);
    return v;
}
__device__ __forceinline__ float wave_max(float v) {
#pragma unroll
    for (int o = 1; o < 64; o <<= 1) v = fmaxf(v, __shfl_xor(v, o));
    return v;
}
__device__ __forceinline__ float sigmoidf_(float x) { return 1.0f / (1.0f + __expf(-x)); }
__device__ __forceinline__ float gelu_tanh(float x) {
    const float u = 0.7978845608028654f * (x + 0.044715f * x * x * x);
    const float e = __expf(2.0f * u);
    const float th = 1.0f - 2.0f / (e + 1.0f);
    return 0.5f * x * (1.0f + th);
}

#define XB_TMO      128
#define XB_XCNT(j)  (256  + 64 * (j))
#define XB_XSUB(j)  (1280 + 64 * (j))
#define XB_XGEN(j)  (2304 + 64 * (j))
#define XB_TOP      3328
#define XB_TOPGEN   3392
#define XCD_BAR_WORDS 3456
#define XB_SPIN_CAP (1u << 22)
__device__ __forceinline__ unsigned xb_ld(unsigned* p)              { return __hip_atomic_load(p, __ATOMIC_RELAXED, __HIP_MEMORY_SCOPE_AGENT); }
__device__ __forceinline__ unsigned xb_add(unsigned* p, unsigned v) { return __hip_atomic_fetch_add(p, v, __ATOMIC_RELAXED, __HIP_MEMORY_SCOPE_AGENT); }
__device__ __forceinline__ unsigned xb_xcc_id() { return (unsigned)__builtin_amdgcn_s_getreg((3 << 11) | 20) & 0xFu; }
#define XB_SPIN(cond, bar) do { unsigned _sp = 0; while (cond) { __builtin_amdgcn_s_sleep(1); \
    if ((++_sp & 255u) == 0u) { if (xb_ld(&(bar)[XB_TMO])) break; if (_sp > XB_SPIN_CAP) { atomicAdd(&(bar)[XB_TMO], 1u); break; } } } } while (0)
struct XcdBarrier { unsigned* bar; unsigned x; volatile LAS unsigned* st; };
__device__ __forceinline__ XcdBarrier xcd_barrier_post(unsigned* bar, volatile LAS unsigned* st) {
    XcdBarrier b; b.bar = bar; b.x = xb_xcc_id(); b.st = st;
    if (threadIdx.x == 0) (void)xb_add(&bar[XB_XCNT(b.x)], 1u);
    return b;
}
__device__ __forceinline__ void xcd_barrier_complete(unsigned* bar, unsigned x, unsigned& nloc, unsigned& nx) {
    const unsigned G = gridDim.x * gridDim.y * gridDim.z;
    unsigned sum, cnt, mine, sp = 0u;
    for (;;) {
        sum = 0u; cnt = 0u; mine = 0u;
#pragma unroll
        for (unsigned j = 0; j < 16; ++j) { const unsigned c = xb_ld(&bar[XB_XCNT(j)]); sum += c; cnt += (c > 0u) ? 1u : 0u; mine = (j == x) ? c : mine; }
        if (sum == G) break;
        __builtin_amdgcn_s_sleep(1);
        if ((++sp & 255u) == 0u) { if (xb_ld(&bar[XB_TMO])) break; if (sp > XB_SPIN_CAP) { atomicAdd(&bar[XB_TMO], 1u); break; } }
    }
    nloc = mine > 0u ? mine : 1u; nx = cnt > 0u ? cnt : 1u;
}
__device__ __forceinline__ void xcd_barrier(const XcdBarrier& b) {
    asm volatile("s_waitcnt vmcnt(0)" ::: "memory");
    __syncthreads();
    if (threadIdx.x == 0) {
        unsigned* bar = b.bar;
        __builtin_amdgcn_s_waitcnt(0);
        unsigned nloc = b.st[0], nx = b.st[1];
        if (nloc == 0u) { xcd_barrier_complete(bar, b.x, nloc, nx); b.st[0] = nloc; b.st[1] = nx; }
        const unsigned old = xb_add(&bar[XB_XSUB(b.x)], 1u);
        const unsigned gen = old / nloc;
        if (old + 1u == (gen + 1u) * nloc) {
            __builtin_amdgcn_fence(__ATOMIC_RELEASE, "agent");
            asm volatile("s_waitcnt vmcnt(0)" ::: "memory");
            const unsigned og = xb_add(&bar[XB_TOP], 1u);
            const unsigned tg = og / nx;
            if (og + 1u == (tg + 1u) * nx) xb_add(&bar[XB_TOPGEN], 1u);
            else XB_SPIN(xb_ld(&bar[XB_TOPGEN]) == tg, bar);
            __builtin_amdgcn_fence(__ATOMIC_ACQUIRE, "agent");
            xb_add(&bar[XB_XGEN(b.x)], 1u);
            asm volatile("s_waitcnt vmcnt(0)" ::: "memory");
        } else {
            XB_SPIN(xb_ld(&bar[XB_XGEN(b.x)]) == gen, bar);
            __builtin_amdgcn_fence(__ATOMIC_ACQUIRE, "agent");
            asm volatile("s_waitcnt vmcnt(0)" ::: "memory");
        }
    }
    __syncthreads();
}

struct Args { const float* in[26]; float* out; unsigned char* ws; int ph_lo, ph_hi; };
struct Ctx {
    LAS unsigned char* lds;
    const Args* a; unsigned char* ws;
    int tid, lane, wave, bid, nblk;
};
#define WSP(T_, off) ((T_*)(C.ws + (off)))

__device__ __forceinline__ void conv_item(const float* colp, int ldw, const float* gain, bf16_t* WT, int K, int k0, int n0, LAS float* scr, int lane) {
#pragma unroll 8
    for (int i = 0; i < 32; ++i) {
        const int kk = 2 * i + (lane >> 5);
        float v = colp ? colp[(size_t)(k0 + kk) * ldw] : 0.f;
        if (gain) v *= gain[k0 + kk];
        scr[kk * 33 + (lane & 31)] = v;
    }
    asm volatile("s_waitcnt lgkmcnt(0)" ::: "memory");
    const int c = lane & 7;
#pragma unroll
    for (int j = 0; j < 4; ++j) {
        const int n = (lane >> 3) + 8 * j; const LAS float* s = scr + (8 * c) * 33 + n;
        u32x4 o; o.x = pk2(s[0 * 33], s[1 * 33]); o.y = pk2(s[2 * 33], s[3 * 33]); o.z = pk2(s[4 * 33], s[5 * 33]); o.w = pk2(s[6 * 33], s[7 * 33]);
        *(u32x4*)(WT + (size_t)(n0 + n) * K + k0 + 8 * c) = o;
    }
    asm volatile("s_waitcnt lgkmcnt(0)" ::: "memory");
}


__device__ __forceinline__ void conv_item64(const float* colp  , int ldw, const float* gain, bf16_t* WT, int K, int k0, int n0, LAS float* scr, int lane) {
    f32x4 v[16];
#pragma unroll
    for (int i = 0; i < 16; ++i) v[i] = *(const f32x4*)(colp + (size_t)(k0 + 4 * i + (lane >> 4)) * ldw);
#pragma unroll
    for (int i = 0; i < 16; ++i) {
        const int kk = 4 * i + (lane >> 4); const float g = gain ? gain[k0 + kk] : 1.f; LAS float* s = scr + kk * 65 + (lane & 15) * 4;
        s[0] = v[i].x * g; s[1] = v[i].y * g; s[2] = v[i].z * g; s[3] = v[i].w * g;
    }
    asm volatile("s_waitcnt lgkmcnt(0)" ::: "memory");
    const int c = lane & 7;
#pragma unroll
    for (int j = 0; j < 8; ++j) {
        const int n = (lane >> 3) + 8 * j; const LAS float* s = scr + (8 * c) * 65 + n;
        u32x4 o; o.x = pk2(s[0 * 65], s[1 * 65]); o.y = pk2(s[2 * 65], s[3 * 65]); o.z = pk2(s[4 * 65], s[5 * 65]); o.w = pk2(s[6 * 65], s[7 * 65]);
        *(u32x4*)(WT + (size_t)(n0 + n) * K + k0 + 8 * c) = o;
    }
    asm volatile("s_waitcnt lgkmcnt(0)" ::: "memory");
}

__device__ __forceinline__ void phase_prologue(Ctx& C) {
    LAS float* scr = (LAS float*)(C.lds + C.wave * 16896);
    const int gw = C.bid * NWAVES + C.wave, NGW = C.nblk * NWAVES, lane = C.lane;
    {
        constexpr int I0 = 16 * 72, I1 = 6 * 24, I6 = 16 * 2;
        constexpr int E0 = 2 * I0, E1 = E0 + 2 * I1, E6 = E1 + 4 * I6;
        for (int it = gw; it < E6; it += NGW) {
            const int nl = lane & 31;
            if (it < E0) {
                const int j = it / I0, r = it % I0, kb = r / 72, nb = r % 72, np = nb * 32 + nl;
                int n;
                if (np < 1920) n = np; else if (np < 1952) { const int q = np - 1920; n = 2176 + (q & 1) * 16 + (q >> 1); } else if (np < 2048) n = -1; else n = 1920 + (np - 2048);
                const float* base = C.a->in[5] + (size_t)j * D * EIN;
                conv_item(n >= 0 ? base + n : nullptr, EIN, C.a->in[3] + (2 * j) * D, WSP(bf16_t, WS_WINE) + (size_t)j * EINP * D, D, kb * 64, nb * 32, scr, lane);
            } else if (it < E1) {
                const int r0 = it - E0, j = r0 / I1, r = r0 % I1, kb = r / 24, nb = r % 24, np = nb * 32 + nl;
                const int hd = np / 96, dd = np % 96; int n = np;
                if (dd >= 64) { const int q = dd - 64; n = hd * 96 + 64 + (q & 1) * 16 + (q >> 1); }
                conv_item(C.a->in[8] + (size_t)j * QR * 768 + n, 768, C.a->in[7] + j * QR, WSP(bf16_t, WS_WQ) + (size_t)j * 768 * QR, QR, kb * 64, nb * 32, scr, lane);
            } else {
                const int r0 = it - E1, l = r0 / I6, r = r0 % I6, kb = r / 2, nb = r % 2, np = nb * 32 + nl;
                const float* cp = nullptr; int ld = 4;
                if (np < 4) { cp = C.a->in[17] + (size_t)l * D * 4 + np; ld = 4; } else if (np < 36) { cp = C.a->in[18] + (size_t)l * D * 32 + (np - 4); ld = 32; }
                conv_item(cp, ld, C.a->in[4] + l * D, WSP(bf16_t, WS_WR) + (size_t)l * 64 * D, D, kb * 64, nb * 32, scr, lane);
            }
        }
        constexpr int J2 = 4 * 16, J3 = 16 * 16, J4 = 16 * 32, J5 = 16 * 16, J7 = 16 * 16, J8 = 4 * 16, J9 = 16 * 16, J10 = 8 * 16;
        constexpr int F2 = 2 * J2, F3 = F2 + 2 * J3, F4 = F3 + 2 * J4, F5 = F4 + 2 * J5, F7 = F5 + 4 * J7, F8 = F7 + 4 * J8, F9 = F8 + 128 * J9, F10 = F9 + 128 * J10;
        const int n4 = (lane & 15) * 4;
        for (int it = gw; it < F10; it += NGW) {
            if (it >= F8) {
                if (it < F9) {
                    const int r0 = it - F8, m = r0 / J9, r = r0 % J9, kb = r / 16, nb = r % 16, np = nb * 64 + n4;
                    const int l = m >> 5, b4 = np >> 2;
                    const float* cp = ((b4 & 1) ? C.a->in[20] : C.a->in[19]) + (size_t)m * D * DEXP + (b4 >> 1) * 4;
                    conv_item64(cp, DEXP, C.a->in[4] + l * D, WSP(bf16_t, WS_WGU) + (size_t)m * D * D, D, kb * 64, nb * 64, scr, lane);
                } else {
                    const int r0 = it - F9, m = r0 / J10, r = r0 % J10, kb = r / 16, nb = r % 16, np = nb * 64 + n4;
                    conv_item64(C.a->in[21] + (size_t)m * DEXP * D + np, D, nullptr, WSP(bf16_t, WS_WDN) + (size_t)m * D * DEXP, DEXP, kb * 64, nb * 64, scr, lane);
                }
            } else if (it < F2) {
                const int j = it / J2, r = it % J2, kb = r / 16, nb = r % 16, np = nb * 64 + n4;
                conv_item64(C.a->in[10] + (size_t)j * KVR * 1024 + np, 1024, C.a->in[9] + j * KVR, WSP(bf16_t, WS_WKV) + (size_t)j * 1024 * KVR, KVR, kb * 64, nb * 64, scr, lane);
            } else if (it < F3) {
                const int r0 = it - F2, j = r0 / J3, r = r0 % J3, kb = r / 16, nb = r % 16, np = nb * 64 + n4;
                conv_item64(C.a->in[11] + (size_t)j * D * D + np, D, nullptr, WSP(bf16_t, WS_WOE) + (size_t)j * D * D, D, kb * 64, nb * 64, scr, lane);
            } else if (it < F4) {
                const int r0 = it - F3, j = r0 / J4, r = r0 % J4, kb = r / 32, nb = r % 32, np = nb * 64 + n4;
                conv_item64(C.a->in[12] + (size_t)j * D * 2048 + np, 2048, C.a->in[3] + (2 * j + 1) * D, WSP(bf16_t, WS_WINO) + (size_t)j * 2048 * D, D, kb * 64, nb * 64, scr, lane);
            } else if (it < F5) {
                const int r0 = it - F4, j = r0 / J5, r = r0 % J5, kb = r / 16, nb = r % 16, np = nb * 64 + n4;
                conv_item64(C.a->in[16] + (size_t)j * D * D + np, D, nullptr, WSP(bf16_t, WS_WOO) + (size_t)j * D * D, D, kb * 64, nb * 64, scr, lane);
            } else if (it < F7) {
                const int r0 = it - F5, l = r0 / J7, r = r0 % J7, kb = r / 16, nb = r % 16, np = nb * 64 + n4;
                conv_item64(C.a->in[23] + (size_t)l * D * D + np, D, C.a->in[22] + l * D, WSP(bf16_t, WS_WG) + (size_t)l * D * D, D, kb * 64, nb * 64, scr, lane);
            } else {
                const int r0 = it - F7, l = r0 / J8, r = r0 % J8, kb = r / 16, nb = r % 16, np = nb * 64 + n4;
                conv_item64(C.a->in[24] + (size_t)l * PLE * D + np, D, nullptr, WSP(bf16_t, WS_WP) + (size_t)l * D * PLE, PLE, kb * 64, nb * 64, scr, lane);
            }
        }
    }
    {
        float* H = WSP(float, WS_H); bf16_t* HB = WSP(bf16_t, WS_HB0); float* SS = WSP(float, WS_SSQ0);
        for (int m = gw; m < T; m += NGW) {
            const f32x4* xr = (const f32x4*)(C.a->in[0] + (size_t)m * D) + lane; f32x4* hr = (f32x4*)(H + (size_t)m * D) + lane;
            u32x2* ob = (u32x2*)(HB + (size_t)m * D) + lane; float s = 0.f;
#pragma unroll
            for (int j = 0; j < 4; ++j) { const f32x4 v = xr[64 * j]; hr[64 * j] = v; s += (v.x * v.x + v.y * v.y) + (v.z * v.z + v.w * v.w); u32x2 o; o.x = pk2(v.x, v.y); o.y = pk2(v.z, v.w); ob[64 * j] = o; }
            s = wave_sum(s);
            if (lane < 16) SS[m * 16 + lane] = (lane == 0) ? s : 0.f;
        }
    }
    {
        const size_t n8 = (size_t)DEPTH * T * PLE / 8; const size_t gt = (size_t)C.bid * NTHREADS + C.tid, NGT = (size_t)C.nblk * NTHREADS;
        const f32x4* src = (const f32x4*)C.a->in[1]; u32x4* dst = WSP(u32x4, WS_PB);
        for (size_t i = gt; i < n8; i += NGT) { const f32x4 a = src[2 * i], b = src[2 * i + 1]; u32x4 o; o.x = pk2(a.x, a.y); o.y = pk2(a.z, a.w); o.z = pk2(b.x, b.y); o.w = pk2(b.z, b.w); dst[i] = o; }
    }
    {
        const int gt = C.bid * NTHREADS + C.tid, NGT = C.nblk * NTHREADS; const int* pos = (const int*)C.a->in[2]; float* R = WSP(float, WS_ROPE);
        for (int i = gt; i < T * 16; i += NGT) {
            const int t = i >> 4, f = i & 15;
            const int q = f & 3; double inv = (q == 0) ? 1.0 : (q == 1) ? 0.5623413251903491 : (q == 2) ? 0.31622776601683794 : 0.17782794100389228;
            const int dec = f >> 2; inv *= (dec == 0) ? 1.0 : (dec == 1) ? 0.1 : (dec == 2) ? 0.01 : 0.001;
            const double ang = (double)pos[t] * inv;
            const double n = __builtin_rint(ang * 0.15915494309189535);
            const double r = ang - n * 6.283185307179586, r2 = r * r;
            double sn = r, cs = 1.0, ts = r, tc = 1.0;
#pragma unroll
            for (int k = 1; k <= 13; ++k) { tc *= -r2 / (double)((2 * k - 1) * (2 * k)); cs += tc; ts *= -r2 / (double)((2 * k) * (2 * k + 1)); sn += ts; }
            R[2 * i] = (float)cs; R[2 * i + 1] = (float)sn;
        }
    }
    {
        const int gt = C.bid * NTHREADS + C.tid, NGT = C.nblk * NTHREADS; float* PR = WSP(float, WS_PAR);
        for (int i = gt; i < PAR_N; i += NGT) {
            float v;
            if (i < PAR_VN) v = C.a->in[6][i]; else if (i < PAR_BS) v = C.a->in[13][i - PAR_VN]; else if (i < PAR_FN) v = C.a->in[15][i - PAR_BS]; else v = C.a->in[25][i - PAR_FN];
            PR[i] = v;
        }
    }
    {
        const int gt = C.bid * NTHREADS + C.tid, NGT = C.nblk * NTHREADS; const float* src = C.a->in[14]; bf16_t* dst = WSP(bf16_t, WS_WS);
        for (int i = gt; i < 2 * 8 * 128 * 128; i += NGT) { const int s = i & 127, t = (i >> 7) & 127; dst[i] = (bf16_t)((s <= t) ? f2bf(src[i]) : 0u); }
    }
}

template <class RM, class Epi>
__device__ __forceinline__ void gemm_naive(Ctx& C, int N, int K, const RM& rm, const Epi& epi) {
    LAS float* As = (LAS float*)C.lds;
    LAS float* Bs = As + 32 * 132;
    const int tid = C.tid, ty = tid >> 4, tx = tid & 15;
    const int nct = N / 128, nunits = rm.ntiles128() * nct;
    for (int u = C.bid; u < nunits; u += C.nblk) {
        const int mt = u / nct, nt = u % nct, row0 = mt * 128, col0 = nt * 128;
        const bf16_t* Bt = rm.bt(row0);
        float acc[4][8];
#pragma unroll
        for (int i = 0; i < 4; ++i)
#pragma unroll
            for (int j = 0; j < 8; ++j) acc[i][j] = 0.f;
        const int lr = tid >> 2, kc = (tid & 3) * 8;
        const bf16_t* ap = rm.arow(row0 + lr);
        const bf16_t* bp = Bt + (size_t)(col0 + lr) * K;
        for (int k0 = 0; k0 < K; k0 += 32) {
            float av[8], bv[8];
            if (ap) { const u32x4 w = *(const u32x4*)(ap + k0 + kc); unpack8(w, av); } else {
#pragma unroll
                for (int i = 0; i < 8; ++i) av[i] = 0.f; }
            { const u32x4 w = *(const u32x4*)(bp + k0 + kc); unpack8(w, bv); }
            __syncthreads();
#pragma unroll
            for (int i = 0; i < 8; ++i) { As[(kc + i) * 132 + lr] = av[i]; Bs[(kc + i) * 132 + lr] = bv[i]; }
            __syncthreads();
#pragma unroll 4
            for (int k = 0; k < 32; ++k) {
                const f32x4 a = *(const LAS f32x4*)(As + k * 132 + ty * 4);
                const f32x4 b0 = *(const LAS f32x4*)(Bs + k * 132 + tx * 8), b1 = *(const LAS f32x4*)(Bs + k * 132 + tx * 8 + 4);
                const float aa[4] = {a.x, a.y, a.z, a.w}; const float bb[8] = {b0.x, b0.y, b0.z, b0.w, b1.x, b1.y, b1.z, b1.w};
#pragma unroll
                for (int i = 0; i < 4; ++i)
#pragma unroll
                    for (int j = 0; j < 8; ++j) acc[i][j] += aa[i] * bb[j];
            }
        }
#pragma unroll
        for (int i = 0; i < 4; ++i) {
            const int srow = row0 + ty * 4 + i;
            const typename Epi::Row rw = epi.row(srow);
            float ss = epi(srow, col0 + tx * 8, acc[i], rw);
            ss += __shfl_xor(ss, 1); ss += __shfl_xor(ss, 2); ss += __shfl_xor(ss, 4);
            if ((tx & 7) == 0) epi.rowsum(srow, (col0 + tx * 8) >> 6, ss);
        }
    }
    __syncthreads();
}

struct DenseRM {
    const bf16_t* A; const bf16_t* Bt; int K;
    __device__ __forceinline__ int ntiles128() const { return T / 128; }
    __device__ __forceinline__ const bf16_t* arow(int r) const { return A + (size_t)r * K; }
    __device__ __forceinline__ const bf16_t* bt(int) const { return Bt; }
};
struct MoeTab { LAS int* ebase; LAS int* tile2e; LAS int* ecnt; };
__device__ __forceinline__ MoeTab moe_tables(Ctx& C, int layer) {
    MoeTab mt; mt.ebase = (LAS int*)(C.lds + LDS_MISC - 2048); mt.tile2e = mt.ebase + 64; mt.ecnt = mt.tile2e + 192;
    __syncthreads();
    if (C.tid < 64) {
        const unsigned* cnt = WSP(unsigned, WS_CTL) + CW_CNT + layer * 32 * 64; const int lane = C.tid;
        const int c = (lane < NEXP) ? (int)__hip_atomic_load(cnt + lane * 64, __ATOMIC_RELAXED, __HIP_MEMORY_SCOPE_AGENT) : 0;
        const int nt = (c + 255) >> 8; int incl = nt;
#pragma unroll
        for (int o = 1; o < 32; o <<= 1) { const int v = __shfl_up(incl, o); if (lane >= o) incl += v; }
        const int excl = incl - nt;
        if (lane < NEXP) { mt.ecnt[lane] = c; mt.ebase[lane] = excl; for (int t = 0; t < nt; ++t) mt.tile2e[excl + t] = lane; }
        if (lane == NEXP - 1) mt.ebase[NEXP] = incl;
    }
    __syncthreads();
    return mt;
}
struct MoeRow { int e, pos, tok; };
__device__ __forceinline__ MoeRow moe_row(const MoeTab& mt, const int* list, int srow) {
    MoeRow r; const int t256 = srow >> 8; r.e = mt.tile2e[t256]; r.pos = (t256 - mt.ebase[r.e]) * 256 + (srow & 255);
    r.tok = (r.pos < mt.ecnt[r.e]) ? list[r.e * T + r.pos] : -1; return r;
}
struct MoeGatherRM {
    MoeTab mt; const int* list; const bf16_t* HB; const bf16_t* W;
    __device__ __forceinline__ int ntiles128() const { return mt.ebase[NEXP] * 2; }
    __device__ __forceinline__ const bf16_t* arow(int r) const { const MoeRow m = moe_row(mt, list, r); return m.tok >= 0 ? HB + (size_t)m.tok * D : nullptr; }
    __device__ __forceinline__ const bf16_t* bt(int r0) const { return W + (size_t)mt.tile2e[r0 >> 8] * D * D; }
};
struct MoeDownRM {
    MoeTab mt; const bf16_t* ACT; const bf16_t* W;
    __device__ __forceinline__ int ntiles128() const { return mt.ebase[NEXP] * 2; }
    __device__ __forceinline__ const bf16_t* arow(int r) const { return ACT + (size_t)r * DEXP; }
    __device__ __forceinline__ const bf16_t* bt(int r0) const { return W + (size_t)mt.tile2e[r0 >> 8] * D * DEXP; }
};

__device__ __forceinline__ float rs_from(const float* ss, int n, float inv_n) { float s = 0.f; for (int i = 0; i < n; ++i) s += ss[i]; return rsqrtf(s * inv_n + EPS); }
struct RowS { float s; };
struct EpiE1 {
    const float* ssq_h; bf16_t* P3; bf16_t* CQ; bf16_t* CKV; bf16_t* KPE; float* ssqx; const float* rope;
    typedef RowS Row;
    __device__ __forceinline__ Row row(int r) const { Row w; w.s = rs_from(ssq_h + r * 16, 16, 1.f / D); return w; }
    __device__ __forceinline__ float operator()(int r, int col, const float* v, const Row& w) const {
        float x[8];
#pragma unroll
        for (int i = 0; i < 8; ++i) x[i] = v[i] * w.s;
        float ss = 0.f;
        if (col < 1536) { *(u32x4*)(P3 + (size_t)r * 1536 + col) = pack8(x); }
        else if (col < 1920) { *(u32x4*)(CQ + (size_t)r * QR + (col - 1536)) = pack8(x);
#pragma unroll
            for (int i = 0; i < 8; ++i) ss += x[i] * x[i]; }
        else if (col < 1952) { const int f0 = (col - 1920) >> 1; float o[8];
#pragma unroll
            for (int i = 0; i < 4; ++i) { const float c = rope[(r * 16 + f0 + i) * 2], s = rope[(r * 16 + f0 + i) * 2 + 1]; o[2 * i] = x[2 * i] * c - x[2 * i + 1] * s; o[2 * i + 1] = x[2 * i + 1] * c + x[2 * i] * s; }
            *(u32x4*)(KPE + (size_t)r * 32 + (col - 1920)) = pack8(o); }
        else if (col < 2048) { }
        else { *(u32x4*)(CKV + (size_t)r * KVR + (col - 2048)) = pack8(x);
#pragma unroll
            for (int i = 0; i < 8; ++i) ss += x[i] * x[i]; }
        return ss;
    }
    __device__ __forceinline__ void rowsum(int r, int slot, float ss) const { ssqx[r * 36 + slot] = ss; }
};
struct EpiQ {
    const float* ssqx; bf16_t* Q; const float* rope;
    typedef RowS Row;
    __device__ __forceinline__ Row row(int r) const { Row w; w.s = rs_from(ssqx + r * 36 + 24, 8, 1.f / QR) * QSCALE; return w; }
    __device__ __forceinline__ float operator()(int r, int col, const float* v, const Row& w) const {
        float x[8];
#pragma unroll
        for (int i = 0; i < 8; ++i) x[i] = v[i] * w.s;
        const int dd = col % 96;
        if (dd >= 64) { const int f0 = (dd - 64) >> 1; float o[8];
#pragma unroll
            for (int i = 0; i < 4; ++i) { const float c = rope[(r * 16 + f0 + i) * 2], s = rope[(r * 16 + f0 + i) * 2 + 1]; o[2 * i] = x[2 * i] * c - x[2 * i + 1] * s; o[2 * i + 1] = x[2 * i + 1] * c + x[2 * i] * s; }
            *(u32x4*)(Q + (size_t)r * 768 + col) = pack8(o);
        } else *(u32x4*)(Q + (size_t)r * 768 + col) = pack8(x);
        return 0.f;
    }
    __device__ __forceinline__ void rowsum(int, int, float) const {}
};
struct EpiKV {
    const float* ssqx; bf16_t* KV;
    typedef RowS Row;
    __device__ __forceinline__ Row row(int r) const { Row w; w.s = rs_from(ssqx + r * 36 + 32, 4, 1.f / KVR); return w; }
    __device__ __forceinline__ float operator()(int r, int col, const float* v, const Row& w) const {
        float x[8];
#pragma unroll
        for (int i = 0; i < 8; ++i) x[i] = v[i] * w.s;
        *(u32x4*)(KV + (size_t)r * 1024 + col) = pack8(x); return 0.f;
    }
    __device__ __forceinline__ void rowsum(int, int, float) const {}
};
struct EpiRes {
    const float* Hr; float* H; bf16_t* HB; float* ssq;
    typedef RowS Row;
    __device__ __forceinline__ Row row(int) const { Row w; w.s = 1.f; return w; }
    __device__ __forceinline__ float operator()(int r, int col, const float* v, const Row&) const {
        const f32x4* hr_ = (const f32x4*)(Hr + (size_t)r * D + col); f32x4* hp = (f32x4*)(H + (size_t)r * D + col); const f32x4 a = hr_[0], b = hr_[1];
        float x[8] = {a.x + v[0], a.y + v[1], a.z + v[2], a.w + v[3], b.x + v[4], b.y + v[5], b.z + v[6], b.w + v[7]};
        hp[0] = (f32x4){x[0], x[1], x[2], x[3]}; hp[1] = (f32x4){x[4], x[5], x[6], x[7]};
        *(u32x4*)(HB + (size_t)r * D + col) = pack8(x);
        float ss = 0.f;
#pragma unroll
        for (int i = 0; i < 8; ++i) ss += x[i] * x[i];
        return ss;
    }
    __device__ __forceinline__ void rowsum(int r, int slot, float ss) const { ssq[r * 16 + slot] = ss; }
};
struct EpiGelu {
    const float* ssq_h; bf16_t* Z; float* ssqx;
    typedef RowS Row;
    __device__ __forceinline__ Row row(int r) const { Row w; w.s = rs_from(ssq_h + r * 16, 16, 1.f / D); return w; }
    __device__ __forceinline__ float operator()(int r, int col, const float* v, const Row& w) const {
        float x[8]; float ss = 0.f;
#pragma unroll
        for (int i = 0; i < 8; ++i) { x[i] = gelu_tanh(v[i] * w.s); ss += x[i] * x[i]; }
        *(u32x4*)(Z + (size_t)r * 2048 + col) = pack8(x);
        return col >= 1024 ? ss : 0.f;
    }
    __device__ __forceinline__ void rowsum(int r, int slot, float ss) const { ssqx[r * 36 + slot] = ss; }
};
struct RowM { float s; int ok; };
struct EpiGU {
    MoeTab mt; const int* list; const float* rffn; bf16_t* ACT;
    typedef RowM Row;
    __device__ __forceinline__ Row row(int r) const { const MoeRow m = moe_row(mt, list, r); Row w; w.ok = m.tok >= 0; w.s = w.ok ? rffn[m.tok] : 0.f; return w; }
    __device__ __forceinline__ float operator()(int r, int col, const float* v, const Row& w) const {
        float a[4];
#pragma unroll
        for (int i = 0; i < 4; ++i) { const float g = v[i] * w.s, u = v[4 + i] * w.s; a[i] = g * sigmoidf_(g) * u; }
        u32x2 o; o.x = pk2(a[0], a[1]); o.y = pk2(a[2], a[3]);
        *(u32x2*)(ACT + (size_t)r * DEXP + (col >> 1)) = o;
        return 0.f;
    }
    __device__ __forceinline__ void rowsum(int, int, float) const {}
};
struct EpiDown {
    MoeTab mt; const int* list; const float* lw; bf16_t* Y;
    typedef RowM Row;
    __device__ __forceinline__ Row row(int r) const { const MoeRow m = moe_row(mt, list, r); Row w; w.ok = m.tok >= 0; w.s = w.ok ? lw[m.e * T + m.pos] : 0.f; return w; }
    __device__ __forceinline__ float operator()(int r, int col, const float* v, const Row& w) const {
        if (w.ok) { float x[8];
#pragma unroll
            for (int i = 0; i < 8; ++i) x[i] = v[i] * w.s;
            *(u32x4*)(Y + (size_t)r * D + col) = pack8(x); }
        return 0.f;
    }
    __device__ __forceinline__ void rowsum(int, int, float) const {}
};
struct EpiPP {
    bf16_t* PP;
    typedef RowS Row;
    __device__ __forceinline__ Row row(int) const { Row w; w.s = 1.f; return w; }
    __device__ __forceinline__ float operator()(int r, int col, const float* v, const Row&) const { *(u32x4*)(PP + (size_t)r * D + col) = pack8(v); return 0.f; }
    __device__ __forceinline__ void rowsum(int, int, float) const {}
};
struct EpiPLE {
    const float* ssq_in; const bf16_t* PP; const float* Hr; float* H; bf16_t* HB; float* ssq;
    typedef RowS Row;
    __device__ __forceinline__ Row row(int r) const { Row w; w.s = rs_from(ssq_in + r * 16, 16, 1.f / D); return w; }
    __device__ __forceinline__ float operator()(int r, int col, const float* v, const Row& w) const {
        float pp[8]; unpack8(*(const u32x4*)(PP + (size_t)r * D + col), pp);
        const f32x4* hr_ = (const f32x4*)(Hr + (size_t)r * D + col); f32x4* hp = (f32x4*)(H + (size_t)r * D + col); const f32x4 a = hr_[0], b = hr_[1];
        const float h0[8] = {a.x, a.y, a.z, a.w, b.x, b.y, b.z, b.w};
        float x[8]; float ss = 0.f;
#pragma unroll
        for (int i = 0; i < 8; ++i) { x[i] = h0[i] + sigmoidf_(v[i] * w.s) * pp[i]; ss += x[i] * x[i]; }
        hp[0] = (f32x4){x[0], x[1], x[2], x[3]}; hp[1] = (f32x4){x[4], x[5], x[6], x[7]};
        *(u32x4*)(HB + (size_t)r * D + col) = pack8(x);
        return ss;
    }
    __device__ __forceinline__ void rowsum(int r, int slot, float ss) const { ssq[r * 16 + slot] = ss; }
};


namespace pg8 {
constexpr int BM = 256, BK = 64, HALF = 128, HTB = HALF * BK * 2, STAGE_BYTES = 8 * HTB, NXCD = 8, WGM = 8;
__host__ __device__ __forceinline__ int lds_byte(int r, int c) { const int st = (r >> 4) * 2 + (c >> 5), rr = r & 15, cc = c & 31, ob = rr * 64 + cc * 2; return st * 1024 + (ob ^ (((ob >> 9) & 1) << 5)); }
__host__ __device__ __forceinline__ void stage_rc(int b, int& R, int& C) { const int st = b / 1024, sb = b % 1024, swz = sb ^ (((sb >> 9) & 1) << 5); R = (st >> 1) * 16 + swz / 64; C = (st & 1) * 32 + (swz % 64) / 2; }
__host__ __device__ __forceinline__ int perm32(int rho) { const int n = rho >> 4, i = rho & 15; return 8 * (i >> 2) + 4 * n + (i & 3); }
struct Unit { int pm, pn; };
struct StaticOrder {
    int nM, nN, nwg, G, c;
    __device__ void init(int M, int N, int G_, int c_) { nM = M / BM; nN = N / BM; nwg = nM * nN; G = G_; c = c_; }
    __device__ bool next(int i, Unit& u) const {
        const long L = (long)i * G + c; if (L >= nwg) return false;
        int wgid = (int)L; { const int q = nwg / NXCD, r = nwg % NXCD, xcd = wgid % NXCD, off = wgid / NXCD; wgid = (xcd < r ? xcd * (q + 1) : r * (q + 1) + (xcd - r) * q) + off; }
        const int nig = WGM * nN, gid = wgid / nig, fm = gid * WGM, gsz = (nM - fm) < WGM ? (nM - fm) : WGM;
        u.pm = fm + ((wgid % nig) % gsz); u.pn = (wgid % nig) / gsz; return true;
    }
};
struct MoeOrder {
    int ntile, G, c;
    __device__ bool next(int i, Unit& u) const { const int L = i * G + c; if (L >= ntile * 4) return false; u.pm = L >> 2; u.pn = L & 3; return true; }
};
template <class Prob, class Epi, class Sched>
__device__ __forceinline__ void gemm_phase(LAS unsigned char* lds, int tid, const Prob& P, const Sched& S, const Epi& E) {
    constexpr bool GATHER = Prob::GATHER;
    const int wid = __builtin_amdgcn_readfirstlane(tid >> 6), lane = tid & 63, wr = wid >> 2, wc = wid & 3, fr = lane & 15, fq = lane >> 4;
    const int K = P.K, nt = K / BK;
    unsigned voffA[2], voffB[2]; int RA[2], CA2[2];
#pragma unroll
    for (int i = 0; i < 2; ++i) { int R, C; stage_rc(tid * 16 + i * 8192, R, C); const int Rb = (R & ~31) + perm32(R & 31);
        voffA[i] = (unsigned)(R * K + C) * 2u; voffB[i] = (unsigned)(Rb * K + C) * 2u; RA[i] = R; CA2[i] = C * 2; }
    const size_t kstep = (size_t)(BK * 2);
    const size_t hstep = (size_t)HALF * K * 2;
    const unsigned ldsw = (unsigned)wid * 1024u;
    const int aoff = lds_byte(wr * 64 + fr, fq * 8), boff = lds_byte(wc * 32 + fr, fq * 8);
#define PG8_SA(b, h) (((b) * 2 + (h)) * HTB)
#define PG8_SB(b, h) ((4 + (b) * 2 + (h)) * HTB)
#define PG8_STAGE2(bufoff, gbase, v0, v1) do { \
        __builtin_amdgcn_global_load_lds((const unsigned*)((const char*)(gbase) + (v0)), (LAS unsigned*)(lds + (bufoff) + ldsw), 16, 0, 0); \
        __builtin_amdgcn_global_load_lds((const unsigned*)((const char*)(gbase) + (v1)), (LAS unsigned*)(lds + (bufoff) + ldsw + 8192), 16, 0, 0); } while (0)
#define PG8_STAGE_B(bufoff, gbase) PG8_STAGE2(bufoff, gbase, voffB[0], voffB[1])
#define PG8_STAGE_A(bufoff, gbase, h, nx) do { if constexpr (GATHER) { PG8_STAGE2(bufoff, gbase, (nx) ? nvA[h][0] : cvA[h][0], (nx) ? nvA[h][1] : cvA[h][1]); } \
        else { PG8_STAGE2(bufoff, (gbase) + (h) * hstep, voffA[0], voffA[1]); } } while (0)
#define PG8_LDA(dst, b, h) do { _Pragma("unroll") for (int m = 0; m < 4; ++m) _Pragma("unroll") for (int k = 0; k < 2; ++k) dst[m][k] = *(const LAS bf16x8*)(lds + PG8_SA(b, h) + aoff + m * 2048 + k * 1024); } while (0)
#define PG8_LDB(dst, b, h) do { _Pragma("unroll") for (int n = 0; n < 2; ++n) _Pragma("unroll") for (int k = 0; k < 2; ++k) dst[n][k] = *(const LAS bf16x8*)(lds + PG8_SB(b, h) + boff + n * 2048 + k * 1024); } while (0)
#define PG8_MMA(ai, bj, At, Bt) do { __builtin_amdgcn_s_setprio(1); _Pragma("unroll") for (int m = 0; m < 4; ++m) _Pragma("unroll") for (int n = 0; n < 2; ++n) _Pragma("unroll") for (int k = 0; k < 2; ++k) \
        acc[ai][bj][m][n] = __builtin_amdgcn_mfma_f32_16x16x32_bf16(Bt[n][k], At[m][k], acc[ai][bj][m][n], 0, 0, 0); __builtin_amdgcn_s_setprio(0); } while (0)
#define PG8_WAIT_V(n) asm volatile("s_waitcnt vmcnt(" #n ")" ::: "memory")
#define PG8_WAIT_L(n) asm volatile("s_waitcnt lgkmcnt(" #n ")" ::: "memory")
#define PG8_BAR __builtin_amdgcn_s_barrier()
#define PG8_SCHED __builtin_amdgcn_sched_barrier(0)
    Unit cur, nxt; int ui = 0;
    if (!S.next(0, cur)) return;
    f32x4 acc[2][2][4][2];
#pragma unroll
    for (int a = 0; a < 2; ++a)
#pragma unroll
        for (int b = 0; b < 2; ++b)
#pragma unroll
            for (int m = 0; m < 4; ++m)
#pragma unroll
                for (int n = 0; n < 2; ++n) acc[a][b][m][n] = (f32x4){0.f, 0.f, 0.f, 0.f};
    bf16x8 At[4][2], B0[2][2], B1[2][2];
    unsigned cvA[2][2], nvA[2][2];
    if constexpr (GATHER) {
#pragma unroll
        for (int h = 0; h < 2; ++h)
#pragma unroll
            for (int i = 0; i < 2; ++i) { cvA[h][i] = P.arow_off(cur, h * HALF + RA[i]) + (unsigned)CA2[i]; nvA[h][i] = cvA[h][i]; }
    } else { cvA[0][0] = cvA[0][1] = cvA[1][0] = cvA[1][1] = 0u; nvA[0][0] = nvA[0][1] = nvA[1][0] = nvA[1][1] = 0u; }
    const char* cA = P.abase(cur); const char* cB = P.bbase(cur);
    PG8_STAGE_B(PG8_SB(0, 0), cB); PG8_STAGE_B(PG8_SB(0, 1), cB + hstep); PG8_STAGE_A(PG8_SA(0, 0), cA, 0, false); PG8_STAGE_A(PG8_SA(0, 1), cA, 1, false);
    if (wr == 1) PG8_BAR;
    PG8_WAIT_V(2); PG8_BAR;
    PG8_STAGE_B(PG8_SB(1, 0), cB + kstep); PG8_STAGE_A(PG8_SA(1, 0), cA + kstep, 0, false); PG8_STAGE_B(PG8_SB(1, 1), cB + hstep + kstep);
    PG8_WAIT_V(6); PG8_BAR;
    for (;;) {
        const bool has_next = S.next(ui + 1, nxt);
        const char* nA = has_next ? P.abase(nxt) : cA; const char* nB = has_next ? P.bbase(nxt) : cB;
        if constexpr (GATHER) {
            if (has_next) {
#pragma unroll
                for (int h = 0; h < 2; ++h)
#pragma unroll
                    for (int i = 0; i < 2; ++i) nvA[h][i] = P.arow_off(nxt, h * HALF + RA[i]) + (unsigned)CA2[i];
            }
        }
        for (int t = 0; t < nt; t += 2) {
            const bool last = (t == nt - 2);
            const char* a1 = cA + (size_t)(t + 1) * kstep;
            const char* a2 = last ? nA : cA + (size_t)(t + 2) * kstep; const char* b2 = last ? nB : cB + (size_t)(t + 2) * kstep;
            const char* a3 = a2 + kstep; const char* b3 = b2 + kstep;
            PG8_LDB(B0, 0, 0); PG8_LDB(B1, 0, 1); PG8_SCHED; PG8_LDA(At, 0, 0); PG8_STAGE_A(PG8_SA(1, 1), a1, 1, false);
            PG8_WAIT_V(8); PG8_WAIT_L(0); PG8_BAR; PG8_MMA(0, 0, At, B0); PG8_MMA(0, 1, At, B1); PG8_BAR; PG8_SCHED;
            PG8_LDA(At, 0, 1); PG8_STAGE_B(PG8_SB(0, 0), b2); PG8_STAGE_B(PG8_SB(0, 1), b2 + hstep); PG8_STAGE_A(PG8_SA(0, 0), a2, 0, last);
            PG8_WAIT_V(8); PG8_WAIT_L(0); PG8_BAR; PG8_MMA(1, 0, At, B0); PG8_MMA(1, 1, At, B1); PG8_BAR; PG8_SCHED;
            PG8_LDB(B0, 1, 0); PG8_LDB(B1, 1, 1); PG8_SCHED; PG8_LDA(At, 1, 0); PG8_STAGE_A(PG8_SA(0, 1), a2, 1, last);
            PG8_WAIT_V(8); PG8_WAIT_L(0); PG8_BAR; PG8_MMA(0, 0, At, B0); PG8_MMA(0, 1, At, B1); PG8_BAR; PG8_SCHED;
            PG8_LDA(At, 1, 1); PG8_STAGE_B(PG8_SB(1, 0), b3); PG8_STAGE_B(PG8_SB(1, 1), b3 + hstep); PG8_STAGE_A(PG8_SA(1, 0), a3, 0, last);
            PG8_WAIT_V(8); PG8_WAIT_L(0); PG8_BAR; PG8_MMA(1, 0, At, B0); PG8_MMA(1, 1, At, B1); PG8_BAR; PG8_SCHED;
        }
        if (wr == 0) PG8_BAR;
        { int fr_e = fr, fq_e = fq; asm volatile("" : "+v"(fr_e), "+v"(fq_e));
          E(acc, cur, wr, wc, fr_e, fq_e); }
        if (!has_next) break;
#pragma unroll
        for (int a = 0; a < 2; ++a)
#pragma unroll
            for (int b = 0; b < 2; ++b)
#pragma unroll
                for (int m = 0; m < 4; ++m)
#pragma unroll
                    for (int n = 0; n < 2; ++n) acc[a][b][m][n] = (f32x4){0.f, 0.f, 0.f, 0.f};
        cur = nxt; cA = nA; cB = nB; ++ui;
        if constexpr (GATHER) {
#pragma unroll
            for (int h = 0; h < 2; ++h)
#pragma unroll
                for (int i = 0; i < 2; ++i) cvA[h][i] = nvA[h][i];
        }
        if (wr == 1) PG8_BAR;
    }
    PG8_WAIT_V(0);
    PG8_BAR;
#undef PG8_SA
#undef PG8_SB
#undef PG8_STAGE2
#undef PG8_STAGE_A
#undef PG8_STAGE_B
#undef PG8_LDA
#undef PG8_LDB
#undef PG8_MMA
#undef PG8_WAIT_V
#undef PG8_WAIT_L
#undef PG8_BAR
#undef PG8_SCHED
}
template <class E> struct EpiAdapt {
    E e;
    __device__ __forceinline__ void operator()(const f32x4 (&acc)[2][2][4][2], const Unit& u, int wr, int wc, int fr, int fq) const {
#pragma unroll
        for (int ai = 0; ai < 2; ++ai)
#pragma unroll
            for (int m = 0; m < 4; ++m) {
                const int row = u.pm * BM + ai * HALF + wr * 64 + m * 16 + fr;
                const typename E::Row rw = e.row(row);
                float ss = 0.f;
#pragma unroll
                for (int bj = 0; bj < 2; ++bj) {
                    const int col = u.pn * BM + bj * HALF + wc * 32 + fq * 8;
                    const f32x4 a0 = acc[ai][bj][m][0], a1 = acc[ai][bj][m][1];
                    const float v[8] = {a0[0], a0[1], a0[2], a0[3], a1[0], a1[1], a1[2], a1[3]};
                    ss += e(row, col, v, rw);
                }
                ss += __shfl_xor(ss, 16); ss += __shfl_xor(ss, 32);
                if (fq == 0) e.rowsum(row, u.pn * 4 + wc, ss);
            }
    }
};
struct DenseProb {
    static constexpr bool GATHER = false;
    const bf16_t* A; const bf16_t* Bt; int K;
    __device__ __forceinline__ const char* abase(const Unit& u) const { return (const char*)A + (size_t)u.pm * BM * K * 2; }
    __device__ __forceinline__ unsigned arow_off(const Unit&, int) const { return 0u; }
    __device__ __forceinline__ const char* bbase(const Unit& u) const { return (const char*)Bt + (size_t)u.pn * BM * K * 2; }
};
}
struct MoeGatherProb {
    static constexpr bool GATHER = true;
    MoeTab mt; const int* list; const bf16_t* HB; const bf16_t* W; int K;
    __device__ __forceinline__ const char* abase(const pg8::Unit&) const { return (const char*)HB; }
    __device__ __forceinline__ unsigned arow_off(const pg8::Unit& u, int r) const { const MoeRow m = moe_row(mt, list, u.pm * 256 + r); return (unsigned)(m.tok >= 0 ? m.tok : 0) * (unsigned)(D * 2); }
    __device__ __forceinline__ const char* bbase(const pg8::Unit& u) const { return (const char*)W + ((size_t)mt.tile2e[u.pm] * D + (size_t)u.pn * 256) * D * 2; }
};
struct MoeDownProb {
    static constexpr bool GATHER = false;
    MoeTab mt; const bf16_t* ACT; const bf16_t* W; int K;
    __device__ __forceinline__ const char* abase(const pg8::Unit& u) const { return (const char*)ACT + (size_t)u.pm * 256 * DEXP * 2; }
    __device__ __forceinline__ unsigned arow_off(const pg8::Unit&, int) const { return 0u; }
    __device__ __forceinline__ const char* bbase(const pg8::Unit& u) const { return (const char*)W + ((size_t)mt.tile2e[u.pm] * D + (size_t)u.pn * 256) * DEXP * 2; }
};
template <class E> __device__ __forceinline__ void gemm_dense(Ctx& C, const bf16_t* A, const bf16_t* Bt, int N, int K, const E& e) {
    pg8::DenseProb P{A, Bt, K}; pg8::StaticOrder S; S.init(T, N, C.nblk, C.bid); pg8::EpiAdapt<E> ea{e};
    pg8::gemm_phase(C.lds, C.tid, P, S, ea);
}

__device__ __forceinline__ void phase_conv(Ctx& C, int j) {
    const bf16_t* P3 = WSP(bf16_t, WS_P3); bf16_t* MIX = WSP(bf16_t, WS_MIX); const float* cw = WSP(float, WS_PAR) + PAR_CONV + (size_t)j * 3 * 512;
    const int gt = C.bid * NTHREADS + C.tid, NGT = C.nblk * NTHREADS;
    for (int i = gt; i < T * 64; i += NGT) {
        const int t = i >> 6, c = (i & 63) * 8, s = t & (SEQ - 1);
        float acc[8];
#pragma unroll
        for (int q = 0; q < 8; ++q) acc[q] = 0.f;
#pragma unroll
        for (int k = 0; k < 3; ++k) {
            const int dt = 2 - k;
            if (s - dt >= 0) {
                float xc[8], gc[8]; unpack8(*(const u32x4*)(P3 + (size_t)(t - dt) * 1536 + c), xc); unpack8(*(const u32x4*)(P3 + (size_t)(t - dt) * 1536 + 1024 + c), gc);
#pragma unroll
                for (int q = 0; q < 8; ++q) acc[q] += cw[k * 512 + c + q] * (gc[q] * xc[q]);
            }
        }
        float gb[8]; unpack8(*(const u32x4*)(P3 + (size_t)t * 1536 + 512 + c), gb);
#pragma unroll
        for (int q = 0; q < 8; ++q) acc[q] *= gb[q];
        *(u32x4*)(MIX + (size_t)t * D + c) = pack8(acc);
    }
}

__device__ __forceinline__ void phase_attn_naive(Ctx& C) {
    const bf16_t* Q = WSP(bf16_t, WS_Q); const bf16_t* KV = WSP(bf16_t, WS_KV); const bf16_t* KPE = WSP(bf16_t, WS_KPE); bf16_t* MIX = WSP(bf16_t, WS_MIX);
    LAS float* Ks = (LAS float*)C.lds;
    LAS float* Vs = Ks + 64 * 97;
    LAS float* Qs = Vs + 64 * 64;
    LAS float* Ps = Qs + 64 * 96;
    const int tid = C.tid, lane = C.lane, wave = C.wave;
    const int nunits = NBATCH * NH * (SEQ / 64);
    for (int u = C.bid; u < nunits; u += C.nblk) {
        const int qb = (SEQ / 64 - 1) - (u / (NBATCH * NH)), bh = u % (NBATCH * NH), b = bh / NH, h = bh % NH;
        const int t0 = b * SEQ + qb * 64;
        __syncthreads();
        for (int i = tid; i < 64 * 12; i += NTHREADS) { const int r = i / 12, c8 = (i % 12) * 8; float v[8]; unpack8(*(const u32x4*)(Q + (size_t)(t0 + r) * 768 + h * 96 + c8), v);
#pragma unroll
            for (int q = 0; q < 8; ++q) Qs[r * 96 + c8 + q] = v[q]; }
        float m[8], l[8], o[8];
#pragma unroll
        for (int i = 0; i < 8; ++i) { m[i] = -1e30f; l[i] = 0.f; o[i] = 0.f; }
        for (int kt = 0; kt <= qb; ++kt) {
            const int k0 = b * SEQ + kt * 64;
            __syncthreads();
            for (int i = tid; i < 64 * 20; i += NTHREADS) { const int r = i / 20, c = i % 20; float v[8];
                if (c < 8) { unpack8(*(const u32x4*)(KV + (size_t)(k0 + r) * 1024 + h * 128 + c * 8), v);
#pragma unroll
                    for (int q = 0; q < 8; ++q) Ks[r * 97 + c * 8 + q] = v[q]; }
                else if (c < 12) { unpack8(*(const u32x4*)(KPE + (size_t)(k0 + r) * 32 + (c - 8) * 8), v);
#pragma unroll
                    for (int q = 0; q < 8; ++q) Ks[r * 97 + c * 8 + q] = v[q]; }
                else { unpack8(*(const u32x4*)(KV + (size_t)(k0 + r) * 1024 + h * 128 + 64 + (c - 12) * 8), v);
#pragma unroll
                    for (int q = 0; q < 8; ++q) Vs[r * 64 + (c - 12) * 8 + q] = v[q]; } }
            __syncthreads();
#pragma unroll
            for (int qi = 0; qi < 8; ++qi) {
                const int qr = wave * 8 + qi;
                float s = 0.f;
                for (int d = 0; d < 96; ++d) s += Qs[qr * 96 + d] * Ks[lane * 97 + d];
                if (kt == qb && lane > qr) s = -1e30f;
                const float mn = fmaxf(m[qi], wave_max(s));
                const float p = exp2f(s - mn), al = exp2f(m[qi] - mn);
                const float pb = rbf(p);
                l[qi] = l[qi] * al + wave_sum(p); m[qi] = mn;
                Ps[wave * 64 + lane] = pb;
                asm volatile("s_waitcnt lgkmcnt(0)" ::: "memory");
                float acc = 0.f;
                for (int k = 0; k < 64; ++k) acc += Ps[wave * 64 + k] * Vs[k * 64 + lane];
                o[qi] = o[qi] * al + acc;
                asm volatile("s_waitcnt lgkmcnt(0)" ::: "memory");
            }
        }
#pragma unroll
        for (int qi = 0; qi < 8; ++qi) MIX[(size_t)(t0 + wave * 8 + qi) * D + 512 + h * 64 + lane] = (bf16_t)f2bf(o[qi] / l[qi]);
    }
    __syncthreads();
}


typedef float f32x16 __attribute__((ext_vector_type(16)));
typedef short s16x4 __attribute__((ext_vector_type(4)));
typedef short v4i16_t __attribute__((ext_vector_type(4)));
__device__ __forceinline__ int crow(int r, int hi) { return (r & 3) + 8 * (r >> 2) + 4 * hi; }
__device__ __forceinline__ s16x4 vtr(const LAS unsigned char* p) { return __builtin_bit_cast(s16x4, __builtin_amdgcn_ds_read_tr16_b64_v4i16((LAS v4i16_t*)p)); }
#ifndef ATT_THR
#define ATT_THR 5.0f
#endif
__device__ __forceinline__ void phase_attn(Ctx& C) {
    const bf16_t* Q = WSP(bf16_t, WS_Q); const bf16_t* KV = WSP(bf16_t, WS_KV); const bf16_t* KPE = WSP(bf16_t, WS_KPE); bf16_t* MIX = WSP(bf16_t, WS_MIX);
    constexpr int KROW = 208, KBUF = 64 * KROW, VBUF = 8192, OFF_K = 0, OFF_V = 2 * KBUF, OFF_WS = OFF_V + 2 * VBUF, OFF_OST = OFF_WS + 8 * 128;
    LAS unsigned char* lds = C.lds;
    const int tid = C.tid, lane = C.lane, wave = C.wave, r32 = lane & 31, hi = lane >> 5;
    LAS float* wsf = (LAS float*)(lds + OFF_WS + wave * 128);
    LAS unsigned char* ost = lds + OFF_OST + wave * 4096;
    const int krow = tid >> 3, kch = tid & 7, prow = tid >> 2, pch = tid & 3;
    const int kdst = krow * KROW + kch * 16, vdst = (kch >> 2) * 4096 + krow * 64 + (kch & 3) * 16, pdst = prow * KROW + 128 + pch * 16;
    const int kfrag = r32 * KROW + hi * 16;
    const int vfrag = ((lane >> 4) & 1) * 32 + (lane & 3) * 8 + (4 * hi + ((lane & 15) >> 2)) * 64;
    for (int pr = C.bid; pr < 256; pr += C.nblk) {
        for (int half = 0; half < 2; ++half) {
            const int bh = pr >> 3, qq = pr & 7, qb = half == 0 ? 15 - qq : qq, b = bh >> 3, h = bh & 7;
            const int tb = b * SEQ, t0 = tb + qb * 256, NT = 4 * qb + 4;
            bf16x8 qf[6];
            { const bf16_t* qp = Q + (size_t)(t0 + wave * 32 + r32) * 768 + h * 96 + hi * 8;
#pragma unroll
              for (int s = 0; s < 6; ++s) qf[s] = *(const bf16x8*)(qp + 16 * s); }
            f32x16 o0, o1;
#pragma unroll
            for (int r = 0; r < 16; ++r) { o0[r] = 0.f; o1[r] = 0.f; }
            float mref = -1e30f, lsum = 0.f;
            const bf16_t* ksrc = KV + (size_t)(tb + krow) * 1024 + h * 128 + kch * 8;
            const bf16_t* vsrc = ksrc + 64;
            const bf16_t* psrc = KPE + (size_t)(tb + prow) * 32 + pch * 8;
            u32x4 kreg, vreg, preg;
            kreg = *(const u32x4*)ksrc; vreg = *(const u32x4*)vsrc; preg = (tid < 256) ? *(const u32x4*)psrc : (u32x4){0u, 0u, 0u, 0u};
            __syncthreads();
            *(LAS u32x4*)(lds + OFF_K + kdst) = kreg; *(LAS u32x4*)(lds + OFF_V + vdst) = vreg; if (tid < 256) *(LAS u32x4*)(lds + OFF_K + pdst) = preg;
            __syncthreads();
            const int qmin = qb * 256 + wave * 32;
            for (int t = 0; t < NT; ++t) {
                const int cur = t & 1;
                if (t + 1 < NT) { const size_t adv = (size_t)(t + 1) * 64; kreg = *(const u32x4*)(ksrc + adv * 1024); vreg = *(const u32x4*)(vsrc + adv * 1024); if (tid < 256) preg = *(const u32x4*)(psrc + adv * 32); }
                const int kmin = 64 * t;
                if (kmin <= qmin + 31) {
                    f32x16 p0, p1;
#pragma unroll
                    for (int r = 0; r < 16; ++r) { p0[r] = 0.f; p1[r] = 0.f; }
                    const LAS unsigned char* kb = lds + OFF_K + cur * KBUF + kfrag;
#pragma unroll
                    for (int s = 0; s < 6; ++s) {
                        const bf16x8 k0 = *(const LAS bf16x8*)(kb + s * 32), k1 = *(const LAS bf16x8*)(kb + 32 * KROW + s * 32);
                        p0 = __builtin_amdgcn_mfma_f32_32x32x16_bf16(k0, qf[s], p0, 0, 0, 0);
                        p1 = __builtin_amdgcn_mfma_f32_32x32x16_bf16(k1, qf[s], p1, 0, 0, 0);
                    }
                    if (kmin + 63 > qmin) {
                        const int qd = qmin + r32 - kmin;
#pragma unroll
                        for (int r = 0; r < 16; ++r) { const int kv = crow(r, hi); if (kv > qd) p0[r] = -1e30f; if (kv + 32 > qd) p1[r] = -1e30f; }
                    }
                    float rm = fmaxf(p0[0], p1[0]);
#pragma unroll
                    for (int r = 1; r < 16; ++r) rm = fmaxf(rm, fmaxf(p0[r], p1[r]));
                    rm = fmaxf(rm, __shfl_xor(rm, 32));
                    if (__any(rm > mref + ATT_THR)) {
                        const float mnew = fmaxf(mref, rm), f = __builtin_amdgcn_exp2f(mref - mnew);
                        lsum *= f; mref = mnew;
                        if (hi == 0) wsf[r32] = f;
                        asm volatile("s_waitcnt lgkmcnt(0)" ::: "memory");
#pragma unroll
                        for (int r = 0; r < 16; ++r) { const float fr = wsf[crow(r, hi)]; o0[r] *= fr; o1[r] *= fr; }
                        asm volatile("s_waitcnt lgkmcnt(0)" ::: "memory");
                    }
#pragma unroll
                    for (int r = 0; r < 16; ++r) { p0[r] = __builtin_amdgcn_exp2f(p0[r] - mref); p1[r] = __builtin_amdgcn_exp2f(p1[r] - mref); lsum += p0[r] + p1[r]; }
                    u32x4 pw[4];
#pragma unroll
                    for (int i = 0; i < 4; ++i) { pw[0][i] = pk2(p0[2 * i], p0[2 * i + 1]); pw[1][i] = pk2(p0[8 + 2 * i], p0[9 + 2 * i]); pw[2][i] = pk2(p1[2 * i], p1[2 * i + 1]); pw[3][i] = pk2(p1[8 + 2 * i], p1[9 + 2 * i]); }
                    const LAS unsigned char* vb = lds + OFF_V + cur * VBUF + vfrag;
#pragma unroll
                    for (int ks = 0; ks < 4; ++ks) {
                        const s16x4 a0 = vtr(vb + ks * 1024), a1 = vtr(vb + ks * 1024 + 512), b0 = vtr(vb + 4096 + ks * 1024), b1 = vtr(vb + 4096 + ks * 1024 + 512);
                        const bf16x8 v0 = (bf16x8){a0[0], a0[1], a0[2], a0[3], a1[0], a1[1], a1[2], a1[3]}, v1 = (bf16x8){b0[0], b0[1], b0[2], b0[3], b1[0], b1[1], b1[2], b1[3]};
                        const bf16x8 pa = __builtin_bit_cast(bf16x8, pw[ks]);
                        o0 = __builtin_amdgcn_mfma_f32_32x32x16_bf16(pa, v0, o0, 0, 0, 0);
                        o1 = __builtin_amdgcn_mfma_f32_32x32x16_bf16(pa, v1, o1, 0, 0, 0);
                    }
                }
                if (t + 1 < NT) { const int nb = cur ^ 1; *(LAS u32x4*)(lds + OFF_K + nb * KBUF + kdst) = kreg; *(LAS u32x4*)(lds + OFF_V + nb * VBUF + vdst) = vreg; if (tid < 256) *(LAS u32x4*)(lds + OFF_K + nb * KBUF + pdst) = preg; }
                __syncthreads();
            }
            const float ltot = lsum + __shfl_xor(lsum, 32);
            if (hi == 0) wsf[r32] = 1.0f / ltot;
            asm volatile("s_waitcnt lgkmcnt(0)" ::: "memory");
#pragma unroll
            for (int r = 0; r < 16; ++r) { const int q = crow(r, hi); const float fr = wsf[q];
                *(LAS bf16_t*)(ost + q * 128 + r32 * 2) = (bf16_t)f2bf(o0[r] * fr); *(LAS bf16_t*)(ost + q * 128 + 64 + r32 * 2) = (bf16_t)f2bf(o1[r] * fr); }
            asm volatile("s_waitcnt lgkmcnt(0)" ::: "memory");
#pragma unroll
            for (int i = 0; i < 4; ++i) { const int idx = i * 64 + lane, q = idx >> 3, c = idx & 7;
                const u32x4 w = *(const LAS u32x4*)(ost + q * 128 + c * 16);
                *(u32x4*)(MIX + (size_t)(t0 + wave * 32 + q) * D + 512 + h * 64 + c * 8) = w; }
        }
    }
    __syncthreads();
}


__device__ __forceinline__ void phase_sg(Ctx& C, int j) {
    const bf16_t* Z = WSP(bf16_t, WS_Z); const float* ssqx = WSP(float, WS_SSQX); const bf16_t* WS = WSP(bf16_t, WS_WS) + (size_t)j * 8 * 128 * 128; bf16_t* MIX = WSP(bf16_t, WS_MIX);
    const float* vg = WSP(float, WS_PAR) + PAR_VN + j * D; const float* bs = WSP(float, WS_PAR) + PAR_BS + (size_t)j * 8 * 128;
    LAS unsigned char* lds = C.lds;
    const int tid = C.tid, lane = C.lane, wave = C.wave, r32 = lane & 31, hi = lane >> 5, wr = wave >> 1, wc = wave & 1;
    const int srow = tid >> 2, sblk = tid & 3;
    const int vfrag = ((lane >> 4) & 1) * 32 + (lane & 3) * 8 + (8 * hi + ((lane & 15) >> 2)) * 64;
    for (int u = C.bid; u < NBATCH * 32 * 8; u += C.nblk) {
        const int g = u & 7, bc = u >> 3, t0 = bc * 128;
        __syncthreads();
        {
            const float rv = rs_from(ssqx + (t0 + srow) * 36 + 16, 16, 1.f / 1024);
            const bf16_t* zp = Z + (size_t)(t0 + srow) * 2048 + 1024 + g * 128 + sblk * 32; const float* gp = vg + g * 128 + sblk * 32;
#pragma unroll
            for (int c = 0; c < 4; ++c) { float v[8]; unpack8(*(const u32x4*)(zp + c * 8), v);
#pragma unroll
                for (int q = 0; q < 8; ++q) v[q] = v[q] * rv * gp[c * 8 + q];
                *(LAS u32x4*)(lds + sblk * 8192 + srow * 64 + c * 16) = pack8(v); }
        }
        __syncthreads();
        f32x16 a0, a1;
#pragma unroll
        for (int r = 0; r < 16; ++r) { a0[r] = 0.f; a1[r] = 0.f; }
        const bf16_t* wp = WS + (size_t)g * 16384 + (32 * wr + r32) * 128 + 8 * hi;
        const LAS unsigned char* vb = lds + (2 * wc) * 8192 + vfrag;
        for (int ks = 0; ks < 2 * wr + 2; ++ks) {
            const bf16x8 wf = *(const bf16x8*)(wp + 16 * ks);
            const s16x4 x0 = vtr(vb + ks * 1024), x1 = vtr(vb + ks * 1024 + 256), y0 = vtr(vb + 8192 + ks * 1024), y1 = vtr(vb + 8192 + ks * 1024 + 256);
            const bf16x8 v0 = (bf16x8){x0[0], x0[1], x0[2], x0[3], x1[0], x1[1], x1[2], x1[3]}, v1 = (bf16x8){y0[0], y0[1], y0[2], y0[3], y1[0], y1[1], y1[2], y1[3]};
            a0 = __builtin_amdgcn_mfma_f32_32x32x16_bf16(wf, v0, a0, 0, 0, 0);
            a1 = __builtin_amdgcn_mfma_f32_32x32x16_bf16(wf, v1, a1, 0, 0, 0);
        }
#pragma unroll
        for (int r = 0; r < 16; ++r) {
            const int t = 32 * wr + crow(r, hi); const float bias = bs[g * 128 + t];
            const size_t zo = (size_t)(t0 + t) * 2048 + g * 128 + 64 * wc + r32, mo = (size_t)(t0 + t) * D + g * 128 + 64 * wc + r32;
            MIX[mo] = (bf16_t)f2bf(bf2f(Z[zo]) * (a0[r] + bias)); MIX[mo + 32] = (bf16_t)f2bf(bf2f(Z[zo + 32]) * (a1[r] + bias));
        }
    }
    __syncthreads();
}

__device__ __forceinline__ void phase_sg_naive(Ctx& C, int j) {
    const bf16_t* Z = WSP(bf16_t, WS_Z); const float* ssqx = WSP(float, WS_SSQX); const bf16_t* WS = WSP(bf16_t, WS_WS) + (size_t)j * 8 * 128 * 128; bf16_t* MIX = WSP(bf16_t, WS_MIX);
    const float* vg = WSP(float, WS_PAR) + PAR_VN + j * D; const float* bs = WSP(float, WS_PAR) + PAR_BS + (size_t)j * 8 * 128;
    LAS float* Wt = (LAS float*)C.lds;
    LAS float* Vn = Wt + 128 * 129;
    const int tid = C.tid;
    for (int u = C.bid; u < NBATCH * 32 * 8; u += C.nblk) {
        const int g = u & 7, bc = u >> 3, t0 = bc * 128;
        __syncthreads();
        for (int i = tid; i < 128 * 16; i += NTHREADS) { const int r = i >> 4, c8 = (i & 15) * 8; float v[8];
            unpack8(*(const u32x4*)(WS + (size_t)g * 16384 + r * 128 + c8), v);
#pragma unroll
            for (int q = 0; q < 8; ++q) Wt[r * 129 + c8 + q] = v[q];
            unpack8(*(const u32x4*)(Z + (size_t)(t0 + r) * 2048 + 1024 + g * 128 + c8), v);
            const float rv = rs_from(ssqx + (t0 + r) * 36 + 16, 16, 1.f / 1024);
#pragma unroll
            for (int q = 0; q < 8; ++q) Vn[r * 128 + c8 + q] = rbf(v[q] * rv * vg[g * 128 + c8 + q]); }
        __syncthreads();
        const int t = tid >> 2, d0 = (tid & 3) * 32;
        float acc[32];
#pragma unroll
        for (int i = 0; i < 32; ++i) acc[i] = 0.f;
        for (int s = 0; s <= t; ++s) { const float w = Wt[t * 129 + s];
#pragma unroll
            for (int i = 0; i < 32; ++i) acc[i] += w * Vn[s * 128 + d0 + i]; }
        const float bias = bs[g * 128 + t];
#pragma unroll
        for (int i8 = 0; i8 < 4; ++i8) { float uu[8], o[8]; unpack8(*(const u32x4*)(Z + (size_t)(t0 + t) * 2048 + g * 128 + d0 + i8 * 8), uu);
#pragma unroll
            for (int q = 0; q < 8; ++q) o[q] = uu[q] * (acc[i8 * 8 + q] + bias);
            *(u32x4*)(MIX + (size_t)(t0 + t) * D + g * 128 + d0 + i8 * 8) = pack8(o); }
    }
    __syncthreads();
}

__device__ __forceinline__ void phase_router(Ctx& C, int layer, bool sh = false) {
    const bf16_t* HB = WSP(bf16_t, WS_HB0); const float* ssq = WSP(float, WS_SSQ0); const bf16_t* WR = WSP(bf16_t, WS_WR) + (size_t)layer * 64 * D;
    int* tok_e = sh ? WSP(int, WS_Y + 4 * MiB) : WSP(int, WS_TOK); int* tok_pos = tok_e + 2 * T; float* rffn = (float*)(tok_pos + 2 * T);
    int* list = sh ? WSP(int, WS_Y) : WSP(int, WS_LIST); float* lw = sh ? WSP(float, WS_Y + 2 * MiB) : WSP(float, WS_LW); unsigned* cnt = WSP(unsigned, WS_CTL) + CW_CNT + (layer + (sh ? 4 : 0)) * 32 * 64;
    LAS u32x4* Wl = (LAS u32x4*)C.lds;
    const int lane = C.lane;
    __syncthreads();
    for (int i = C.tid; i < 48 * 128; i += NTHREADS) Wl[(i >> 7) * 129 + (i & 127)] = *(const u32x4*)(WR + (size_t)i * 8);
    __syncthreads();
    LAS float* lgw = (LAS float*)(C.lds + 48 * 129 * 16) + C.wave * (16 * 49);
    const int gw = C.bid * NWAVES + C.wave, NGW = C.nblk * NWAVES, fr = lane & 15, fq = lane >> 4;
    for (int grp = gw; grp < T / 16; grp += NGW) {
        const int tok0 = grp * 16;
        f32x4 acc[3];
#pragma unroll
        for (int n = 0; n < 3; ++n) acc[n] = (f32x4){0.f, 0.f, 0.f, 0.f};
        const bf16_t* ap = HB + (size_t)(tok0 + fr) * D + fq * 8;
#pragma unroll 8
        for (int ks = 0; ks < 32; ++ks) {
            const bf16x8 a = *(const bf16x8*)(ap + 32 * ks);
#pragma unroll
            for (int n = 0; n < 3; ++n) { const bf16x8 b = __builtin_bit_cast(bf16x8, Wl[(16 * n + fr) * 129 + 4 * ks + fq]); acc[n] = __builtin_amdgcn_mfma_f32_16x16x32_bf16(a, b, acc[n], 0, 0, 0); }
        }
#pragma unroll
        for (int n = 0; n < 3; ++n)
#pragma unroll
            for (int r = 0; r < 4; ++r) lgw[(4 * fq + r) * 49 + 16 * n + fr] = acc[n][r];
        asm volatile("s_waitcnt lgkmcnt(0)" ::: "memory");
        if (lane < 16) {
            const int m = tok0 + lane; const LAS float* lg = lgw + lane * 49;
            const float r = rs_from(ssq + m * 16, 16, 1.f / D);
            const float g0 = lg[0] * r, g1 = lg[1] * r, g2 = lg[2] * r, g3 = lg[3] * r;
            int g = 0; float gm = g0;
            if (g1 > gm) { gm = g1; g = 1; }
            if (g2 > gm) { gm = g2; g = 2; }
            if (g3 > gm) { gm = g3; g = 3; }
            const float gs = __expf(g0 - gm) + __expf(g1 - gm) + __expf(g2 - gm) + __expf(g3 - gm);
            const float gw_ = 1.0f / gs;
            float el[8];
#pragma unroll
            for (int q = 0; q < 8; ++q) el[q] = lg[4 + g * 8 + q] * r;
            int i1 = 0; float m1 = el[0];
#pragma unroll
            for (int q = 1; q < 8; ++q) if (el[q] > m1) { m1 = el[q]; i1 = q; }
            int i2 = -1; float m2 = -3.0e38f;
#pragma unroll
            for (int q = 0; q < 8; ++q) if (q != i1 && el[q] > m2) { m2 = el[q]; i2 = q; }
            const float e2 = __expf(m2 - m1), p1 = 1.0f / (1.0f + e2), p2 = e2 / (1.0f + e2);
            rffn[m] = r;
            const int ea = g * 8 + i1, eb = g * 8 + i2;
            const int pa = (int)atomicAdd(cnt + ea * 64, 1u), pb = (int)atomicAdd(cnt + eb * 64, 1u);
            list[ea * T + pa] = m; lw[ea * T + pa] = gw_ * p1; list[eb * T + pb] = m; lw[eb * T + pb] = gw_ * p2;
            tok_e[2 * m] = ea; tok_e[2 * m + 1] = eb; tok_pos[2 * m] = pa; tok_pos[2 * m + 1] = pb;
        }
        asm volatile("s_waitcnt lgkmcnt(0)" ::: "memory");
    }
    __syncthreads();
}

__device__ __forceinline__ void phase_combine(Ctx& C, int layer, bool sh = false) {
    const MoeTab mt = moe_tables(C, layer);
    const float* H = WSP(float, WS_H); float* Ho = sh ? WSP(float, WS_P3) : WSP(float, WS_H); bf16_t* HB = sh ? WSP(bf16_t, WS_KV) : WSP(bf16_t, WS_HB1); float* SS = sh ? WSP(float, WS_SSQX) : WSP(float, WS_SSQ1); const bf16_t* Y = WSP(bf16_t, WS_Y);
    const int* tok_e = WSP(int, WS_TOK); const int* tok_pos = tok_e + 2 * T;
    const int gw = C.bid * NWAVES + C.wave, NGW = C.nblk * NWAVES, lane = C.lane;
    for (int m = gw; m < T; m += NGW) {
        const int ea = tok_e[2 * m], eb = tok_e[2 * m + 1];
        const size_t sa = (size_t)mt.ebase[ea] * 256 + tok_pos[2 * m], sb = (size_t)mt.ebase[eb] * 256 + tok_pos[2 * m + 1];
        const f32x4* hr = (const f32x4*)(H + (size_t)m * D) + lane; f32x4* ho = (f32x4*)(Ho + (size_t)m * D) + lane; const u32x2* ya = (const u32x2*)(Y + sa * D) + lane; const u32x2* yb = (const u32x2*)(Y + sb * D) + lane;
        u32x2* ob = (u32x2*)(HB + (size_t)m * D) + lane; float s = 0.f;
#pragma unroll
        for (int j = 0; j < 4; ++j) {
            f32x4 v = hr[64 * j]; const u32x2 a = ya[64 * j], b = yb[64 * j];
            v.x += bf2f(a.x & 0xffffu) + bf2f(b.x & 0xffffu); v.y += bf2f(a.x >> 16) + bf2f(b.x >> 16); v.z += bf2f(a.y & 0xffffu) + bf2f(b.y & 0xffffu); v.w += bf2f(a.y >> 16) + bf2f(b.y >> 16);
            ho[64 * j] = v; s += (v.x * v.x + v.y * v.y) + (v.z * v.z + v.w * v.w); u32x2 o; o.x = pk2(v.x, v.y); o.y = pk2(v.z, v.w); ob[64 * j] = o;
        }
        s = wave_sum(s);
        if (lane < 16) SS[m * 16 + lane] = (lane == 0) ? s : 0.f;
    }
    __syncthreads();
}

__device__ __forceinline__ void phase_final(Ctx& C, float* outp) {
    const float* H = WSP(float, WS_H); const float* SS = WSP(float, WS_SSQ0); const float* g = WSP(float, WS_PAR) + PAR_FN;
    const int gw = C.bid * NWAVES + C.wave, NGW = C.nblk * NWAVES, lane = C.lane;
    for (int m = gw; m < T; m += NGW) {
        const float r = rs_from(SS + m * 16, 16, 1.f / D);
        const f32x4* hr = (const f32x4*)(H + (size_t)m * D) + lane; f32x4* o = (f32x4*)(outp + (size_t)m * D) + lane; const f32x4* gg = (const f32x4*)g + lane;
#pragma unroll
        for (int j = 0; j < 4; ++j) { const f32x4 v = hr[64 * j], w = gg[64 * j]; o[64 * j] = (f32x4){v.x * r * w.x, v.y * r * w.y, v.z * r * w.z, v.w * r * w.w}; }
    }
}

constexpr int NPHASES = 42;
template <int ph, bool SH = false> __device__ __forceinline__ void run_phase(Ctx& C) {
    constexpr int layer = (ph - 1) / 10, sub = (ph - 1) % 10, j = layer >> 1; constexpr bool even = (layer & 1) == 0;
    float* H = WSP(float, WS_H); bf16_t* HB0 = WSP(bf16_t, WS_HB0); bf16_t* HB1 = WSP(bf16_t, WS_HB1); float* SSQ0 = WSP(float, WS_SSQ0); float* SSQ1 = WSP(float, WS_SSQ1); float* SSQX = WSP(float, WS_SSQX);
    float* Hw = SH ? WSP(float, WS_P3) : H; bf16_t* HB0w = SH ? WSP(bf16_t, WS_KV) : HB0; float* SSQ0w = SH ? SSQX : SSQ0;
    const float* ROPE = WSP(float, WS_ROPE); bf16_t* MIX = WSP(bf16_t, WS_MIX);
    switch (sub) {
    case 0:
        if (even) { const bf16_t* W = WSP(bf16_t, WS_WINE) + (size_t)j * EINP * D; EpiE1 e{SSQ0, WSP(bf16_t, WS_P3), WSP(bf16_t, WS_CQ), WSP(bf16_t, WS_CKV), WSP(bf16_t, WS_KPE), SSQX, ROPE};
            if (FASTMASK & 1) gemm_dense(C, HB0, W, EINP, D, e); else { DenseRM rm{HB0, W, D}; gemm_naive(C, EINP, D, rm, e); } }
        else { const bf16_t* W = WSP(bf16_t, WS_WINO) + (size_t)j * 2048 * D; EpiGelu e{SSQ0, WSP(bf16_t, WS_Z), SSQX};
            if (FASTMASK & 2) gemm_dense(C, HB0, W, 2048, D, e); else { DenseRM rm{HB0, W, D}; gemm_naive(C, 2048, D, rm, e); } }
        break;
    case 1:
        if (even) {
            { const bf16_t* W = WSP(bf16_t, WS_WQ) + (size_t)j * 768 * QR; EpiQ e{SSQX, WSP(bf16_t, WS_Q), ROPE};
              if (FASTMASK & 4) gemm_dense(C, WSP(bf16_t, WS_CQ), W, 768, QR, e); else { DenseRM rm{WSP(bf16_t, WS_CQ), W, QR}; gemm_naive(C, 768, QR, rm, e); } }
            { const bf16_t* W = WSP(bf16_t, WS_WKV) + (size_t)j * 1024 * KVR; EpiKV e{SSQX, WSP(bf16_t, WS_KV)};
              if (FASTMASK & 8) gemm_dense(C, WSP(bf16_t, WS_CKV), W, 1024, KVR, e); else { DenseRM rm{WSP(bf16_t, WS_CKV), W, KVR}; gemm_naive(C, 1024, KVR, rm, e); } }
            phase_conv(C, j);
        } else { if (FASTMASK & 1024) phase_sg(C, j); else phase_sg_naive(C, j); }
        break;
    case 2:
        if (even) { if (FASTMASK & 512) phase_attn(C); else phase_attn_naive(C); }
        break;
    case 3: {
        const bf16_t* W = (even ? WSP(bf16_t, WS_WOE) : WSP(bf16_t, WS_WOO)) + (size_t)j * D * D; EpiRes e{H, Hw, HB0w, SSQ0w};
        if (FASTMASK & 16) gemm_dense(C, MIX, W, D, D, e); else { DenseRM rm{MIX, W, D}; gemm_naive(C, D, D, rm, e); }
        break; }
    case 4: phase_router(C, layer, SH); break;
    case 5: { const MoeTab mt = moe_tables(C, layer); const int* tok_e = WSP(int, WS_TOK); const bf16_t* W = WSP(bf16_t, WS_WGU) + (size_t)layer * NEXP * D * D;
        EpiGU e{mt, WSP(int, WS_LIST), (const float*)(tok_e + 4 * T), WSP(bf16_t, WS_ACT)};
        if (FASTMASK & 32) { MoeGatherProb P{mt, WSP(int, WS_LIST), HB0, W, D}; pg8::MoeOrder S{mt.ebase[NEXP], C.nblk, C.bid}; pg8::EpiAdapt<EpiGU> ea{e}; pg8::gemm_phase(C.lds, C.tid, P, S, ea); }
        else { MoeGatherRM rm{mt, WSP(int, WS_LIST), HB0, W}; gemm_naive(C, D, D, rm, e); }
        break; }
    case 6: { const MoeTab mt = moe_tables(C, layer); const bf16_t* W = WSP(bf16_t, WS_WDN) + (size_t)layer * NEXP * D * DEXP;
        EpiDown e{mt, WSP(int, WS_LIST), WSP(float, WS_LW), WSP(bf16_t, WS_Y)};
        if (FASTMASK & 64) { MoeDownProb P{mt, WSP(bf16_t, WS_ACT), W, DEXP}; pg8::MoeOrder S{mt.ebase[NEXP], C.nblk, C.bid}; pg8::EpiAdapt<EpiDown> ea{e}; pg8::gemm_phase(C.lds, C.tid, P, S, ea); }
        else { MoeDownRM rm{mt, WSP(bf16_t, WS_ACT), W}; gemm_naive(C, D, DEXP, rm, e); }
        break; }
    case 7: phase_combine(C, layer, SH); break;
    case 8: { const bf16_t* A = WSP(bf16_t, WS_PB) + (size_t)layer * T * PLE; const bf16_t* W = WSP(bf16_t, WS_WP) + (size_t)layer * D * PLE; EpiPP e{WSP(bf16_t, WS_PP)};
        if (FASTMASK & 128) gemm_dense(C, A, W, D, PLE, e); else { DenseRM rm{A, W, PLE}; gemm_naive(C, D, PLE, rm, e); }
        break; }
    case 9: { const bf16_t* W = WSP(bf16_t, WS_WG) + (size_t)layer * D * D; EpiPLE e{SSQ1, WSP(bf16_t, WS_PP), H, Hw, HB0w, SSQ0w};
        if (FASTMASK & 256) gemm_dense(C, HB1, W, D, D, e); else { DenseRM rm{HB1, W, D}; gemm_naive(C, D, D, rm, e); }
        break; }
    }
}
__host__ __device__ constexpr bool phase_is_nop(int ph) { return (ph != 0 && ph != NPHASES - 1) && ((((ph - 1) / 10) & 1) != 0) && (((ph - 1) % 10) == 2); }

__device__ __forceinline__ void phase_enter(Ctx& C, unsigned char* ws) {
    int t = threadIdx.x; asm volatile("" : "+v"(t)); C.tid = t; C.lane = t & 63; C.wave = __builtin_amdgcn_readfirstlane(t >> 6);
    unsigned char* w = ws; asm volatile("" : "+s"(w)); C.ws = w;
    int b = blockIdx.x; asm volatile("" : "+s"(b)); C.bid = b;
}
template <int PH> __device__ __forceinline__ void run_all(Ctx& C, unsigned char* ws, const XcdBarrier& bar) {
    if constexpr (PH < NPHASES - 1) {
        if constexpr (!phase_is_nop(PH)) { phase_enter(C, ws); run_phase<PH>(C); xcd_barrier(bar);
            if constexpr ((DUPMASK >> PH) & 1ull) { phase_enter(C, ws); run_phase<PH, true>(C); xcd_barrier(bar); } }
        run_all<PH + 1>(C, ws, bar);
    }
}
template <int PH> __device__ __forceinline__ void run_one(Ctx& C, unsigned char* ws, int ph) {
    if constexpr (PH < NPHASES - 1) {
        if (ph == PH) { if constexpr (!phase_is_nop(PH)) { phase_enter(C, ws); run_phase<PH>(C); } }
        else run_one<PH + 1>(C, ws, ph);
    }
}
__global__ void __launch_bounds__(NTHREADS, 2) fwd_kernel(Args args) {
    extern __shared__ __attribute__((aligned(16))) unsigned char lds_raw[];
    Ctx C;
    C.lds = (LAS unsigned char*)lds_raw;
    C.a = &args; C.ws = args.ws;
    C.tid = threadIdx.x; C.lane = C.tid & 63; C.wave = __builtin_amdgcn_readfirstlane(C.tid >> 6);
    C.bid = blockIdx.x; C.nblk = gridDim.x;
    volatile LAS unsigned* misc = (volatile LAS unsigned*)(C.lds + LDS_MISC);
    if (C.tid < 64) misc[C.tid] = 0u;
    __syncthreads();
#if MEGA
    XcdBarrier bar = xcd_barrier_post(WSP(unsigned, WS_CTL) + CW_BAR, misc + 8);
#endif
#if MEGA
    int lo = 0; constexpr int hi = NPHASES;
#else
    int lo = args.ph_lo; const int hi = args.ph_hi;
#endif
#if MEGA
#define SEAM(p) do { if ((p) + 1 < hi) xcd_barrier(bar); } while (0)
#else
#define SEAM(p) do { } while (0)
#endif
    if (lo == 0) { phase_prologue(C); SEAM(0); if (DUPMASK & 1ull) { phase_prologue(C); SEAM(0); } lo = 1; }
#if MEGA
    run_all<1>(C, args.ws, bar);
#else
    run_one<1>(C, args.ws, lo);
#endif
    if (hi == NPHASES && lo <= NPHASES - 1) {
        int t = threadIdx.x; asm volatile("" : "+v"(t)); C.tid = t; C.lane = t & 63; C.wave = __builtin_amdgcn_readfirstlane(t >> 6);
        unsigned char* w = args.ws; asm volatile("" : "+s"(w)); C.ws = w;
        phase_final(C, args.out);
    }
#undef SEAM
}

extern "C" void kernel_launch(void* const* d_in, const int* in_sizes, int n_in, void* d_out, int out_size, void* d_ws, size_t ws_size, hipStream_t stream) {
    static int grid = 0;
    if (grid == 0) {
        if (n_in != 26 || out_size != T * D || ws_size < WS_END) { fprintf(stderr, "kernel_launch: unexpected shapes (n_in %d out %d ws %zu)\n", n_in, out_size, ws_size); grid = -1; return; }
        int dev = 0, cus = 0;
        if (hipGetDevice(&dev) != hipSuccess || hipDeviceGetAttribute(&cus, hipDeviceAttributeMultiprocessorCount, dev) != hipSuccess) { grid = -1; return; }
        if (hipFuncSetAttribute((const void*)fwd_kernel, hipFuncAttributeMaxDynamicSharedMemorySize, LDS_BYTES) != hipSuccess) { fprintf(stderr, "kernel_launch: hipFuncSetAttribute failed\n"); grid = -1; return; }
        grid = cus;
    }
    if (grid < 0) return;
    (void)hipMemsetAsync((char*)d_ws + WS_CTL, 0, CTL_ZERO_BYTES, stream);
    Args a{};
    for (int i = 0; i < 26; ++i) a.in[i] = (const float*)d_in[i];
    a.out = (float*)d_out; a.ws = (unsigned char*)d_ws;
#if MEGA
    a.ph_lo = 0; a.ph_hi = NPHASES;
    hipLaunchKernelGGL(fwd_kernel, dim3(grid), dim3(NTHREADS), LDS_BYTES, stream, a);
#else
    for (int ph = 0; ph < NPHASES; ++ph) {
        if (phase_is_nop(ph)) continue;
        a.ph_lo = ph; a.ph_hi = ph + 1;
        hipLaunchKernelGGL(fwd_kernel, dim3(grid), dim3(NTHREADS), LDS_BYTES, stream, a);
    }
#endif
}
```

```cpp
#include <hip/hip_runtime.h>
#include <cstdio>
#include <cstdint>

#ifndef FASTMASK
#define FASTMASK 0x7ff
#endif
#ifndef DUPMASK
#define DUPMASK 0ull
#endif
#ifndef MEGA
#define MEGA 1
#endif

#define LAS __attribute__((address_space(3)))
#define GAS __attribute__((address_space(1)))
typedef unsigned short bf16_t;
typedef float f32x4 __attribute__((ext_vector_type(4)));
typedef unsigned u32x4 __attribute__((ext_vector_type(4)));
typedef unsigned u32x2 __attribute__((ext_vector_type(2)));
typedef short bf16x8 __attribute__((ext_vector_type(8)));

constexpr int T = 16384, D = 1024, SEQ = 4096, NBATCH = 4, DEPTH = 4;
constexpr int EIN = 2208, EINP = 2304;
constexpr int NH = 8, DQK = 96, DV = 64;
constexpr int QR = 384, KVR = 256;
constexpr int NEXP = 32, DEXP = 512;
constexpr int PLE = 256;
constexpr float EPS = 1e-6f;
constexpr int NWAVES = 8, NTHREADS = 512;
constexpr int MOE_ROWS = 40960;
constexpr float QSCALE = 0.10206207261596577f * 1.4426950408889634f;

constexpr size_t MiB = 1u << 20;
constexpr size_t WS_CTL = 0, CTL_ZERO_BYTES = 1 * MiB;
constexpr size_t WS_WINE = 1 * MiB;
constexpr size_t WS_WQ = 10 * MiB;
constexpr size_t WS_WKV = 12 * MiB;
constexpr size_t WS_WOE = 13 * MiB;
constexpr size_t WS_WINO = 17 * MiB;
constexpr size_t WS_WOO = 25 * MiB;
constexpr size_t WS_WS = 29 * MiB;
constexpr size_t WS_WR = 30 * MiB;
constexpr size_t WS_WG = 31 * MiB;
constexpr size_t WS_WP = 39 * MiB;
constexpr size_t WS_WGU = 41 * MiB;
constexpr size_t WS_WDN = 297 * MiB;
constexpr size_t WS_H = 425 * MiB;
constexpr size_t WS_HB0 = 489 * MiB;
constexpr size_t WS_HB1 = 521 * MiB;
constexpr size_t WS_SSQ0 = 553 * MiB;
constexpr size_t WS_SSQ1 = 554 * MiB;
constexpr size_t WS_SSQX = 555 * MiB;
constexpr size_t WS_ROPE = 558 * MiB;
constexpr size_t WS_PB = 560 * MiB;
constexpr size_t WS_P3 = 592 * MiB;
constexpr size_t WS_CQ = 640 * MiB;
constexpr size_t WS_CKV = 652 * MiB;
constexpr size_t WS_KPE = 660 * MiB;
constexpr size_t WS_Z = 592 * MiB;
constexpr size_t WS_Q = 661 * MiB;
constexpr size_t WS_KV = 685 * MiB;
constexpr size_t WS_MIX = 717 * MiB;
constexpr size_t WS_LIST = 749 * MiB;
constexpr size_t WS_LW = 751 * MiB;
constexpr size_t WS_TOK = 753 * MiB;
constexpr size_t WS_ACT = 754 * MiB;
constexpr size_t WS_Y = 794 * MiB;
constexpr size_t WS_PP = 874 * MiB;
constexpr size_t WS_PAR = 906 * MiB;
constexpr int PAR_CONV = 0, PAR_VN = 3072, PAR_BS = 5120, PAR_FN = 7168, PAR_N = 8192;
constexpr size_t WS_END = 907 * MiB;

constexpr int CW_CNT = 8192;
constexpr int CW_BAR = 4096;

constexpr int LDS_BYTES = 147456;
constexpr int LDS_MISC = LDS_BYTES - 256;

__device__ __forceinline__ float bf2f(unsigned b) { return __uint_as_float(b << 16); }
__device__ __forceinline__ unsigned f2bf(float f) { unsigned u = __float_as_uint(f); return (u + 0x7fffu + ((u >> 16) & 1u)) >> 16; }
typedef float f32x2_t __attribute__((ext_vector_type(2))); typedef __bf16 bf16x2_t __attribute__((ext_vector_type(2)));
__device__ __forceinline__ unsigned pk2(float lo, float hi) { f32x2_t v = {lo, hi}; bf16x2_t b = __builtin_convertvector(v, bf16x2_t); return __builtin_bit_cast(unsigned, b); }
__device__ __forceinline__ void unpack8(const u32x4 w, float* v) {
    v[0] = __uint_as_float(w.x << 16); v[1] = __uint_as_float(w.x & 0xffff0000u);
    v[2] = __uint_as_float(w.y << 16); v[3] = __uint_as_float(w.y & 0xffff0000u);
    v[4] = __uint_as_float(w.z << 16); v[5] = __uint_as_float(w.z & 0xffff0000u);
    v[6] = __uint_as_float(w.w << 16); v[7] = __uint_as_float(w.w & 0xffff0000u);
}
__device__ __forceinline__ u32x4 pack8(const float* v) { u32x4 w; w.x = pk2(v[0], v[1]); w.y = pk2(v[2], v[3]); w.z = pk2(v[4], v[5]); w.w = pk2(v[6], v[7]); return w; }
__device__ __forceinline__ float rbf(float f) { return bf2f(f2bf(f)); }
__device__ __forceinline__ float wave_sum(float v) {
#pragma unroll
    for (int o = 1; o < 64; o <<= 1) v += __shfl_xor(v, o);
    return v;
}
__device__ __forceinline__ float wave_max(float v) {
#pragma unroll
    for (int o = 1; o < 64; o <<= 1) v = fmaxf(v, __shfl_xor(v, o));
    return v;
}
__device__ __forceinline__ float sigmoidf_(float x) { return 1.0f / (1.0f + __expf(-x)); }
__device__ __forceinline__ float gelu_tanh(float x) {
    const float u = 0.7978845608028654f * (x + 0.044715f * x * x * x);
    const float e = __expf(2.0f * u);
    const float th = 1.0f - 2.0f / (e + 1.0f);
    return 0.5f * x * (1.0f + th);
}

#define XB_TMO      128
#define XB_XCNT(j)  (256  + 64 * (j))
#define XB_XSUB(j)  (1280 + 64 * (j))
#define XB_XGEN(j)  (2304 + 64 * (j))
#define XB_TOP      3328
#define XB_TOPGEN   3392
#define XCD_BAR_WORDS 3456
#define XB_SPIN_CAP (1u << 22)
__device__ __forceinline__ unsigned xb_ld(unsigned* p)              { return __hip_atomic_load(p, __ATOMIC_RELAXED, __HIP_MEMORY_SCOPE_AGENT); }
__device__ __forceinline__ unsigned xb_add(unsigned* p, unsigned v) { return __hip_atomic_fetch_add(p, v, __ATOMIC_RELAXED, __HIP_MEMORY_SCOPE_AGENT); }
__device__ __forceinline__ unsigned xb_xcc_id() { return (unsigned)__builtin_amdgcn_s_getreg((3 << 11) | 20) & 0xFu; }
#define XB_SPIN(cond, bar) do { unsigned _sp = 0; while (cond) { __builtin_amdgcn_s_sleep(1); \
    if ((++_sp & 255u) == 0u) { if (xb_ld(&(bar)[XB_TMO])) break; if (_sp > XB_SPIN_CAP) { atomicAdd(&(bar)[XB_TMO], 1u); break; } } } } while (0)
struct XcdBarrier { unsigned* bar; unsigned x; volatile LAS unsigned* st; };
__device__ __forceinline__ XcdBarrier xcd_barrier_post(unsigned* bar, volatile LAS unsigned* st) {
    XcdBarrier b; b.bar = bar; b.x = xb_xcc_id(); b.st = st;
    if (threadIdx.x == 0) (void)xb_add(&bar[XB_XCNT(b.x)], 1u);
    return b;
}
__device__ __forceinline__ void xcd_barrier_complete(unsigned* bar, unsigned x, unsigned& nloc, unsigned& nx) {
    const unsigned G = gridDim.x * gridDim.y * gridDim.z;
    unsigned sum, cnt, mine, sp = 0u;
    for (;;) {
        sum = 0u; cnt = 0u; mine = 0u;
#pragma unroll
        for (unsigned j = 0; j < 16; ++j) { const unsigned c = xb_ld(&bar[XB_XCNT(j)]); sum += c; cnt += (c > 0u) ? 1u : 0u; mine = (j == x) ? c : mine; }
        if (sum == G) break;
        __builtin_amdgcn_s_sleep(1);
        if ((++sp & 255u) == 0u) { if (xb_ld(&bar[XB_TMO])) break; if (sp > XB_SPIN_CAP) { atomicAdd(&bar[XB_TMO], 1u); break; } }
    }
    nloc = mine > 0u ? mine : 1u; nx = cnt > 0u ? cnt : 1u;
}
__device__ __forceinline__ void xcd_barrier(const XcdBarrier& b) {
    asm volatile("s_waitcnt vmcnt(0)" ::: "memory");
    __syncthreads();
    if (threadIdx.x == 0) {
        unsigned* bar = b.bar;
        __builtin_amdgcn_s_waitcnt(0);
        unsigned nloc = b.st[0], nx = b.st[1];
        if (nloc == 0u) { xcd_barrier_complete(bar, b.x, nloc, nx); b.st[0] = nloc; b.st[1] = nx; }
        const unsigned old = xb_add(&bar[XB_XSUB(b.x)], 1u);
        const unsigned gen = old / nloc;
        if (old + 1u == (gen + 1u) * nloc) {
            __builtin_amdgcn_fence(__ATOMIC_RELEASE, "agent");
            asm volatile("s_waitcnt vmcnt(0)" ::: "memory");
            const unsigned og = xb_add(&bar[XB_TOP], 1u);
            const unsigned tg = og / nx;
            if (og + 1u == (tg + 1u) * nx) xb_add(&bar[XB_TOPGEN], 1u);
            else XB_SPIN(xb_ld(&bar[XB_TOPGEN]) == tg, bar);
            __builtin_amdgcn_fence(__ATOMIC_ACQUIRE, "agent");
            xb_add(&bar[XB_XGEN(b.x)], 1u);
            asm volatile("s_waitcnt vmcnt(0)" ::: "memory");
        } else {
            XB_SPIN(xb_ld(&bar[XB_XGEN(b.x)]) == gen, bar);
            __builtin_amdgcn_fence(__ATOMIC_ACQUIRE, "agent");
            asm volatile("s_waitcnt vmcnt(0)" ::: "memory");
        }
    }
    __syncthreads();
}

struct Args { const float* in[26]; float* out; unsigned char* ws; int ph_lo, ph_hi; };
struct Ctx {
    LAS unsigned char* lds;
    const Args* a; unsigned char* ws;
    int tid, lane, wave, bid, nblk;
};
#define WSP(T_, off) ((T_*)(C.ws + (off)))

__device__ __forceinline__ void conv_item(const float* colp, int ldw, const float* gain, bf16_t* WT, int K, int k0, int n0, LAS float* scr, int lane) {
#pragma unroll 8
    for (int i = 0; i < 32; ++i) {
        const int kk = 2 * i + (lane >> 5);
        float v = colp ? colp[(size_t)(k0 + kk) * ldw] : 0.f;
        if (gain) v *= gain[k0 + kk];
        scr[kk * 33 + (lane & 31)] = v;
    }
    asm volatile("s_waitcnt lgkmcnt(0)" ::: "memory");
    const int c = lane & 7;
#pragma unroll
    for (int j = 0; j < 4; ++j) {
        const int n = (lane >> 3) + 8 * j; const LAS float* s = scr + (8 * c) * 33 + n;
        u32x4 o; o.x = pk2(s[0 * 33], s[1 * 33]); o.y = pk2(s[2 * 33], s[3 * 33]); o.z = pk2(s[4 * 33], s[5 * 33]); o.w = pk2(s[6 * 33], s[7 * 33]);
        *(u32x4*)(WT + (size_t)(n0 + n) * K + k0 + 8 * c) = o;
    }
    asm volatile("s_waitcnt lgkmcnt(0)" ::: "memory");
}


__device__ __forceinline__ void conv_item64(const float* colp  , int ldw, const float* gain, bf16_t* WT, int K, int k0, int n0, LAS float* scr, int lane) {
    f32x4 v[16];
#pragma unroll
    for (int i = 0; i < 16; ++i) v[i] = *(const f32x4*)(colp + (size_t)(k0 + 4 * i + (lane >> 4)) * ldw);
#pragma unroll
    for (int i = 0; i < 16; ++i) {
        const int kk = 4 * i + (lane >> 4); const float g = gain ? gain[k0 + kk] : 1.f; LAS float* s = scr + kk * 65 + (lane & 15) * 4;
        s[0] = v[i].x * g; s[1] = v[i].y * g; s[2] = v[i].z * g; s[3] = v[i].w * g;
    }
    asm volatile("s_waitcnt lgkmcnt(0)" ::: "memory");
    const int c = lane & 7;
#pragma unroll
    for (int j = 0; j < 8; ++j) {
        const int n = (lane >> 3) + 8 * j; const LAS float* s = scr + (8 * c) * 65 + n;
        u32x4 o; o.x = pk2(s[0 * 65], s[1 * 65]); o.y = pk2(s[2 * 65], s[3 * 65]); o.z = pk2(s[4 * 65], s[5 * 65]); o.w = pk2(s[6 * 65], s[7 * 65]);
        *(u32x4*)(WT + (size_t)(n0 + n) * K + k0 + 8 * c) = o;
    }
    asm volatile("s_waitcnt lgkmcnt(0)" ::: "memory");
}

__device__ __forceinline__ void phase_prologue(Ctx& C) {
    LAS float* scr = (LAS float*)(C.lds + C.wave * 16896);
    const int gw = C.bid * NWAVES + C.wave, NGW = C.nblk * NWAVES, lane = C.lane;
    {
        constexpr int I0 = 16 * 72, I1 = 6 * 24, I6 = 16 * 2;
        constexpr int E0 = 2 * I0, E1 = E0 + 2 * I1, E6 = E1 + 4 * I6;
        for (int it = gw; it < E6; it += NGW) {
            const int nl = lane & 31;
            if (it < E0) {
                const int j = it / I0, r = it % I0, kb = r / 72, nb = r % 72, np = nb * 32 + nl;
                int n;
                if (np < 1920) n = np; else if (np < 1952) { const int q = np - 1920; n = 2176 + (q & 1) * 16 + (q >> 1); } else if (np < 2048) n = -1; else n = 1920 + (np - 2048);
                const float* base = C.a->in[5] + (size_t)j * D * EIN;
                conv_item(n >= 0 ? base + n : nullptr, EIN, C.a->in[3] + (2 * j) * D, WSP(bf16_t, WS_WINE) + (size_t)j * EINP * D, D, kb * 64, nb * 32, scr, lane);
            } else if (it < E1) {
                const int r0 = it - E0, j = r0 / I1, r = r0 % I1, kb = r / 24, nb = r % 24, np = nb * 32 + nl;
                const int hd = np / 96, dd = np % 96; int n = np;
                if (dd >= 64) { const int q = dd - 64; n = hd * 96 + 64 + (q & 1) * 16 + (q >> 1); }
                conv_item(C.a->in[8] + (size_t)j * QR * 768 + n, 768, C.a->in[7] + j * QR, WSP(bf16_t, WS_WQ) + (size_t)j * 768 * QR, QR, kb * 64, nb * 32, scr, lane);
            } else {
                const int r0 = it - E1, l = r0 / I6, r = r0 % I6, kb = r / 2, nb = r % 2, np = nb * 32 + nl;
                const float* cp = nullptr; int ld = 4;
                if (np < 4) { cp = C.a->in[17] + (size_t)l * D * 4 + np; ld = 4; } else if (np < 36) { cp = C.a->in[18] + (size_t)l * D * 32 + (np - 4); ld = 32; }
                conv_item(cp, ld, C.a->in[4] + l * D, WSP(bf16_t, WS_WR) + (size_t)l * 64 * D, D, kb * 64, nb * 32, scr, lane);
            }
        }
        constexpr int J2 = 4 * 16, J3 = 16 * 16, J4 = 16 * 32, J5 = 16 * 16, J7 = 16 * 16, J8 = 4 * 16, J9 = 16 * 16, J10 = 8 * 16;
        constexpr int F2 = 2 * J2, F3 = F2 + 2 * J3, F4 = F3 + 2 * J4, F5 = F4 + 2 * J5, F7 = F5 + 4 * J7, F8 = F7 + 4 * J8, F9 = F8 + 128 * J9, F10 = F9 + 128 * J10;
        const int n4 = (lane & 15) * 4;
        for (int it = gw; it < F10; it += NGW) {
            if (it >= F8) {
                if (it < F9) {
                    const int r0 = it - F8, m = r0 / J9, r = r0 % J9, kb = r / 16, nb = r % 16, np = nb * 64 + n4;
                    const int l = m >> 5, b4 = np >> 2;
                    const float* cp = ((b4 & 1) ? C.a->in[20] : C.a->in[19]) + (size_t)m * D * DEXP + (b4 >> 1) * 4;
                    conv_item64(cp, DEXP, C.a->in[4] + l * D, WSP(bf16_t, WS_WGU) + (size_t)m * D * D, D, kb * 64, nb * 64, scr, lane);
                } else {
                    const int r0 = it - F9, m = r0 / J10, r = r0 % J10, kb = r / 16, nb = r % 16, np = nb * 64 + n4;
                    conv_item64(C.a->in[21] + (size_t)m * DEXP * D + np, D, nullptr, WSP(bf16_t, WS_WDN) + (size_t)m * D * DEXP, DEXP, kb * 64, nb * 64, scr, lane);
                }
            } else if (it < F2) {
                const int j = it / J2, r = it % J2, kb = r / 16, nb = r % 16, np = nb * 64 + n4;
                conv_item64(C.a->in[10] + (size_t)j * KVR * 1024 + np, 1024, C.a->in[9] + j * KVR, WSP(bf16_t, WS_WKV) + (size_t)j * 1024 * KVR, KVR, kb * 64, nb * 64, scr, lane);
            } else if (it < F3) {
                const int r0 = it - F2, j = r0 / J3, r = r0 % J3, kb = r / 16, nb = r % 16, np = nb * 64 + n4;
                conv_item64(C.a->in[11] + (size_t)j * D * D + np, D, nullptr, WSP(bf16_t, WS_WOE) + (size_t)j * D * D, D, kb * 64, nb * 64, scr, lane);
            } else if (it < F4) {
                const int r0 = it - F3, j = r0 / J4, r = r0 % J4, kb = r / 32, nb = r % 32, np = nb * 64 + n4;
                conv_item64(C.a->in[12] + (size_t)j * D * 2048 + np, 2048, C.a->in[3] + (2 * j + 1) * D, WSP(bf16_t, WS_WINO) + (size_t)j * 2048 * D, D, kb * 64, nb * 64, scr, lane);
            } else if (it < F5) {
                const int r0 = it - F4, j = r0 / J5, r = r0 % J5, kb = r / 16, nb = r % 16, np = nb * 64 + n4;
                conv_item64(C.a->in[16] + (size_t)j * D * D + np, D, nullptr, WSP(bf16_t, WS_WOO) + (size_t)j * D * D, D, kb * 64, nb * 64, scr, lane);
            } else if (it < F7) {
                const int r0 = it - F5, l = r0 / J7, r = r0 % J7, kb = r / 16, nb = r % 16, np = nb * 64 + n4;
                conv_item64(C.a->in[23] + (size_t)l * D * D + np, D, C.a->in[22] + l * D, WSP(bf16_t, WS_WG) + (size_t)l * D * D, D, kb * 64, nb * 64, scr, lane);
            } else {
                const int r0 = it - F7, l = r0 / J8, r = r0 % J8, kb = r / 16, nb = r % 16, np = nb * 64 + n4;
                conv_item64(C.a->in[24] + (size_t)l * PLE * D + np, D, nullptr, WSP(bf16_t, WS_WP) + (size_t)l * D * PLE, PLE, kb * 64, nb * 64, scr, lane);
            }
        }
    }
    {
        bf16_t* HB = WSP(bf16_t, WS_HB0); float* SS = WSP(float, WS_SSQ0);
        for (int m = gw; m < T; m += NGW) {
            const f32x4* xr = (const f32x4*)(C.a->in[0] + (size_t)m * D) + lane;
            u32x2* ob = (u32x2*)(HB + (size_t)m * D) + lane; float s = 0.f;
#pragma unroll
            for (int j = 0; j < 4; ++j) { const f32x4 v = xr[64 * j]; s += (v.x * v.x + v.y * v.y) + (v.z * v.z + v.w * v.w); u32x2 o; o.x = pk2(v.x, v.y); o.y = pk2(v.z, v.w); ob[64 * j] = o; }
            s = wave_sum(s);
            if (lane < 16) SS[m * 16 + lane] = (lane == 0) ? s : 0.f;
        }
    }
    {
        const size_t n8 = (size_t)DEPTH * T * PLE / 8; const size_t gt = (size_t)C.bid * NTHREADS + C.tid, NGT = (size_t)C.nblk * NTHREADS;
        const f32x4* src = (const f32x4*)C.a->in[1]; u32x4* dst = WSP(u32x4, WS_PB);
        for (size_t i = gt; i < n8; i += NGT) { const f32x4 a = src[2 * i], b = src[2 * i + 1]; u32x4 o; o.x = pk2(a.x, a.y); o.y = pk2(a.z, a.w); o.z = pk2(b.x, b.y); o.w = pk2(b.z, b.w); dst[i] = o; }
    }
    {
        const int gt = C.bid * NTHREADS + C.tid, NGT = C.nblk * NTHREADS; const int* pos = (const int*)C.a->in[2]; float* R = WSP(float, WS_ROPE);
        for (int i = gt; i < T * 16; i += NGT) {
            const int t = i >> 4, f = i & 15;
            const int q = f & 3; double inv = (q == 0) ? 1.0 : (q == 1) ? 0.5623413251903491 : (q == 2) ? 0.31622776601683794 : 0.17782794100389228;
            const int dec = f >> 2; inv *= (dec == 0) ? 1.0 : (dec == 1) ? 0.1 : (dec == 2) ? 0.01 : 0.001;
            const double ang = (double)pos[t] * inv;
            const double n = __builtin_rint(ang * 0.15915494309189535);
            const double r = ang - n * 6.283185307179586, r2 = r * r;
            double sn = r, cs = 1.0, ts = r, tc = 1.0;
#pragma unroll
            for (int k = 1; k <= 13; ++k) { tc *= -r2 / (double)((2 * k - 1) * (2 * k)); cs += tc; ts *= -r2 / (double)((2 * k) * (2 * k + 1)); sn += ts; }
            R[2 * i] = (float)cs; R[2 * i + 1] = (float)sn;
        }
    }
    {
        const int gt = C.bid * NTHREADS + C.tid, NGT = C.nblk * NTHREADS; float* PR = WSP(float, WS_PAR);
        for (int i = gt; i < PAR_N; i += NGT) {
            float v;
            if (i < PAR_VN) v = C.a->in[6][i]; else if (i < PAR_BS) v = C.a->in[13][i - PAR_VN]; else if (i < PAR_FN) v = C.a->in[15][i - PAR_BS]; else v = C.a->in[25][i - PAR_FN];
            PR[i] = v;
        }
    }
    {
        const int gt = C.bid * NTHREADS + C.tid, NGT = C.nblk * NTHREADS; const float* src = C.a->in[14]; bf16_t* dst = WSP(bf16_t, WS_WS);
        for (int i = gt; i < 2 * 8 * 128 * 128; i += NGT) { const int s = i & 127, t = (i >> 7) & 127; dst[i] = (bf16_t)((s <= t) ? f2bf(src[i]) : 0u); }
    }
}

template <class RM, class Epi>
__device__ __forceinline__ void gemm_naive(Ctx& C, int N, int K, const RM& rm, const Epi& epi) {
    LAS float* As = (LAS float*)C.lds;
    LAS float* Bs = As + 32 * 132;
    const int tid = C.tid, ty = tid >> 4, tx = tid & 15;
    const int nct = N / 128, nunits = rm.ntiles128() * nct;
    for (int u = C.bid; u < nunits; u += C.nblk) {
        const int mt = u / nct, nt = u % nct, row0 = mt * 128, col0 = nt * 128;
        const bf16_t* Bt = rm.bt(row0);
        float acc[4][8];
#pragma unroll
        for (int i = 0; i < 4; ++i)
#pragma unroll
            for (int j = 0; j < 8; ++j) acc[i][j] = 0.f;
        const int lr = tid >> 2, kc = (tid & 3) * 8;
        const bf16_t* ap = rm.arow(row0 + lr);
        const bf16_t* bp = Bt + (size_t)(col0 + lr) * K;
        for (int k0 = 0; k0 < K; k0 += 32) {
            float av[8], bv[8];
            if (ap) { const u32x4 w = *(const u32x4*)(ap + k0 + kc); unpack8(w, av); } else {
#pragma unroll
                for (int i = 0; i < 8; ++i) av[i] = 0.f; }
            { const u32x4 w = *(const u32x4*)(bp + k0 + kc); unpack8(w, bv); }
            __syncthreads();
#pragma unroll
            for (int i = 0; i < 8; ++i) { As[(kc + i) * 132 + lr] = av[i]; Bs[(kc + i) * 132 + lr] = bv[i]; }
            __syncthreads();
#pragma unroll 4
            for (int k = 0; k < 32; ++k) {
                const f32x4 a = *(const LAS f32x4*)(As + k * 132 + ty * 4);
                const f32x4 b0 = *(const LAS f32x4*)(Bs + k * 132 + tx * 8), b1 = *(const LAS f32x4*)(Bs + k * 132 + tx * 8 + 4);
                const float aa[4] = {a.x, a.y, a.z, a.w}; const float bb[8] = {b0.x, b0.y, b0.z, b0.w, b1.x, b1.y, b1.z, b1.w};
#pragma unroll
                for (int i = 0; i < 4; ++i)
#pragma unroll
                    for (int j = 0; j < 8; ++j) acc[i][j] += aa[i] * bb[j];
            }
        }
#pragma unroll
        for (int i = 0; i < 4; ++i) {
            const int srow = row0 + ty * 4 + i;
            const typename Epi::Row rw = epi.row(srow);
            float ss = epi(srow, col0 + tx * 8, acc[i], rw);
            ss += __shfl_xor(ss, 1); ss += __shfl_xor(ss, 2); ss += __shfl_xor(ss, 4);
            if ((tx & 7) == 0) epi.rowsum(srow, (col0 + tx * 8) >> 6, ss);
        }
    }
    __syncthreads();
}

struct DenseRM {
    const bf16_t* A; const bf16_t* Bt; int K;
    __device__ __forceinline__ int ntiles128() const { return T / 128; }
    __device__ __forceinline__ const bf16_t* arow(int r) const { return A + (size_t)r * K; }
    __device__ __forceinline__ const bf16_t* bt(int) const { return Bt; }
};
struct MoeTab { LAS int* ebase; LAS int* tile2e; LAS int* ecnt; };
__device__ __forceinline__ MoeTab moe_tables(Ctx& C, int layer) {
    MoeTab mt; mt.ebase = (LAS int*)(C.lds + LDS_MISC - 2048); mt.tile2e = mt.ebase + 64; mt.ecnt = mt.tile2e + 192;
    __syncthreads();
    if (C.tid < 64) {
        const unsigned* cnt = WSP(unsigned, WS_CTL) + CW_CNT + layer * 32 * 64; const int lane = C.tid;
        const int c = (lane < NEXP) ? (int)__hip_atomic_load(cnt + lane * 64, __ATOMIC_RELAXED, __HIP_MEMORY_SCOPE_AGENT) : 0;
        const int nt = (c + 255) >> 8; int incl = nt;
#pragma unroll
        for (int o = 1; o < 32; o <<= 1) { const int v = __shfl_up(incl, o); if (lane >= o) incl += v; }
        const int excl = incl - nt;
        if (lane < NEXP) { mt.ecnt[lane] = c; mt.ebase[lane] = excl; for (int t = 0; t < nt; ++t) mt.tile2e[excl + t] = lane; }
        if (lane == NEXP - 1) mt.ebase[NEXP] = incl;
    }
    __syncthreads();
    return mt;
}
struct MoeRow { int e, pos, tok; };
__device__ __forceinline__ MoeRow moe_row(const MoeTab& mt, const int* list, int srow) {
    MoeRow r; const int t256 = srow >> 8; r.e = mt.tile2e[t256]; r.pos = (t256 - mt.ebase[r.e]) * 256 + (srow & 255);
    r.tok = (r.pos < mt.ecnt[r.e]) ? list[r.e * T + r.pos] : -1; return r;
}
struct MoeGatherRM {
    MoeTab mt; const int* list; const bf16_t* HB; const bf16_t* W;
    __device__ __forceinline__ int ntiles128() const { return mt.ebase[NEXP] * 2; }
    __device__ __forceinline__ const bf16_t* arow(int r) const { const MoeRow m = moe_row(mt, list, r); return m.tok >= 0 ? HB + (size_t)m.tok * D : nullptr; }
    __device__ __forceinline__ const bf16_t* bt(int r0) const { return W + (size_t)mt.tile2e[r0 >> 8] * D * D; }
};
struct MoeDownRM {
    MoeTab mt; const bf16_t* ACT; const bf16_t* W;
    __device__ __forceinline__ int ntiles128() const { return mt.ebase[NEXP] * 2; }
    __device__ __forceinline__ const bf16_t* arow(int r) const { return ACT + (size_t)r * DEXP; }
    __device__ __forceinline__ const bf16_t* bt(int r0) const { return W + (size_t)mt.tile2e[r0 >> 8] * D * DEXP; }
};

__device__ __forceinline__ float rs_from(const float* ss, int n, float inv_n) { float s = 0.f; for (int i = 0; i < n; ++i) s += ss[i]; return rsqrtf(s * inv_n + EPS); }
struct RowS { float s; };
struct EpiE1 {
    const float* ssq_h; bf16_t* P3; bf16_t* CQ; bf16_t* CKV; bf16_t* KPE; float* ssqx; const float* rope;
    typedef RowS Row;
    __device__ __forceinline__ Row row(int r) const { Row w; w.s = rs_from(ssq_h + r * 16, 16, 1.f / D); return w; }
    __device__ __forceinline__ float operator()(int r, int col, const float* v, const Row& w) const {
        float x[8];
#pragma unroll
        for (int i = 0; i < 8; ++i) x[i] = v[i] * w.s;
        float ss = 0.f;
        if (col < 1536) { *(u32x4*)(P3 + (size_t)r * 1536 + col) = pack8(x); }
        else if (col < 1920) { *(u32x4*)(CQ + (size_t)r * QR + (col - 1536)) = pack8(x);
#pragma unroll
            for (int i = 0; i < 8; ++i) ss += x[i] * x[i]; }
        else if (col < 1952) { const int f0 = (col - 1920) >> 1; float o[8];
#pragma unroll
            for (int i = 0; i < 4; ++i) { const float c = rope[(r * 16 + f0 + i) * 2], s = rope[(r * 16 + f0 + i) * 2 + 1]; o[2 * i] = x[2 * i] * c - x[2 * i + 1] * s; o[2 * i + 1] = x[2 * i + 1] * c + x[2 * i] * s; }
            *(u32x4*)(KPE + (size_t)r * 32 + (col - 1920)) = pack8(o); }
        else if (col < 2048) { }
        else { *(u32x4*)(CKV + (size_t)r * KVR + (col - 2048)) = pack8(x);
#pragma unroll
            for (int i = 0; i < 8; ++i) ss += x[i] * x[i]; }
        return ss;
    }
    __device__ __forceinline__ void rowsum(int r, int slot, float ss) const { ssqx[r * 36 + slot] = ss; }
};
struct EpiQ {
    const float* ssqx; bf16_t* Q; const float* rope;
    typedef RowS Row;
    __device__ __forceinline__ Row row(int r) const { Row w; w.s = rs_from(ssqx + r * 36 + 24, 8, 1.f / QR) * QSCALE; return w; }
    __device__ __forceinline__ float operator()(int r, int col, const float* v, const Row& w) const {
        float x[8];
#pragma unroll
        for (int i = 0; i < 8; ++i) x[i] = v[i] * w.s;
        const int dd = col % 96;
        if (dd >= 64) { const int f0 = (dd - 64) >> 1; float o[8];
#pragma unroll
            for (int i = 0; i < 4; ++i) { const float c = rope[(r * 16 + f0 + i) * 2], s = rope[(r * 16 + f0 + i) * 2 + 1]; o[2 * i] = x[2 * i] * c - x[2 * i + 1] * s; o[2 * i + 1] = x[2 * i + 1] * c + x[2 * i] * s; }
            *(u32x4*)(Q + (size_t)r * 768 + col) = pack8(o);
        } else *(u32x4*)(Q + (size_t)r * 768 + col) = pack8(x);
        return 0.f;
    }
    __device__ __forceinline__ void rowsum(int, int, float) const {}
};
struct EpiKV {
    const float* ssqx; bf16_t* KV;
    typedef RowS Row;
    __device__ __forceinline__ Row row(int r) const { Row w; w.s = rs_from(ssqx + r * 36 + 32, 4, 1.f / KVR); return w; }
    __device__ __forceinline__ float operator()(int r, int col, const float* v, const Row& w) const {
        float x[8];
#pragma unroll
        for (int i = 0; i < 8; ++i) x[i] = v[i] * w.s;
        *(u32x4*)(KV + (size_t)r * 1024 + col) = pack8(x); return 0.f;
    }
    __device__ __forceinline__ void rowsum(int, int, float) const {}
};
struct EpiRes {
    const bf16_t* Hr; bf16_t* HB; float* ssq;
    typedef RowS Row;
    __device__ __forceinline__ Row row(int) const { Row w; w.s = 1.f; return w; }
    __device__ __forceinline__ float operator()(int r, int col, const float* v, const Row&) const {
        float x[8]; unpack8(*(const u32x4*)(Hr + (size_t)r * D + col), x);
        float ss = 0.f;
#pragma unroll
        for (int i = 0; i < 8; ++i) { x[i] += v[i]; ss += x[i] * x[i]; }
        *(u32x4*)(HB + (size_t)r * D + col) = pack8(x);
        return ss;
    }
    __device__ __forceinline__ void rowsum(int r, int slot, float ss) const { ssq[r * 16 + slot] = ss; }
};
struct EpiGelu {
    const float* ssq_h; bf16_t* Z; float* ssqx;
    typedef RowS Row;
    __device__ __forceinline__ Row row(int r) const { Row w; w.s = rs_from(ssq_h + r * 16, 16, 1.f / D); return w; }
    __device__ __forceinline__ float operator()(int r, int col, const float* v, const Row& w) const {
        float x[8]; float ss = 0.f;
#pragma unroll
        for (int i = 0; i < 8; ++i) { x[i] = gelu_tanh(v[i] * w.s); ss += x[i] * x[i]; }
        *(u32x4*)(Z + (size_t)r * 2048 + col) = pack8(x);
        return col >= 1024 ? ss : 0.f;
    }
    __device__ __forceinline__ void rowsum(int r, int slot, float ss) const { ssqx[r * 36 + slot] = ss; }
};
struct RowM { float s; int ok; };
struct EpiGU {
    MoeTab mt; const int* list; const float* rffn; bf16_t* ACT;
    typedef RowM Row;
    __device__ __forceinline__ Row row(int r) const { const MoeRow m = moe_row(mt, list, r); Row w; w.ok = m.tok >= 0; w.s = w.ok ? rffn[m.tok] : 0.f; return w; }
    __device__ __forceinline__ float operator()(int r, int col, const float* v, const Row& w) const {
        float a[4];
#pragma unroll
        for (int i = 0; i < 4; ++i) { const float g = v[i] * w.s, u = v[4 + i] * w.s; a[i] = g * sigmoidf_(g) * u; }
        u32x2 o; o.x = pk2(a[0], a[1]); o.y = pk2(a[2], a[3]);
        *(u32x2*)(ACT + (size_t)r * DEXP + (col >> 1)) = o;
        return 0.f;
    }
    __device__ __forceinline__ void rowsum(int, int, float) const {}
};
struct EpiDown {
    MoeTab mt; const int* list; const float* lw; bf16_t* Y;
    typedef RowM Row;
    __device__ __forceinline__ Row row(int r) const { const MoeRow m = moe_row(mt, list, r); Row w; w.ok = m.tok >= 0; w.s = w.ok ? lw[m.e * T + m.pos] : 0.f; return w; }
    __device__ __forceinline__ float operator()(int r, int col, const float* v, const Row& w) const {
        if (w.ok) { float x[8];
#pragma unroll
            for (int i = 0; i < 8; ++i) x[i] = v[i] * w.s;
            *(u32x4*)(Y + (size_t)r * D + col) = pack8(x); }
        return 0.f;
    }
    __device__ __forceinline__ void rowsum(int, int, float) const {}
};
struct EpiPP {
    bf16_t* PP;
    typedef RowS Row;
    __device__ __forceinline__ Row row(int) const { Row w; w.s = 1.f; return w; }
    __device__ __forceinline__ float operator()(int r, int col, const float* v, const Row&) const { *(u32x4*)(PP + (size_t)r * D + col) = pack8(v); return 0.f; }
    __device__ __forceinline__ void rowsum(int, int, float) const {}
};
struct EpiPLE {
    const float* ssq_in; const bf16_t* PP; const bf16_t* Hr; bf16_t* HB; float* ssq;
    typedef RowS Row;
    __device__ __forceinline__ Row row(int r) const { Row w; w.s = rs_from(ssq_in + r * 16, 16, 1.f / D); return w; }
    __device__ __forceinline__ float operator()(int r, int col, const float* v, const Row& w) const {
        float pp[8], x[8]; unpack8(*(const u32x4*)(PP + (size_t)r * D + col), pp); unpack8(*(const u32x4*)(Hr + (size_t)r * D + col), x);
        float ss = 0.f;
#pragma unroll
        for (int i = 0; i < 8; ++i) { x[i] += sigmoidf_(v[i] * w.s) * pp[i]; ss += x[i] * x[i]; }
        *(u32x4*)(HB + (size_t)r * D + col) = pack8(x);
        return ss;
    }
    __device__ __forceinline__ void rowsum(int r, int slot, float ss) const { ssq[r * 16 + slot] = ss; }
};

namespace pg8 {
constexpr int BM = 256, BK = 64, HALF = 128, HTB = HALF * BK * 2, STAGE_BYTES = 8 * HTB, NXCD = 8, WGM = 8;
__host__ __device__ __forceinline__ int lds_byte(int r, int c) { const int st = (r >> 4) * 2 + (c >> 5), rr = r & 15, cc = c & 31, ob = rr * 64 + cc * 2; return st * 1024 + (ob ^ (((ob >> 9) & 1) << 5)); }
__host__ __device__ __forceinline__ void stage_rc(int b, int& R, int& C) { const int st = b / 1024, sb = b % 1024, swz = sb ^ (((sb >> 9) & 1) << 5); R = (st >> 1) * 16 + swz / 64; C = (st & 1) * 32 + (swz % 64) / 2; }
__host__ __device__ __forceinline__ int perm32(int rho) { const int n = rho >> 4, i = rho & 15; return 8 * (i >> 2) + 4 * n + (i & 3); }
struct Unit { int pm, pn; };
struct StaticOrder {
    int nM, nN, nwg, G, c;
    __device__ void init(int M, int N, int G_, int c_) { nM = M / BM; nN = N / BM; nwg = nM * nN; G = G_; c = c_; }
    __device__ bool next(int i, Unit& u) const {
        const long L = (long)i * G + c; if (L >= nwg) return false;
        int wgid = (int)L; { const int q = nwg / NXCD, r = nwg % NXCD, xcd = wgid % NXCD, off = wgid / NXCD; wgid = (xcd < r ? xcd * (q + 1) : r * (q + 1) + (xcd - r) * q) + off; }
        const int nig = WGM * nN, gid = wgid / nig, fm = gid * WGM, gsz = (nM - fm) < WGM ? (nM - fm) : WGM;
        u.pm = fm + ((wgid % nig) % gsz); u.pn = (wgid % nig) / gsz; return true;
    }
};
struct MoeOrder {
    int ntile, G, c;
    __device__ bool next(int i, Unit& u) const { const int L = i * G + c; if (L >= ntile * 4) return false; u.pm = L >> 2; u.pn = L & 3; return true; }
};
template <class Prob, class Epi, class Sched>
__device__ __forceinline__ void gemm_phase(LAS unsigned char* lds, int tid, const Prob& P, const Sched& S, const Epi& E) {
    constexpr bool GATHER = Prob::GATHER;
    const int wid = __builtin_amdgcn_readfirstlane(tid >> 6), lane = tid & 63, wr = wid >> 2, wc = wid & 3, fr = lane & 15, fq = lane >> 4;
    const int K = P.K, nt = K / BK;
    unsigned voffA[2], voffB[2]; int RA[2], CA2[2];
#pragma unroll
    for (int i = 0; i < 2; ++i) { int R, C; stage_rc(tid * 16 + i * 8192, R, C); const int Rb = (R & ~31) + perm32(R & 31);
        voffA[i] = (unsigned)(R * K + C) * 2u; voffB[i] = (unsigned)(Rb * K + C) * 2u; RA[i] = R; CA2[i] = C * 2; }
    const size_t kstep = (size_t)(BK * 2);
    const size_t hstep = (size_t)HALF * K * 2;
    const unsigned ldsw = (unsigned)wid * 1024u;
    const int aoff = lds_byte(wr * 64 + fr, fq * 8), boff = lds_byte(wc * 32 + fr, fq * 8);
#define PG8_SA(b, h) (((b) * 2 + (h)) * HTB)
#define PG8_SB(b, h) ((4 + (b) * 2 + (h)) * HTB)
#define PG8_STAGE2(bufoff, gbase, v0, v1) do { \
        __builtin_amdgcn_global_load_lds((const unsigned*)((const char*)(gbase) + (v0)), (LAS unsigned*)(lds + (bufoff) + ldsw), 16, 0, 0); \
        __builtin_amdgcn_global_load_lds((const unsigned*)((const char*)(gbase) + (v1)), (LAS unsigned*)(lds + (bufoff) + ldsw + 8192), 16, 0, 0); } while (0)
#define PG8_STAGE_B(bufoff, gbase) PG8_STAGE2(bufoff, gbase, voffB[0], voffB[1])
#define PG8_STAGE_A(bufoff, gbase, h, nx) do { if constexpr (GATHER) { PG8_STAGE2(bufoff, gbase, (nx) ? nvA[h][0] : cvA[h][0], (nx) ? nvA[h][1] : cvA[h][1]); } \
        else { PG8_STAGE2(bufoff, (gbase) + (h) * hstep, voffA[0], voffA[1]); } } while (0)
#define PG8_LDA(dst, b, h) do { _Pragma("unroll") for (int m = 0; m < 4; ++m) _Pragma("unroll") for (int k = 0; k < 2; ++k) dst[m][k] = *(const LAS bf16x8*)(lds + PG8_SA(b, h) + aoff + m * 2048 + k * 1024); } while (0)
#define PG8_LDB(dst, b, h) do { _Pragma("unroll") for (int n = 0; n < 2; ++n) _Pragma("unroll") for (int k = 0; k < 2; ++k) dst[n][k] = *(const LAS bf16x8*)(lds + PG8_SB(b, h) + boff + n * 2048 + k * 1024); } while (0)
#define PG8_MMA(ai, bj, At, Bt) do { __builtin_amdgcn_s_setprio(1); _Pragma("unroll") for (int m = 0; m < 4; ++m) _Pragma("unroll") for (int n = 0; n < 2; ++n) _Pragma("unroll") for (int k = 0; k < 2; ++k) \
        acc[ai][bj][m][n] = __builtin_amdgcn_mfma_f32_16x16x32_bf16(Bt[n][k], At[m][k], acc[ai][bj][m][n], 0, 0, 0); __builtin_amdgcn_s_setprio(0); } while (0)
#define PG8_WAIT_V(n) asm volatile("s_waitcnt vmcnt(" #n ")" ::: "memory")
#define PG8_WAIT_L(n) asm volatile("s_waitcnt lgkmcnt(" #n ")" ::: "memory")
#define PG8_BAR __builtin_amdgcn_s_barrier()
#define PG8_SCHED __builtin_amdgcn_sched_barrier(0)
    Unit cur, nxt; int ui = 0;
    if (!S.next(0, cur)) return;
    f32x4 acc[2][2][4][2];
#pragma unroll
    for (int a = 0; a < 2; ++a)
#pragma unroll
        for (int b = 0; b < 2; ++b)
#pragma unroll
            for (int m = 0; m < 4; ++m)
#pragma unroll
                for (int n = 0; n < 2; ++n) acc[a][b][m][n] = (f32x4){0.f, 0.f, 0.f, 0.f};
    bf16x8 At[4][2], B0[2][2], B1[2][2];
    unsigned cvA[2][2], nvA[2][2];
    if constexpr (GATHER) {
#pragma unroll
        for (int h = 0; h < 2; ++h)
#pragma unroll
            for (int i = 0; i < 2; ++i) { cvA[h][i] = P.arow_off(cur, h * HALF + RA[i]) + (unsigned)CA2[i]; nvA[h][i] = cvA[h][i]; }
    } else { cvA[0][0] = cvA[0][1] = cvA[1][0] = cvA[1][1] = 0u; nvA[0][0] = nvA[0][1] = nvA[1][0] = nvA[1][1] = 0u; }
    const char* cA = P.abase(cur); const char* cB = P.bbase(cur);
    PG8_STAGE_B(PG8_SB(0, 0), cB); PG8_STAGE_B(PG8_SB(0, 1), cB + hstep); PG8_STAGE_A(PG8_SA(0, 0), cA, 0, false); PG8_STAGE_A(PG8_SA(0, 1), cA, 1, false);
    if (wr == 1) PG8_BAR;
    PG8_WAIT_V(2); PG8_BAR;
    PG8_STAGE_B(PG8_SB(1, 0), cB + kstep); PG8_STAGE_A(PG8_SA(1, 0), cA + kstep, 0, false); PG8_STAGE_B(PG8_SB(1, 1), cB + hstep + kstep);
    PG8_WAIT_V(6); PG8_BAR;
    for (;;) {
        const bool has_next = S.next(ui + 1, nxt);
        const char* nA = has_next ? P.abase(nxt) : cA; const char* nB = has_next ? P.bbase(nxt) : cB;
        if constexpr (GATHER) {
            if (has_next) {
#pragma unroll
                for (int h = 0; h < 2; ++h)
#pragma unroll
                    for (int i = 0; i < 2; ++i) nvA[h][i] = P.arow_off(nxt, h * HALF + RA[i]) + (unsigned)CA2[i];
            }
        }
        for (int t = 0; t < nt; t += 2) {
            const bool last = (t == nt - 2);
            const char* a1 = cA + (size_t)(t + 1) * kstep;
            const char* a2 = last ? nA : cA + (size_t)(t + 2) * kstep; const char* b2 = last ? nB : cB + (size_t)(t + 2) * kstep;
            const char* a3 = a2 + kstep; const char* b3 = b2 + kstep;
            PG8_LDB(B0, 0, 0); PG8_LDB(B1, 0, 1); PG8_SCHED; PG8_LDA(At, 0, 0); PG8_STAGE_A(PG8_SA(1, 1), a1, 1, false);
            PG8_WAIT_V(8); PG8_WAIT_L(0); PG8_BAR; PG8_MMA(0, 0, At, B0); PG8_MMA(0, 1, At, B1); PG8_BAR; PG8_SCHED;
            PG8_LDA(At, 0, 1); PG8_STAGE_B(PG8_SB(0, 0), b2); PG8_STAGE_B(PG8_SB(0, 1), b2 + hstep); PG8_STAGE_A(PG8_SA(0, 0), a2, 0, last);
            PG8_WAIT_V(8); PG8_WAIT_L(0); PG8_BAR; PG8_MMA(1, 0, At, B0); PG8_MMA(1, 1, At, B1); PG8_BAR; PG8_SCHED;
            PG8_LDB(B0, 1, 0); PG8_LDB(B1, 1, 1); PG8_SCHED; PG8_LDA(At, 1, 0); PG8_STAGE_A(PG8_SA(0, 1), a2, 1, last);
            PG8_WAIT_V(8); PG8_WAIT_L(0); PG8_BAR; PG8_MMA(0, 0, At, B0); PG8_MMA(0, 1, At, B1); PG8_BAR; PG8_SCHED;
            PG8_LDA(At, 1, 1); PG8_STAGE_B(PG8_SB(1, 0), b3); PG8_STAGE_B(PG8_SB(1, 1), b3 + hstep); PG8_STAGE_A(PG8_SA(1, 0), a3, 0, last);
            PG8_WAIT_V(8); PG8_WAIT_L(0); PG8_BAR; PG8_MMA(1, 0, At, B0); PG8_MMA(1, 1, At, B1); PG8_BAR; PG8_SCHED;
        }
        if (wr == 0) PG8_BAR;
        { int fr_e = fr, fq_e = fq; asm volatile("" : "+v"(fr_e), "+v"(fq_e));
          E(acc, cur, wr, wc, fr_e, fq_e); }
        if (!has_next) break;
#pragma unroll
        for (int a = 0; a < 2; ++a)
#pragma unroll
            for (int b = 0; b < 2; ++b)
#pragma unroll
                for (int m = 0; m < 4; ++m)
#pragma unroll
                    for (int n = 0; n < 2; ++n) acc[a][b][m][n] = (f32x4){0.f, 0.f, 0.f, 0.f};
        cur = nxt; cA = nA; cB = nB; ++ui;
        if constexpr (GATHER) {
#pragma unroll
            for (int h = 0; h < 2; ++h)
#pragma unroll
                for (int i = 0; i < 2; ++i) cvA[h][i] = nvA[h][i];
        }
        if (wr == 1) PG8_BAR;
    }
    PG8_WAIT_V(0);
    PG8_BAR;
#undef PG8_SA
#undef PG8_SB
#undef PG8_STAGE2
#undef PG8_STAGE_A
#undef PG8_STAGE_B
#undef PG8_LDA
#undef PG8_LDB
#undef PG8_MMA
#undef PG8_WAIT_V
#undef PG8_WAIT_L
#undef PG8_BAR
#undef PG8_SCHED
}
template <class E> struct EpiAdapt {
    E e;
    __device__ __forceinline__ void operator()(const f32x4 (&acc)[2][2][4][2], const Unit& u, int wr, int wc, int fr, int fq) const {
#pragma unroll
        for (int ai = 0; ai < 2; ++ai)
#pragma unroll
            for (int m = 0; m < 4; ++m) {
                const int row = u.pm * BM + ai * HALF + wr * 64 + m * 16 + fr;
                const typename E::Row rw = e.row(row);
                float ss = 0.f;
#pragma unroll
                for (int bj = 0; bj < 2; ++bj) {
                    const int col = u.pn * BM + bj * HALF + wc * 32 + fq * 8;
                    const f32x4 a0 = acc[ai][bj][m][0], a1 = acc[ai][bj][m][1];
                    const float v[8] = {a0[0], a0[1], a0[2], a0[3], a1[0], a1[1], a1[2], a1[3]};
                    ss += e(row, col, v, rw);
                }
                ss += __shfl_xor(ss, 16); ss += __shfl_xor(ss, 32);
                if (fq == 0) e.rowsum(row, u.pn * 4 + wc, ss);
            }
    }
};
struct DenseProb {
    static constexpr bool GATHER = false;
    const bf16_t* A; const bf16_t* Bt; int K;
    __device__ __forceinline__ const char* abase(const Unit& u) const { return (const char*)A + (size_t)u.pm * BM * K * 2; }
    __device__ __forceinline__ unsigned arow_off(const Unit&, int) const { return 0u; }
    __device__ __forceinline__ const char* bbase(const Unit& u) const { return (const char*)Bt + (size_t)u.pn * BM * K * 2; }
};
}
struct MoeGatherProb {
    static constexpr bool GATHER = true;
    MoeTab mt; const int* list; const bf16_t* HB; const bf16_t* W; int K;
    __device__ __forceinline__ const char* abase(const pg8::Unit&) const { return (const char*)HB; }
    __device__ __forceinline__ unsigned arow_off(const pg8::Unit& u, int r) const { const MoeRow m = moe_row(mt, list, u.pm * 256 + r); return (unsigned)(m.tok >= 0 ? m.tok : 0) * (unsigned)(D * 2); }
    __device__ __forceinline__ const char* bbase(const pg8::Unit& u) const { return (const char*)W + ((size_t)mt.tile2e[u.pm] * D + (size_t)u.pn * 256) * D * 2; }
};
struct MoeDownProb {
    static constexpr bool GATHER = false;
    MoeTab mt; const bf16_t* ACT; const bf16_t* W; int K;
    __device__ __forceinline__ const char* abase(const pg8::Unit& u) const { return (const char*)ACT + (size_t)u.pm * 256 * DEXP * 2; }
    __device__ __forceinline__ unsigned arow_off(const pg8::Unit&, int) const { return 0u; }
    __device__ __forceinline__ const char* bbase(const pg8::Unit& u) const { return (const char*)W + ((size_t)mt.tile2e[u.pm] * D + (size_t)u.pn * 256) * DEXP * 2; }
};
template <class E> __device__ __forceinline__ void gemm_dense(Ctx& C, const bf16_t* A, const bf16_t* Bt, int N, int K, const E& e) {
    pg8::DenseProb P{A, Bt, K}; pg8::StaticOrder S; S.init(T, N, C.nblk, C.bid); pg8::EpiAdapt<E> ea{e};
    pg8::gemm_phase(C.lds, C.tid, P, S, ea);
}

__device__ __forceinline__ void phase_conv(Ctx& C, int j) {
    const bf16_t* P3 = WSP(bf16_t, WS_P3); bf16_t* MIX = WSP(bf16_t, WS_MIX); const float* cw = WSP(float, WS_PAR) + PAR_CONV + (size_t)j * 3 * 512;
    const int gt = C.bid * NTHREADS + C.tid, NGT = C.nblk * NTHREADS;
    for (int i = gt; i < T * 64; i += NGT) {
        const int t = i >> 6, c = (i & 63) * 8, s = t & (SEQ - 1);
        float acc[8];
#pragma unroll
        for (int q = 0; q < 8; ++q) acc[q] = 0.f;
#pragma unroll
        for (int k = 0; k < 3; ++k) {
            const int dt = 2 - k;
            if (s - dt >= 0) {
                float xc[8], gc[8]; unpack8(*(const u32x4*)(P3 + (size_t)(t - dt) * 1536 + c), xc); unpack8(*(const u32x4*)(P3 + (size_t)(t - dt) * 1536 + 1024 + c), gc);
#pragma unroll
                for (int q = 0; q < 8; ++q) acc[q] += cw[k * 512 + c + q] * (gc[q] * xc[q]);
            }
        }
        float gb[8]; unpack8(*(const u32x4*)(P3 + (size_t)t * 1536 + 512 + c), gb);
#pragma unroll
        for (int q = 0; q < 8; ++q) acc[q] *= gb[q];
        *(u32x4*)(MIX + (size_t)t * D + c) = pack8(acc);
    }
}

__device__ __forceinline__ void phase_attn_naive(Ctx& C) {
    const bf16_t* Q = WSP(bf16_t, WS_Q); const bf16_t* KV = WSP(bf16_t, WS_KV); const bf16_t* KPE = WSP(bf16_t, WS_KPE); bf16_t* MIX = WSP(bf16_t, WS_MIX);
    LAS float* Ks = (LAS float*)C.lds;
    LAS float* Vs = Ks + 64 * 97;
    LAS float* Qs = Vs + 64 * 64;
    LAS float* Ps = Qs + 64 * 96;
    const int tid = C.tid, lane = C.lane, wave = C.wave;
    const int nunits = NBATCH * NH * (SEQ / 64);
    for (int u = C.bid; u < nunits; u += C.nblk) {
        const int qb = (SEQ / 64 - 1) - (u / (NBATCH * NH)), bh = u % (NBATCH * NH), b = bh / NH, h = bh % NH;
        const int t0 = b * SEQ + qb * 64;
        __syncthreads();
        for (int i = tid; i < 64 * 12; i += NTHREADS) { const int r = i / 12, c8 = (i % 12) * 8; float v[8]; unpack8(*(const u32x4*)(Q + (size_t)(t0 + r) * 768 + h * 96 + c8), v);
#pragma unroll
            for (int q = 0; q < 8; ++q) Qs[r * 96 + c8 + q] = v[q]; }
        float m[8], l[8], o[8];
#pragma unroll
        for (int i = 0; i < 8; ++i) { m[i] = -1e30f; l[i] = 0.f; o[i] = 0.f; }
        for (int kt = 0; kt <= qb; ++kt) {
            const int k0 = b * SEQ + kt * 64;
            __syncthreads();
            for (int i = tid; i < 64 * 20; i += NTHREADS) { const int r = i / 20, c = i % 20; float v[8];
                if (c < 8) { unpack8(*(const u32x4*)(KV + (size_t)(k0 + r) * 1024 + h * 128 + c * 8), v);
#pragma unroll
                    for (int q = 0; q < 8; ++q) Ks[r * 97 + c * 8 + q] = v[q]; }
                else if (c < 12) { unpack8(*(const u32x4*)(KPE + (size_t)(k0 + r) * 32 + (c - 8) * 8), v);
#pragma unroll
                    for (int q = 0; q < 8; ++q) Ks[r * 97 + c * 8 + q] = v[q]; }
                else { unpack8(*(const u32x4*)(KV + (size_t)(k0 + r) * 1024 + h * 128 + 64 + (c - 12) * 8), v);
#pragma unroll
                    for (int q = 0; q < 8; ++q) Vs[r * 64 + (c - 12) * 8 + q] = v[q]; } }
            __syncthreads();
#pragma unroll
            for (int qi = 0; qi < 8; ++qi) {
                const int qr = wave * 8 + qi;
                float s = 0.f;
                for (int d = 0; d < 96; ++d) s += Qs[qr * 96 + d] * Ks[lane * 97 + d];
                if (kt == qb && lane > qr) s = -1e30f;
                const float mn = fmaxf(m[qi], wave_max(s));
                const float p = exp2f(s - mn), al = exp2f(m[qi] - mn);
                const float pb = rbf(p);
                l[qi] = l[qi] * al + wave_sum(p); m[qi] = mn;
                Ps[wave * 64 + lane] = pb;
                asm volatile("s_waitcnt lgkmcnt(0)" ::: "memory");
                float acc = 0.f;
                for (int k = 0; k < 64; ++k) acc += Ps[wave * 64 + k] * Vs[k * 64 + lane];
                o[qi] = o[qi] * al + acc;
                asm volatile("s_waitcnt lgkmcnt(0)" ::: "memory");
            }
        }
#pragma unroll
        for (int qi = 0; qi < 8; ++qi) MIX[(size_t)(t0 + wave * 8 + qi) * D + 512 + h * 64 + lane] = (bf16_t)f2bf(o[qi] / l[qi]);
    }
    __syncthreads();
}


typedef float f32x16 __attribute__((ext_vector_type(16)));
typedef short s16x4 __attribute__((ext_vector_type(4)));
typedef short v4i16_t __attribute__((ext_vector_type(4)));
__device__ __forceinline__ int crow(int r, int hi) { return (r & 3) + 8 * (r >> 2) + 4 * hi; }
__device__ __forceinline__ s16x4 vtr(const LAS unsigned char* p) { return __builtin_bit_cast(s16x4, __builtin_amdgcn_ds_read_tr16_b64_v4i16((LAS v4i16_t*)p)); }
#ifndef ATT_THR
#define ATT_THR 5.0f
#endif
__device__ __forceinline__ void phase_attn(Ctx& C) {
    const bf16_t* Q = WSP(bf16_t, WS_Q); const bf16_t* KV = WSP(bf16_t, WS_KV); const bf16_t* KPE = WSP(bf16_t, WS_KPE); bf16_t* MIX = WSP(bf16_t, WS_MIX);
    constexpr int KROW = 208, KBUF = 64 * KROW, VBUF = 8192, OFF_K = 0, OFF_V = 2 * KBUF, OFF_WS = OFF_V + 2 * VBUF, OFF_OST = OFF_WS + 8 * 128;
    LAS unsigned char* lds = C.lds;
    const int tid = C.tid, lane = C.lane, wave = C.wave, r32 = lane & 31, hi = lane >> 5;
    LAS float* wsf = (LAS float*)(lds + OFF_WS + wave * 128);
    LAS unsigned char* ost = lds + OFF_OST + wave * 4096;
    const int krow = tid >> 3, kch = tid & 7, prow = tid >> 2, pch = tid & 3;
    const int kdst = krow * KROW + kch * 16, vdst = (kch >> 2) * 4096 + krow * 64 + (kch & 3) * 16, pdst = prow * KROW + 128 + pch * 16;
    const int kfrag = r32 * KROW + hi * 16;
    const int vfrag = ((lane >> 4) & 1) * 32 + (lane & 3) * 8 + (4 * hi + ((lane & 15) >> 2)) * 64;
    for (int pr = C.bid; pr < 256; pr += C.nblk) {
        for (int half = 0; half < 2; ++half) {
            const int bh = pr >> 3, qq = pr & 7, qb = half == 0 ? 15 - qq : qq, b = bh >> 3, h = bh & 7;
            const int tb = b * SEQ, t0 = tb + qb * 256, NT = 4 * qb + 4;
            bf16x8 qf[6];
            { const bf16_t* qp = Q + (size_t)(t0 + wave * 32 + r32) * 768 + h * 96 + hi * 8;
#pragma unroll
              for (int s = 0; s < 6; ++s) qf[s] = *(const bf16x8*)(qp + 16 * s); }
            f32x16 o0, o1;
#pragma unroll
            for (int r = 0; r < 16; ++r) { o0[r] = 0.f; o1[r] = 0.f; }
            float mref = -1e30f, lsum = 0.f;
            const bf16_t* ksrc = KV + (size_t)(tb + krow) * 1024 + h * 128 + kch * 8;
            const bf16_t* vsrc = ksrc + 64;
            const bf16_t* psrc = KPE + (size_t)(tb + prow) * 32 + pch * 8;
            u32x4 kreg, vreg, preg;
            kreg = *(const u32x4*)ksrc; vreg = *(const u32x4*)vsrc; preg = (tid < 256) ? *(const u32x4*)psrc : (u32x4){0u, 0u, 0u, 0u};
            __syncthreads();
            *(LAS u32x4*)(lds + OFF_K + kdst) = kreg; *(LAS u32x4*)(lds + OFF_V + vdst) = vreg; if (tid < 256) *(LAS u32x4*)(lds + OFF_K + pdst) = preg;
            __syncthreads();
            const int qmin = qb * 256 + wave * 32;
            for (int t = 0; t < NT; ++t) {
                const int cur = t & 1;
                if (t + 1 < NT) { const size_t adv = (size_t)(t + 1) * 64; kreg = *(const u32x4*)(ksrc + adv * 1024); vreg = *(const u32x4*)(vsrc + adv * 1024); if (tid < 256) preg = *(const u32x4*)(psrc + adv * 32); }
                const int kmin = 64 * t;
                if (kmin <= qmin + 31) {
                    f32x16 p0, p1;
#pragma unroll
                    for (int r = 0; r < 16; ++r) { p0[r] = 0.f; p1[r] = 0.f; }
                    const LAS unsigned char* kb = lds + OFF_K + cur * KBUF + kfrag;
#pragma unroll
                    for (int s = 0; s < 6; ++s) {
                        const bf16x8 k0 = *(const LAS bf16x8*)(kb + s * 32), k1 = *(const LAS bf16x8*)(kb + 32 * KROW + s * 32);
                        p0 = __builtin_amdgcn_mfma_f32_32x32x16_bf16(k0, qf[s], p0, 0, 0, 0);
                        p1 = __builtin_amdgcn_mfma_f32_32x32x16_bf16(k1, qf[s], p1, 0, 0, 0);
                    }
                    if (kmin + 63 > qmin) {
                        const int qd = qmin + r32 - kmin;
#pragma unroll
                        for (int r = 0; r < 16; ++r) { const int kv = crow(r, hi); if (kv > qd) p0[r] = -1e30f; if (kv + 32 > qd) p1[r] = -1e30f; }
                    }
                    float rm = fmaxf(p0[0], p1[0]);
#pragma unroll
                    for (int r = 1; r < 16; ++r) rm = fmaxf(rm, fmaxf(p0[r], p1[r]));
                    rm = fmaxf(rm, __shfl_xor(rm, 32));
                    if (__any(rm > mref + ATT_THR)) {
                        const float mnew = fmaxf(mref, rm), f = __builtin_amdgcn_exp2f(mref - mnew);
                        lsum *= f; mref = mnew;
                        if (hi == 0) wsf[r32] = f;
                        asm volatile("s_waitcnt lgkmcnt(0)" ::: "memory");
#pragma unroll
                        for (int r = 0; r < 16; ++r) { const float fr = wsf[crow(r, hi)]; o0[r] *= fr; o1[r] *= fr; }
                        asm volatile("s_waitcnt lgkmcnt(0)" ::: "memory");
                    }
#pragma unroll
                    for (int r = 0; r < 16; ++r) { p0[r] = __builtin_amdgcn_exp2f(p0[r] - mref); p1[r] = __builtin_amdgcn_exp2f(p1[r] - mref); lsum += p0[r] + p1[r]; }
                    u32x4 pw[4];
#pragma unroll
                    for (int i = 0; i < 4; ++i) { pw[0][i] = pk2(p0[2 * i], p0[2 * i + 1]); pw[1][i] = pk2(p0[8 + 2 * i], p0[9 + 2 * i]); pw[2][i] = pk2(p1[2 * i], p1[2 * i + 1]); pw[3][i] = pk2(p1[8 + 2 * i], p1[9 + 2 * i]); }
                    const LAS unsigned char* vb = lds + OFF_V + cur * VBUF + vfrag;
#pragma unroll
                    for (int ks = 0; ks < 4; ++ks) {
                        const s16x4 a0 = vtr(vb + ks * 1024), a1 = vtr(vb + ks * 1024 + 512), b0 = vtr(vb + 4096 + ks * 1024), b1 = vtr(vb + 4096 + ks * 1024 + 512);
                        const bf16x8 v0 = (bf16x8){a0[0], a0[1], a0[2], a0[3], a1[0], a1[1], a1[2], a1[3]}, v1 = (bf16x8){b0[0], b0[1], b0[2], b0[3], b1[0], b1[1], b1[2], b1[3]};
                        const bf16x8 pa = __builtin_bit_cast(bf16x8, pw[ks]);
                        o0 = __builtin_amdgcn_mfma_f32_32x32x16_bf16(pa, v0, o0, 0, 0, 0);
                        o1 = __builtin_amdgcn_mfma_f32_32x32x16_bf16(pa, v1, o1, 0, 0, 0);
                    }
                }
                if (t + 1 < NT) { const int nb = cur ^ 1; *(LAS u32x4*)(lds + OFF_K + nb * KBUF + kdst) = kreg; *(LAS u32x4*)(lds + OFF_V + nb * VBUF + vdst) = vreg; if (tid < 256) *(LAS u32x4*)(lds + OFF_K + nb * KBUF + pdst) = preg; }
                __syncthreads();
            }
            const float ltot = lsum + __shfl_xor(lsum, 32);
            if (hi == 0) wsf[r32] = 1.0f / ltot;
            asm volatile("s_waitcnt lgkmcnt(0)" ::: "memory");
#pragma unroll
            for (int r = 0; r < 16; ++r) { const int q = crow(r, hi); const float fr = wsf[q];
                *(LAS bf16_t*)(ost + q * 128 + r32 * 2) = (bf16_t)f2bf(o0[r] * fr); *(LAS bf16_t*)(ost + q * 128 + 64 + r32 * 2) = (bf16_t)f2bf(o1[r] * fr); }
            asm volatile("s_waitcnt lgkmcnt(0)" ::: "memory");
#pragma unroll
            for (int i = 0; i < 4; ++i) { const int idx = i * 64 + lane, q = idx >> 3, c = idx & 7;
                const u32x4 w = *(const LAS u32x4*)(ost + q * 128 + c * 16);
                *(u32x4*)(MIX + (size_t)(t0 + wave * 32 + q) * D + 512 + h * 64 + c * 8) = w; }
        }
    }
    __syncthreads();
}


__device__ __forceinline__ void phase_sg(Ctx& C, int j) {
    const bf16_t* Z = WSP(bf16_t, WS_Z); const float* ssqx = WSP(float, WS_SSQX); const bf16_t* WS = WSP(bf16_t, WS_WS) + (size_t)j * 8 * 128 * 128; bf16_t* MIX = WSP(bf16_t, WS_MIX);
    const float* vg = WSP(float, WS_PAR) + PAR_VN + j * D; const float* bs = WSP(float, WS_PAR) + PAR_BS + (size_t)j * 8 * 128;
    LAS unsigned char* lds = C.lds;
    const int tid = C.tid, lane = C.lane, wave = C.wave, r32 = lane & 31, hi = lane >> 5, wr = wave >> 1, wc = wave & 1;
    const int srow = tid >> 2, sblk = tid & 3;
    const int vfrag = ((lane >> 4) & 1) * 32 + (lane & 3) * 8 + (8 * hi + ((lane & 15) >> 2)) * 64;
    for (int u = C.bid; u < NBATCH * 32 * 8; u += C.nblk) {
        const int g = u & 7, bc = u >> 3, t0 = bc * 128;
        __syncthreads();
        {
            const float rv = rs_from(ssqx + (t0 + srow) * 36 + 16, 16, 1.f / 1024);
            const bf16_t* zp = Z + (size_t)(t0 + srow) * 2048 + 1024 + g * 128 + sblk * 32; const float* gp = vg + g * 128 + sblk * 32;
#pragma unroll
            for (int c = 0; c < 4; ++c) { float v[8]; unpack8(*(const u32x4*)(zp + c * 8), v);
#pragma unroll
                for (int q = 0; q < 8; ++q) v[q] = v[q] * rv * gp[c * 8 + q];
                *(LAS u32x4*)(lds + sblk * 8192 + srow * 64 + c * 16) = pack8(v); }
        }
        __syncthreads();
        f32x16 a0, a1;
#pragma unroll
        for (int r = 0; r < 16; ++r) { a0[r] = 0.f; a1[r] = 0.f; }
        const bf16_t* wp = WS + (size_t)g * 16384 + (32 * wr + r32) * 128 + 8 * hi;
        const LAS unsigned char* vb = lds + (2 * wc) * 8192 + vfrag;
        for (int ks = 0; ks < 2 * wr + 2; ++ks) {
            const bf16x8 wf = *(const bf16x8*)(wp + 16 * ks);
            const s16x4 x0 = vtr(vb + ks * 1024), x1 = vtr(vb + ks * 1024 + 256), y0 = vtr(vb + 8192 + ks * 1024), y1 = vtr(vb + 8192 + ks * 1024 + 256);
            const bf16x8 v0 = (bf16x8){x0[0], x0[1], x0[2], x0[3], x1[0], x1[1], x1[2], x1[3]}, v1 = (bf16x8){y0[0], y0[1], y0[2], y0[3], y1[0], y1[1], y1[2], y1[3]};
            a0 = __builtin_amdgcn_mfma_f32_32x32x16_bf16(wf, v0, a0, 0, 0, 0);
            a1 = __builtin_amdgcn_mfma_f32_32x32x16_bf16(wf, v1, a1, 0, 0, 0);
        }
#pragma unroll
        for (int r = 0; r < 16; ++r) {
            const int t = 32 * wr + crow(r, hi); const float bias = bs[g * 128 + t];
            const size_t zo = (size_t)(t0 + t) * 2048 + g * 128 + 64 * wc + r32, mo = (size_t)(t0 + t) * D + g * 128 + 64 * wc + r32;
            MIX[mo] = (bf16_t)f2bf(bf2f(Z[zo]) * (a0[r] + bias)); MIX[mo + 32] = (bf16_t)f2bf(bf2f(Z[zo + 32]) * (a1[r] + bias));
        }
    }
    __syncthreads();
}

__device__ __forceinline__ void phase_sg_naive(Ctx& C, int j) {
    const bf16_t* Z = WSP(bf16_t, WS_Z); const float* ssqx = WSP(float, WS_SSQX); const bf16_t* WS = WSP(bf16_t, WS_WS) + (size_t)j * 8 * 128 * 128; bf16_t* MIX = WSP(bf16_t, WS_MIX);
    const float* vg = WSP(float, WS_PAR) + PAR_VN + j * D; const float* bs = WSP(float, WS_PAR) + PAR_BS + (size_t)j * 8 * 128;
    LAS float* Wt = (LAS float*)C.lds;
    LAS float* Vn = Wt + 128 * 129;
    const int tid = C.tid;
    for (int u = C.bid; u < NBATCH * 32 * 8; u += C.nblk) {
        const int g = u & 7, bc = u >> 3, t0 = bc * 128;
        __syncthreads();
        for (int i = tid; i < 128 * 16; i += NTHREADS) { const int r = i >> 4, c8 = (i & 15) * 8; float v[8];
            unpack8(*(const u32x4*)(WS + (size_t)g * 16384 + r * 128 + c8), v);
#pragma unroll
            for (int q = 0; q < 8; ++q) Wt[r * 129 + c8 + q] = v[q];
            unpack8(*(const u32x4*)(Z + (size_t)(t0 + r) * 2048 + 1024 + g * 128 + c8), v);
            const float rv = rs_from(ssqx + (t0 + r) * 36 + 16, 16, 1.f / 1024);
#pragma unroll
            for (int q = 0; q < 8; ++q) Vn[r * 128 + c8 + q] = rbf(v[q] * rv * vg[g * 128 + c8 + q]); }
        __syncthreads();
        const int t = tid >> 2, d0 = (tid & 3) * 32;
        float acc[32];
#pragma unroll
        for (int i = 0; i < 32; ++i) acc[i] = 0.f;
        for (int s = 0; s <= t; ++s) { const float w = Wt[t * 129 + s];
#pragma unroll
            for (int i = 0; i < 32; ++i) acc[i] += w * Vn[s * 128 + d0 + i]; }
        const float bias = bs[g * 128 + t];
#pragma unroll
        for (int i8 = 0; i8 < 4; ++i8) { float uu[8], o[8]; unpack8(*(const u32x4*)(Z + (size_t)(t0 + t) * 2048 + g * 128 + d0 + i8 * 8), uu);
#pragma unroll
            for (int q = 0; q < 8; ++q) o[q] = uu[q] * (acc[i8 * 8 + q] + bias);
            *(u32x4*)(MIX + (size_t)(t0 + t) * D + g * 128 + d0 + i8 * 8) = pack8(o); }
    }
    __syncthreads();
}

__device__ __forceinline__ void phase_router(Ctx& C, int layer, bool sh = false) {
    const bf16_t* HB = WSP(bf16_t, WS_HB0); const float* ssq = WSP(float, WS_SSQ0); const bf16_t* WR = WSP(bf16_t, WS_WR) + (size_t)layer * 64 * D;
    int* tok_e = sh ? WSP(int, WS_Y + 4 * MiB) : WSP(int, WS_TOK); int* tok_pos = tok_e + 2 * T; float* rffn = (float*)(tok_pos + 2 * T);
    int* list = sh ? WSP(int, WS_Y) : WSP(int, WS_LIST); float* lw = sh ? WSP(float, WS_Y + 2 * MiB) : WSP(float, WS_LW); unsigned* cnt = WSP(unsigned, WS_CTL) + CW_CNT + (layer + (sh ? 4 : 0)) * 32 * 64;
    LAS u32x4* Wl = (LAS u32x4*)C.lds;
    const int lane = C.lane;
    __syncthreads();
    for (int i = C.tid; i < 48 * 128; i += NTHREADS) Wl[(i >> 7) * 129 + (i & 127)] = *(const u32x4*)(WR + (size_t)i * 8);
    __syncthreads();
    LAS float* lgw = (LAS float*)(C.lds + 48 * 129 * 16) + C.wave * (16 * 49);
    const int gw = C.bid * NWAVES + C.wave, NGW = C.nblk * NWAVES, fr = lane & 15, fq = lane >> 4;
    for (int grp = gw; grp < T / 16; grp += NGW) {
        const int tok0 = grp * 16;
        f32x4 acc[3];
#pragma unroll
        for (int n = 0; n < 3; ++n) acc[n] = (f32x4){0.f, 0.f, 0.f, 0.f};
        const bf16_t* ap = HB + (size_t)(tok0 + fr) * D + fq * 8;
#pragma unroll 8
        for (int ks = 0; ks < 32; ++ks) {
            const bf16x8 a = *(const bf16x8*)(ap + 32 * ks);
#pragma unroll
            for (int n = 0; n < 3; ++n) { const bf16x8 b = __builtin_bit_cast(bf16x8, Wl[(16 * n + fr) * 129 + 4 * ks + fq]); acc[n] = __builtin_amdgcn_mfma_f32_16x16x32_bf16(a, b, acc[n], 0, 0, 0); }
        }
#pragma unroll
        for (int n = 0; n < 3; ++n)
#pragma unroll
            for (int r = 0; r < 4; ++r) lgw[(4 * fq + r) * 49 + 16 * n + fr] = acc[n][r];
        asm volatile("s_waitcnt lgkmcnt(0)" ::: "memory");
        if (lane < 16) {
            const int m = tok0 + lane; const LAS float* lg = lgw + lane * 49;
            const float r = rs_from(ssq + m * 16, 16, 1.f / D);
            const float g0 = lg[0] * r, g1 = lg[1] * r, g2 = lg[2] * r, g3 = lg[3] * r;
            int g = 0; float gm = g0;
            if (g1 > gm) { gm = g1; g = 1; }
            if (g2 > gm) { gm = g2; g = 2; }
            if (g3 > gm) { gm = g3; g = 3; }
            const float gs = __expf(g0 - gm) + __expf(g1 - gm) + __expf(g2 - gm) + __expf(g3 - gm);
            const float gw_ = 1.0f / gs;
            float el[8];
#pragma unroll
            for (int q = 0; q < 8; ++q) el[q] = lg[4 + g * 8 + q] * r;
            int i1 = 0; float m1 = el[0];
#pragma unroll
            for (int q = 1; q < 8; ++q) if (el[q] > m1) { m1 = el[q]; i1 = q; }
            int i2 = -1; float m2 = -3.0e38f;
#pragma unroll
            for (int q = 0; q < 8; ++q) if (q != i1 && el[q] > m2) { m2 = el[q]; i2 = q; }
            const float e2 = __expf(m2 - m1), p1 = 1.0f / (1.0f + e2), p2 = e2 / (1.0f + e2);
            rffn[m] = r;
            const int ea = g * 8 + i1, eb = g * 8 + i2;
            const int pa = (int)atomicAdd(cnt + ea * 64, 1u), pb = (int)atomicAdd(cnt + eb * 64, 1u);
            list[ea * T + pa] = m; lw[ea * T + pa] = gw_ * p1; list[eb * T + pb] = m; lw[eb * T + pb] = gw_ * p2;
            tok_e[2 * m] = ea; tok_e[2 * m + 1] = eb; tok_pos[2 * m] = pa; tok_pos[2 * m + 1] = pb;
        }
        asm volatile("s_waitcnt lgkmcnt(0)" ::: "memory");
    }
    __syncthreads();
}

__device__ __forceinline__ void phase_combine(Ctx& C, int layer, bool sh = false) {
    const MoeTab mt = moe_tables(C, layer);
    const bf16_t* HI = WSP(bf16_t, WS_HB0); bf16_t* HB = sh ? WSP(bf16_t, WS_KV) : WSP(bf16_t, WS_HB1); float* SS = sh ? WSP(float, WS_SSQX) : WSP(float, WS_SSQ1); const bf16_t* Y = WSP(bf16_t, WS_Y);
    const int* tok_e = WSP(int, WS_TOK); const int* tok_pos = tok_e + 2 * T;
    const int gw = C.bid * NWAVES + C.wave, NGW = C.nblk * NWAVES, lane = C.lane;
    for (int m = gw; m < T; m += NGW) {
        const int ea = tok_e[2 * m], eb = tok_e[2 * m + 1];
        const size_t sa = (size_t)mt.ebase[ea] * 256 + tok_pos[2 * m], sb = (size_t)mt.ebase[eb] * 256 + tok_pos[2 * m + 1];
        const u32x4* hr = (const u32x4*)(HI + (size_t)m * D) + lane; const u32x4* ya = (const u32x4*)(Y + sa * D) + lane; const u32x4* yb = (const u32x4*)(Y + sb * D) + lane;
        u32x4* ob = (u32x4*)(HB + (size_t)m * D) + lane; float s = 0.f;
#pragma unroll
        for (int j = 0; j < 2; ++j) {
            float h[8], a[8], b[8]; unpack8(hr[64 * j], h); unpack8(ya[64 * j], a); unpack8(yb[64 * j], b);
#pragma unroll
            for (int i = 0; i < 8; ++i) { h[i] += a[i] + b[i]; s += h[i] * h[i]; }
            ob[64 * j] = pack8(h);
        }
        s = wave_sum(s);
        if (lane < 16) SS[m * 16 + lane] = (lane == 0) ? s : 0.f;
    }
    __syncthreads();
}

__device__ __forceinline__ void phase_final(Ctx& C, float* outp) {
    const bf16_t* HB = WSP(bf16_t, WS_HB0); const float* SS = WSP(float, WS_SSQ0); const float* g = WSP(float, WS_PAR) + PAR_FN;
    const int gw = C.bid * NWAVES + C.wave, NGW = C.nblk * NWAVES, lane = C.lane;
    for (int m = gw; m < T; m += NGW) {
        const float r = rs_from(SS + m * 16, 16, 1.f / D);
        const u32x4* hr = (const u32x4*)(HB + (size_t)m * D) + lane; f32x4* o = (f32x4*)(outp + (size_t)m * D) + 2 * lane; const f32x4* gg = (const f32x4*)g + 2 * lane;
#pragma unroll
        for (int j = 0; j < 2; ++j) { float h[8]; unpack8(hr[64 * j], h); const f32x4 w0 = gg[128 * j], w1 = gg[128 * j + 1];
            o[128 * j] = (f32x4){h[0] * r * w0.x, h[1] * r * w0.y, h[2] * r * w0.z, h[3] * r * w0.w}; o[128 * j + 1] = (f32x4){h[4] * r * w1.x, h[5] * r * w1.y, h[6] * r * w1.z, h[7] * r * w1.w}; }
    }
}

constexpr int NPHASES = 42;
template <int ph, bool SH = false> __device__ __forceinline__ void run_phase(Ctx& C) {
    constexpr int layer = (ph - 1) / 10, sub = (ph - 1) % 10, j = layer >> 1; constexpr bool even = (layer & 1) == 0;
    bf16_t* HB0 = WSP(bf16_t, WS_HB0); bf16_t* HB1 = WSP(bf16_t, WS_HB1); float* SSQ0 = WSP(float, WS_SSQ0); float* SSQ1 = WSP(float, WS_SSQ1); float* SSQX = WSP(float, WS_SSQX);
    bf16_t* HB0w = SH ? WSP(bf16_t, WS_KV) : HB0; float* SSQ0w = SH ? SSQX : SSQ0;
    const float* ROPE = WSP(float, WS_ROPE); bf16_t* MIX = WSP(bf16_t, WS_MIX);
    switch (sub) {
    case 0:
        if (even) { const bf16_t* W = WSP(bf16_t, WS_WINE) + (size_t)j * EINP * D; EpiE1 e{SSQ0, WSP(bf16_t, WS_P3), WSP(bf16_t, WS_CQ), WSP(bf16_t, WS_CKV), WSP(bf16_t, WS_KPE), SSQX, ROPE};
            if (FASTMASK & 1) gemm_dense(C, HB0, W, EINP, D, e); else { DenseRM rm{HB0, W, D}; gemm_naive(C, EINP, D, rm, e); } }
        else { const bf16_t* W = WSP(bf16_t, WS_WINO) + (size_t)j * 2048 * D; EpiGelu e{SSQ0, WSP(bf16_t, WS_Z), SSQX};
            if (FASTMASK & 2) gemm_dense(C, HB0, W, 2048, D, e); else { DenseRM rm{HB0, W, D}; gemm_naive(C, 2048, D, rm, e); } }
        break;
    case 1:
        if (even) {
            { const bf16_t* W = WSP(bf16_t, WS_WQ) + (size_t)j * 768 * QR; EpiQ e{SSQX, WSP(bf16_t, WS_Q), ROPE};
              if (FASTMASK & 4) gemm_dense(C, WSP(bf16_t, WS_CQ), W, 768, QR, e); else { DenseRM rm{WSP(bf16_t, WS_CQ), W, QR}; gemm_naive(C, 768, QR, rm, e); } }
            { const bf16_t* W = WSP(bf16_t, WS_WKV) + (size_t)j * 1024 * KVR; EpiKV e{SSQX, WSP(bf16_t, WS_KV)};
              if (FASTMASK & 8) gemm_dense(C, WSP(bf16_t, WS_CKV), W, 1024, KVR, e); else { DenseRM rm{WSP(bf16_t, WS_CKV), W, KVR}; gemm_naive(C, 1024, KVR, rm, e); } }
            phase_conv(C, j);
        } else { if (FASTMASK & 1024) phase_sg(C, j); else phase_sg_naive(C, j); }
        break;
    case 2:
        if (even) { if (FASTMASK & 512) phase_attn(C); else phase_attn_naive(C); }
        break;
    case 3: {
        const bf16_t* W = (even ? WSP(bf16_t, WS_WOE) : WSP(bf16_t, WS_WOO)) + (size_t)j * D * D; EpiRes e{HB0, HB0w, SSQ0w};
        if (FASTMASK & 16) gemm_dense(C, MIX, W, D, D, e); else { DenseRM rm{MIX, W, D}; gemm_naive(C, D, D, rm, e); }
        break; }
    case 4: { phase_router(C, layer, SH);
        const bf16_t* A = WSP(bf16_t, WS_PB) + (size_t)layer * T * PLE; const bf16_t* W = WSP(bf16_t, WS_WP) + (size_t)layer * D * PLE; EpiPP e{WSP(bf16_t, WS_PP)};
        gemm_dense(C, A, W, D, PLE, e);
        break; }
    case 5: { const MoeTab mt = moe_tables(C, layer); const int* tok_e = WSP(int, WS_TOK); const bf16_t* W = WSP(bf16_t, WS_WGU) + (size_t)layer * NEXP * D * D;
        EpiGU e{mt, WSP(int, WS_LIST), (const float*)(tok_e + 4 * T), WSP(bf16_t, WS_ACT)};
        if (FASTMASK & 32) { MoeGatherProb P{mt, WSP(int, WS_LIST), HB0, W, D}; pg8::MoeOrder S{mt.ebase[NEXP], C.nblk, C.bid}; pg8::EpiAdapt<EpiGU> ea{e}; pg8::gemm_phase(C.lds, C.tid, P, S, ea); }
        else { MoeGatherRM rm{mt, WSP(int, WS_LIST), HB0, W}; gemm_naive(C, D, D, rm, e); }
        break; }
    case 6: { const MoeTab mt = moe_tables(C, layer); const bf16_t* W = WSP(bf16_t, WS_WDN) + (size_t)layer * NEXP * D * DEXP;
        EpiDown e{mt, WSP(int, WS_LIST), WSP(float, WS_LW), WSP(bf16_t, WS_Y)};
        if (FASTMASK & 64) { MoeDownProb P{mt, WSP(bf16_t, WS_ACT), W, DEXP}; pg8::MoeOrder S{mt.ebase[NEXP], C.nblk, C.bid}; pg8::EpiAdapt<EpiDown> ea{e}; pg8::gemm_phase(C.lds, C.tid, P, S, ea); }
        else { MoeDownRM rm{mt, WSP(bf16_t, WS_ACT), W}; gemm_naive(C, D, DEXP, rm, e); }
        break; }
    case 7: phase_combine(C, layer, SH); break;
    case 8: break;
    case 9: { const bf16_t* W = WSP(bf16_t, WS_WG) + (size_t)layer * D * D; EpiPLE e{SSQ1, WSP(bf16_t, WS_PP), HB1, HB0w, SSQ0w};
        if (FASTMASK & 256) gemm_dense(C, HB1, W, D, D, e); else { DenseRM rm{HB1, W, D}; gemm_naive(C, D, D, rm, e); }
        break; }
    }
}
__host__ __device__ constexpr bool phase_is_nop(int ph) { return (ph != 0 && ph != NPHASES - 1) && ((((((ph - 1) / 10) & 1) != 0) && (((ph - 1) % 10) == 2)) || (((ph - 1) % 10) == 8)); }

__device__ __forceinline__ void phase_enter(Ctx& C, unsigned char* ws) {
    int t = threadIdx.x; asm volatile("" : "+v"(t)); C.tid = t; C.lane = t & 63; C.wave = __builtin_amdgcn_readfirstlane(t >> 6);
    unsigned char* w = ws; asm volatile("" : "+s"(w)); C.ws = w;
    int b = blockIdx.x; asm volatile("" : "+s"(b)); C.bid = b;
}
template <int PH> __device__ __forceinline__ void run_all(Ctx& C, unsigned char* ws, const XcdBarrier& bar) {
    if constexpr (PH < NPHASES - 1) {
        if constexpr (!phase_is_nop(PH)) { phase_enter(C, ws); run_phase<PH>(C); xcd_barrier(bar);
            if constexpr ((DUPMASK >> PH) & 1ull) { phase_enter(C, ws); run_phase<PH, true>(C); xcd_barrier(bar); } }
        run_all<PH + 1>(C, ws, bar);
    }
}
template <int PH> __device__ __forceinline__ void run_one(Ctx& C, unsigned char* ws, int ph) {
    if constexpr (PH < NPHASES - 1) {
        if (ph == PH) { if constexpr (!phase_is_nop(PH)) { phase_enter(C, ws); run_phase<PH>(C); } }
        else run_one<PH + 1>(C, ws, ph);
    }
}
__global__ void __launch_bounds__(NTHREADS, 2) fwd_kernel(Args args) {
    extern __shared__ __attribute__((aligned(16))) unsigned char lds_raw[];
    Ctx C;
    C.lds = (LAS unsigned char*)lds_raw;
    C.a = &args; C.ws = args.ws;
    C.tid = threadIdx.x; C.lane = C.tid & 63; C.wave = __builtin_amdgcn_readfirstlane(C.tid >> 6);
    C.bid = blockIdx.x; C.nblk = gridDim.x;
    volatile LAS unsigned* misc = (volatile LAS unsigned*)(C.lds + LDS_MISC);
    if (C.tid < 64) misc[C.tid] = 0u;
    __syncthreads();
#if MEGA
    XcdBarrier bar = xcd_barrier_post(WSP(unsigned, WS_CTL) + CW_BAR, misc + 8);
#endif
#if MEGA
    int lo = 0; constexpr int hi = NPHASES;
#else
    int lo = args.ph_lo; const int hi = args.ph_hi;
#endif
#if MEGA
#define SEAM(p) do { if ((p) + 1 < hi) xcd_barrier(bar); } while (0)
#else
#define SEAM(p) do { } while (0)
#endif
    if (lo == 0) { phase_prologue(C); SEAM(0); if (DUPMASK & 1ull) { phase_prologue(C); SEAM(0); } lo = 1; }
#if MEGA
    run_all<1>(C, args.ws, bar);
#else
    run_one<1>(C, args.ws, lo);
#endif
    if (hi == NPHASES && lo <= NPHASES - 1) {
        int t = threadIdx.x; asm volatile("" : "+v"(t)); C.tid = t; C.lane = t & 63; C.wave = __builtin_amdgcn_readfirstlane(t >> 6);
        unsigned char* w = args.ws; asm volatile("" : "+s"(w)); C.ws = w;
        phase_final(C, args.out);
    }
#undef SEAM
}

extern "C" void kernel_launch(void* const* d_in, const int* in_sizes, int n_in, void* d_out, int out_size, void* d_ws, size_t ws_size, hipStream_t stream) {
    static int grid = 0;
    if (grid == 0) {
        if (n_in != 26 || out_size != T * D || ws_size < WS_END) { fprintf(stderr, "kernel_launch: unexpected shapes (n_in %d out %d ws %zu)\n", n_in, out_size, ws_size); grid = -1; return; }
        int dev = 0, cus = 0;
        if (hipGetDevice(&dev) != hipSuccess || hipDeviceGetAttribute(&cus, hipDeviceAttributeMultiprocessorCount, dev) != hipSuccess) { grid = -1; return; }
        if (hipFuncSetAttribute((const void*)fwd_kernel, hipFuncAttributeMaxDynamicSharedMemorySize, LDS_BYTES) != hipSuccess) { fprintf(stderr, "kernel_launch: hipFuncSetAttribute failed\n"); grid = -1; return; }
        grid = cus;
    }
    if (grid < 0) return;
    (void)hipMemsetAsync((char*)d_ws + WS_CTL, 0, CTL_ZERO_BYTES, stream);
    Args a{};
    for (int i = 0; i < 26; ++i) a.in[i] = (const float*)d_in[i];
    a.out = (float*)d_out; a.ws = (unsigned char*)d_ws;
#if MEGA
    a.ph_lo = 0; a.ph_hi = NPHASES;
    hipLaunchKernelGGL(fwd_kernel, dim3(grid), dim3(NTHREADS), LDS_BYTES, stream, a);
#else
    for (int ph = 0; ph < NPHASES; ++ph) {
        if (phase_is_nop(ph)) continue;
        a.ph_lo = ph; a.ph_hi = ph + 1;
        hipLaunchKernelGGL(fwd_kernel, dim3(grid), dim3(NTHREADS), LDS_BYTES, stream, a);
    }
#endif
}
```
